# Optimizing an MI355X kernel written in HIP

```python
import jax, jax.numpy as jnp
from jax import lax
import numpy as np

D_MODEL = 1024
BATCH = 32
SEQ = 256
DEPTH = 4
DEC_BATCH = 4
DEC_SEQ = 4096
PAST_LEN = 512

GRID_W = 64
ROPE_BASE = 10000.0
EPS = 1e-6
QBLK = 128

MLA_HEADS = 8
MLA_NOPE = 64
MLA_ROPE = 32
MLA_QK = MLA_NOPE + MLA_ROPE
MLA_V = 64
Q_LORA = 384
KV_LORA = 256
MLA_WIDTH = MLA_HEADS * MLA_V

RET_HEADS = 4
RET_DK = 64
RET_DV = 128
RET_CHUNK = 128
RET_WIDTH = RET_HEADS * RET_DV

WIN_HEADS = 16
WIN_KV_HEADS = 4
WIN_HEAD_DIM = 64
WINDOW = 128
WIN_WIDTH = WIN_HEADS * WIN_HEAD_DIM

AB_SIZES = (Q_LORA, KV_LORA, MLA_ROPE, MLA_WIDTH, RET_HEADS * RET_DK, RET_HEADS * RET_DK, RET_WIDTH, RET_WIDTH)
AB_IN = sum(AB_SIZES)
WIN_SIZES = (WIN_WIDTH, WIN_KV_HEADS * WIN_HEAD_DIM, WIN_KV_HEADS * WIN_HEAD_DIM, WIN_WIDTH)
WIN_IN = sum(WIN_SIZES)
N_EVEN = (DEPTH + 1) // 2
N_ODD = DEPTH // 2

kernel_name = 'hybrid_mla_retention_window_dit_step'

F32 = jnp.float32


def split_cols(y, sizes):
    idx = np.cumsum(sizes)[:-1].tolist()
    return jnp.split(y, idx, axis=-1)


def rms_norm(x, g):
    xf = x.astype(F32)
    y = xf * lax.rsqrt(jnp.mean(xf * xf, axis=-1, keepdims=True) + EPS)
    return (y * g.astype(F32)).astype(x.dtype)


def grid_positions(n_tokens):
    rows = n_tokens // GRID_W
    t = jnp.arange(rows * GRID_W)
    return (t // GRID_W).astype(F32), (t % GRID_W).astype(F32)


def rope_1d(x, pos):
    half = x.shape[-1] // 2
    inv = jnp.power(jnp.float32(ROPE_BASE), -jnp.arange(half, dtype=F32) / half)
    ang = pos[:, None] * inv[None, :]
    cos = jnp.cos(ang)[:, None, :]
    sin = jnp.sin(ang)[:, None, :]
    xf = x.astype(F32)
    x1, x2 = xf[..., :half], xf[..., half:]
    return jnp.concatenate([x1 * cos - x2 * sin, x1 * sin + x2 * cos], axis=-1).astype(x.dtype)


def axial_rope(x, pos):
    rows, cols = pos
    d = x.shape[-1]
    return jnp.concatenate([rope_1d(x[..., : d // 2], rows), rope_1d(x[..., d // 2:], cols)], axis=-1)


def softmax_sink(s, sink):
    if sink is None:
        return jax.nn.softmax(s, axis=-1)
    sk = sink.astype(F32).reshape(1, s.shape[1], s.shape[2], 1, 1)
    m = jnp.maximum(s.max(axis=-1, keepdims=True), sk)
    e = jnp.exp(s - m)
    return e / (e.sum(axis=-1, keepdims=True) + jnp.exp(sk - m))


def block_attention(q, k, v, sink):
    B, Lq, H, D = q.shape
    KVH = k.shape[2]
    G = H // KVH
    E = v.shape[-1]
    NB = Lq // QBLK
    scale = D ** -0.5
    qb = q.reshape(B, NB, QBLK, KVH, G, D).transpose(1, 0, 2, 3, 4, 5)

    def one(q_blk):
        s = jnp.einsum('bqhgd,bkhd->bhgqk', q_blk, k).astype(F32) * scale
        pr = softmax_sink(s, sink).astype(v.dtype)
        return jnp.einsum('bhgqk,bkhe->bqhge', pr, v)

    o = lax.map(one, qb)
    return o.transpose(1, 0, 2, 3, 4, 5).reshape(B, Lq, H, E)


def window_attention(q, k, v, kc, vc, sink):
    B, L, H, D = q.shape
    KVH = k.shape[2]
    G = H // KVH
    NB = L // QBLK
    W3 = 3 * QBLK
    P = kc.shape[1]
    scale = D ** -0.5
    qb = q.reshape(B, NB, QBLK, KVH, G, D).transpose(1, 0, 2, 3, 4, 5)

    def band(x):
        xp = jnp.pad(x, ((0, 0), (QBLK, QBLK), (0, 0), (0, 0))).reshape(B, NB + 2, QBLK, KVH, x.shape[-1])
        xb = jnp.concatenate([xp[:, :-2], xp[:, 1:-1], xp[:, 2:]], axis=2)
        return xb.transpose(1, 0, 2, 3, 4)

    kb, vb = band(k), band(v)
    q_idx = jnp.arange(QBLK)[:, None]
    k_idx = jnp.arange(W3)[None, :]
    in_window = jnp.abs(k_idx - QBLK - q_idx) <= WINDOW
    kpos = (jnp.arange(NB)[:, None] - 1) * QBLK + jnp.arange(W3)[None, :]
    in_range = (kpos >= 0) & (kpos < L)
    mask = in_window[None, :, :] & in_range[:, None, :]

    def one(args):
        q_blk, k_blk, v_blk, m_blk = args
        s_ctx = jnp.einsum('bqhgd,bkhd->bhgqk', q_blk, kc).astype(F32) * scale
        s_loc = jnp.einsum('bqhgd,bkhd->bhgqk', q_blk, k_blk).astype(F32) * scale
        s_loc = jnp.where(m_blk, s_loc, -jnp.inf)
        pr = softmax_sink(jnp.concatenate([s_ctx, s_loc], axis=-1), sink).astype(v.dtype)
        return (jnp.einsum('bhgqk,bkhe->bqhge', pr[..., :P], vc)
                + jnp.einsum('bhgqk,bkhe->bqhge', pr[..., P:], v_blk))

    o = lax.map(one, (qb, kb, vb, mask))
    return o.transpose(1, 0, 2, 3, 4, 5).reshape(B, L, H, v.shape[-1])


def retention_scan(q, k, v, log_g, state0):
    B, L, H, DK = q.shape
    DV = v.shape[-1]
    C = RET_CHUNK
    N = L // C
    qc = q.reshape(B, N, C, H, DK)
    kc = k.reshape(B, N, C, H, DK)
    vc = v.reshape(B, N, C, H, DV)
    pos = jnp.arange(C, dtype=F32)
    rel = pos[:, None] - pos[None, :]
    causal = rel >= 0
    dmask = jnp.where(causal[None], jnp.exp(jnp.where(causal, rel, 0.0)[None] * log_g[:, None, None]), 0.0)
    s = jnp.einsum('bnqhd,bnkhd->bnhqk', qc, kc) * dmask.astype(q.dtype)
    intra = jnp.einsum('bnhqk,bnkhe->bnqhe', s, vc)
    k_w = jnp.exp((C - 1 - pos)[:, None] * log_g[None, :]).astype(k.dtype)
    U = jnp.einsum('bnkhd,kh,bnkhe->nbhde', kc, k_w, vc).astype(F32)
    g_chunk = jnp.exp(C * log_g)[None, :, None, None]

    def step(R, u):
        return g_chunk * R + u, R

    R_fin, R_prev = lax.scan(step, state0.astype(F32), U)
    q_w = jnp.exp((pos + 1.0)[:, None] * log_g[None, :]).astype(q.dtype)
    inter = jnp.einsum('bnqhd,qh,nbhde->bnqhe', qc, q_w, R_prev.astype(q.dtype))
    return (intra + inter).reshape(B, L, H, DV), R_fin.astype(v.dtype)


def bidir_retention(q, k, v, log_g2, sf, sb):
    of, rf = retention_scan(q, k, v, log_g2[0], sf)
    ob, rb = retention_scan(q[:, ::-1], k[:, ::-1], v[:, ::-1], log_g2[1], sb)
    return of + ob[:, ::-1], rf, rb


def head_group_norm(y, g):
    yf = y.astype(F32)
    mu = yf.mean(axis=-1, keepdims=True)
    var = jnp.mean(jnp.square(yf - mu), axis=-1, keepdims=True)
    out = (yf - mu) * lax.rsqrt(var + EPS) * g.astype(F32).reshape(y.shape[2], y.shape[3])
    return out.astype(y.dtype)


def mla_kv(ckv, krope, w_ukv, k_head_g):
    B, L, _ = ckv.shape
    kv = (ckv @ w_ukv).reshape(B, L, MLA_HEADS, MLA_NOPE + MLA_V)
    k_nope, v = kv[..., :MLA_NOPE], kv[..., MLA_NOPE:]
    k = jnp.concatenate([k_nope, jnp.broadcast_to(krope[:, :, None, :], (B, L, MLA_HEADS, MLA_ROPE))], axis=-1)
    return rms_norm(k, k_head_g), v


def rope_tail(x, pos):
    return jnp.concatenate([x[..., :MLA_NOPE], axial_rope(x[..., MLA_NOPE:], pos)], axis=-1)


def mixer_ab(h, p, ctx, pos):
    B, L, _ = h.shape
    cq, ckv, krope, g_a, rq, rk, rv, g_b = split_cols(h @ p['w_in'], AB_SIZES)
    ckv = rms_norm(ckv, p['kv_norm_g'])
    q = (rms_norm(cq, p['q_norm_g']) @ p['w_uq']).reshape(B, L, MLA_HEADS, MLA_QK)
    q = rms_norm(q, p['q_head_g'])
    k, v = mla_kv(ckv, krope, p['w_ukv'], p['k_head_g'])
    rq = rq.reshape(B, L, RET_HEADS, RET_DK) * (RET_DK ** -0.5)
    rk = rk.reshape(B, L, RET_HEADS, RET_DK)
    rv = rv.reshape(B, L, RET_HEADS, RET_DV)
    log_g = -jnp.exp(p['decay'].astype(F32))
    if ctx is None:
        a = block_attention(q, k, v, None)
        sf = jnp.zeros((B, RET_HEADS, RET_DK, RET_DV), F32)
        sb = sf
    else:
        ckv_c, krope_c, sf, sb = ctx
        kc, vc = mla_kv(ckv_c, krope_c, p['w_ukv'], p['k_head_g'])
        a = block_attention(rope_tail(q, pos), jnp.concatenate([kc, rope_tail(k, pos)], axis=1),
                            jnp.concatenate([vc, v], axis=1), None)
        rq = axial_rope(rq, pos)
        rk = axial_rope(rk, pos)
    r, rf, rb = bidir_retention(rq, rk, rv, log_g, sf, sb)
    r = head_group_norm(r, p['ret_norm_g'])
    mixed = jnp.concatenate([a.reshape(B, L, MLA_WIDTH) * jax.nn.silu(g_a),
                             r.reshape(B, L, RET_WIDTH) * jax.nn.silu(g_b)], axis=-1)
    return mixed @ p['w_out'], (ckv, krope, rf, rb)


def mixer_win(h, p, ctx, pos):
    B, L, _ = h.shape
    q, k, v, g = split_cols(h @ p['w_in'], WIN_SIZES)
    q = rms_norm(q.reshape(B, L, WIN_HEADS, WIN_HEAD_DIM), p['q_head_g'])
    k = rms_norm(k.reshape(B, L, WIN_KV_HEADS, WIN_HEAD_DIM), p['k_head_g'])
    v = v.reshape(B, L, WIN_KV_HEADS, WIN_HEAD_DIM)
    if ctx is None:
        o = block_attention(q, k, v, p['sink'])
    else:
        kc, vc = ctx
        o = window_attention(axial_rope(q, pos), axial_rope(k, pos), v, kc, vc, p['sink'])
    return (o.reshape(B, L, WIN_WIDTH) * jax.nn.silu(g)) @ p['w_out'], (k, v)


def ada_modulate(x, cond, w, b, g):
    mod = jax.nn.silu(cond) @ w + b
    shift, scale, gate = jnp.split(mod, 3, axis=-1)
    h = rms_norm(x, g) * (1.0 + scale[:, None, :]) + shift[:, None, :]
    return h, gate[:, None, :]


def setup_inputs(seed: int = 0) -> dict:
    key = jax.random.key(seed)
    ks = iter(jax.random.split(key, 48))

    def nrm(shape, scale):
        return scale * jax.random.normal(next(ks), shape, jnp.float32)

    D = D_MODEL
    inp = {}
    inp['x_prompt'] = nrm((BATCH, SEQ, D), 1.0)
    inp['x_sample'] = nrm((DEC_BATCH, DEC_SEQ, D), 1.0)
    for l in range(DEPTH):
        if l % 2 == 0:
            inp['cache_l%d_mla_ckv' % l] = nrm((DEC_BATCH, PAST_LEN, KV_LORA), 1.0)
            inp['cache_l%d_mla_krope' % l] = nrm((DEC_BATCH, PAST_LEN, MLA_ROPE), 1.0)
            inp['state_l%d_ret_fwd' % l] = nrm((DEC_BATCH, RET_HEADS, RET_DK, RET_DV), 1.0)
            inp['state_l%d_ret_bwd' % l] = nrm((DEC_BATCH, RET_HEADS, RET_DK, RET_DV), 1.0)
        else:
            inp['cache_l%d_win_k' % l] = nrm((DEC_BATCH, PAST_LEN, WIN_KV_HEADS, WIN_HEAD_DIM), 1.0)
            inp['cache_l%d_win_v' % l] = nrm((DEC_BATCH, PAST_LEN, WIN_KV_HEADS, WIN_HEAD_DIM), 1.0)
    inp['c'] = nrm((DEC_BATCH, D), 1.0)
    inp['c_ctx'] = nrm((D,), 1.0)
    inp['ada_w'] = nrm((DEPTH, D, 3 * D), 0.5 * D ** -0.5)
    inp['ada_b'] = nrm((DEPTH, 3 * D), 0.02)
    inp['norm_g'] = 1.0 + nrm((DEPTH, D), 0.02)
    inp['ab_w_in'] = nrm((N_EVEN, D, AB_IN), D ** -0.5)
    inp['mla_q_norm_g'] = 1.0 + nrm((N_EVEN, Q_LORA), 0.02)
    inp['mla_w_uq'] = nrm((N_EVEN, Q_LORA, MLA_HEADS * MLA_QK), Q_LORA ** -0.5)
    inp['mla_kv_norm_g'] = 1.0 + nrm((N_EVEN, KV_LORA), 0.02)
    inp['mla_w_ukv'] = nrm((N_EVEN, KV_LORA, MLA_HEADS * (MLA_NOPE + MLA_V)), KV_LORA ** -0.5)
    inp['mla_q_head_g'] = 1.0 + nrm((N_EVEN, MLA_QK), 0.02)
    inp['mla_k_head_g'] = 1.0 + nrm((N_EVEN, MLA_QK), 0.02)
    hh = np.arange(RET_HEADS)
    base = np.stack([np.log(-np.log(1.0 - 2.0 ** (-5.0 - hh))),
                     np.log(-np.log(1.0 - 2.0 ** (-5.5 - hh)))])
    inp['ret_decay'] = jnp.asarray(base, jnp.float32)[None] + nrm((N_EVEN, 2, RET_HEADS), 0.05)
    inp['ret_norm_g'] = 1.0 + nrm((N_EVEN, RET_WIDTH), 0.02)
    inp['ab_w_out'] = nrm((N_EVEN, MLA_WIDTH + RET_WIDTH, D), (MLA_WIDTH + RET_WIDTH) ** -0.5)
    inp['win_w_in'] = nrm((N_ODD, D, WIN_IN), D ** -0.5)
    inp['win_q_head_g'] = 1.0 + nrm((N_ODD, WIN_HEAD_DIM), 0.02)
    inp['win_k_head_g'] = 1.0 + nrm((N_ODD, WIN_HEAD_DIM), 0.02)
    inp['win_sink'] = nrm((N_ODD, WIN_HEADS), 0.5)
    inp['win_w_out'] = nrm((N_ODD, WIN_WIDTH, D), WIN_WIDTH ** -0.5)
    return inp


def reference(x_prompt, x_sample,
              cache_l0_mla_ckv, cache_l0_mla_krope, state_l0_ret_fwd, state_l0_ret_bwd,
              cache_l1_win_k, cache_l1_win_v,
              cache_l2_mla_ckv, cache_l2_mla_krope, state_l2_ret_fwd, state_l2_ret_bwd,
              cache_l3_win_k, cache_l3_win_v,
              c, c_ctx, ada_w, ada_b, norm_g,
              ab_w_in, mla_q_norm_g, mla_w_uq, mla_kv_norm_g, mla_w_ukv, mla_q_head_g, mla_k_head_g,
              ret_decay, ret_norm_g, ab_w_out,
              win_w_in, win_q_head_g, win_k_head_g, win_sink, win_w_out):
    pos = grid_positions(x_sample.shape[1])
    ctx_caches = ((cache_l0_mla_ckv, cache_l0_mla_krope, state_l0_ret_fwd, state_l0_ret_bwd),
                  (cache_l1_win_k, cache_l1_win_v),
                  (cache_l2_mla_ckv, cache_l2_mla_krope, state_l2_ret_fwd, state_l2_ret_bwd),
                  (cache_l3_win_k, cache_l3_win_v))
    cond_ctx = c_ctx[None, :]
    y_p, y_s = x_prompt, x_sample
    new_state = []
    for l in range(DEPTH):
        i = l // 2
        if l % 2 == 0:
            p = {'w_in': ab_w_in[i], 'q_norm_g': mla_q_norm_g[i], 'w_uq': mla_w_uq[i],
                 'kv_norm_g': mla_kv_norm_g[i], 'w_ukv': mla_w_ukv[i], 'q_head_g': mla_q_head_g[i],
                 'k_head_g': mla_k_head_g[i], 'decay': ret_decay[i], 'ret_norm_g': ret_norm_g[i],
                 'w_out': ab_w_out[i]}
            mixer = mixer_ab
        else:
            p = {'w_in': win_w_in[i], 'q_head_g': win_q_head_g[i], 'k_head_g': win_k_head_g[i],
                 'sink': win_sink[i], 'w_out': win_w_out[i]}
            mixer = mixer_win
        h_p, gate_p = ada_modulate(y_p, cond_ctx, ada_w[l], ada_b[l], norm_g[l])
        out_p, st = mixer(h_p, p, None, None)
        h_s, gate_s = ada_modulate(y_s, c, ada_w[l], ada_b[l], norm_g[l])
        out_s, _ = mixer(h_s, p, ctx_caches[l], pos)
        y_p = y_p + gate_p * out_p
        y_s = y_s + gate_s * out_s
        new_state.append(st)
    (l0_ckv, l0_krope, l0_rf, l0_rb), (l1_k, l1_v), (l2_ckv, l2_krope, l2_rf, l2_rb), (l3_k, l3_v) = new_state
    return (y_p, y_s, l0_ckv, l0_krope, l0_rf, l0_rb, l1_k, l1_v, l2_ckv, l2_krope, l2_rf, l2_rb, l3_k, l3_v)
```

```cpp
#include <hip/hip_runtime.h>
#include <cstdio>
#include <cstdint>

constexpr int DM = 1024;
constexpr int NP_ROWS = 32 * 256;
constexpr int NS_ROWS = 4 * 4096;
constexpr int MROWS = NP_ROWS + NS_ROWS;
constexpr int CTX_ROWS = 4 * 512;
constexpr int MROWS_X = MROWS + CTX_ROWS;
constexpr float EPS = 1e-6f;
constexpr float LOG2E = 1.4426950408889634f;
constexpr int AB_IN = 2720, WIN_IN = 2560;

enum { I_XP = 0, I_XS, I_C0CKV, I_C0KR, I_S0F, I_S0B, I_C1K, I_C1V, I_C2CKV, I_C2KR, I_S2F, I_S2B, I_C3K, I_C3V, I_C, I_CCTX, I_ADAW, I_ADAB, I_NORMG,
       I_ABWIN, I_QNG, I_WUQ, I_KVNG, I_WUKV, I_QHG, I_KHG, I_DECAY, I_RNG, I_ABWOUT, I_WWIN, I_WQHG, I_WKHG, I_SINK, I_WWOUT, N_INPUTS };

constexpr size_t O_Y = 0;
constexpr size_t O_L0CKV = (size_t)MROWS * DM;
constexpr size_t O_L0KR = O_L0CKV + (size_t)NP_ROWS * 256;
constexpr size_t O_L0RF = O_L0KR + (size_t)NP_ROWS * 32;
constexpr size_t O_L0RB = O_L0RF + (size_t)32 * 4 * 64 * 128;
constexpr size_t O_L1K = O_L0RB + (size_t)32 * 4 * 64 * 128;
constexpr size_t O_L1V = O_L1K + (size_t)NP_ROWS * 256;
constexpr size_t O_L2CKV = O_L1V + (size_t)NP_ROWS * 256;
constexpr size_t O_L2KR = O_L2CKV + (size_t)NP_ROWS * 256;
constexpr size_t O_L2RF = O_L2KR + (size_t)NP_ROWS * 32;
constexpr size_t O_L2RB = O_L2RF + (size_t)32 * 4 * 64 * 128;
constexpr size_t O_L3K = O_L2RB + (size_t)32 * 4 * 64 * 128;
constexpr size_t O_L3V = O_L3K + (size_t)NP_ROWS * 256;
constexpr size_t O_END = O_L3V + (size_t)NP_ROWS * 256;

constexpr size_t MiB = 1u << 20;
constexpr size_t WS_CTL = 0;
constexpr size_t WS_MOD = 1 * MiB;
constexpr size_t WS_GS = WS_MOD + 4 * 5 * 3072 * 4;
constexpr size_t WS_BIAS = WS_GS + 4 * 5 * 1024 * 4;
constexpr size_t WS_BIASL = WS_BIAS + 4 * 5 * 2816 * 4;
constexpr size_t WS_SS = WS_BIASL + 4 * 5 * 2816 * 4;
constexpr size_t WS_SSCQ = WS_SS + (size_t)MROWS * 16 * 4;
constexpr size_t WS_SSKR = WS_SSCQ + (size_t)MROWS * 2 * 4;
constexpr size_t WS_SSQN = WS_SSKR + (size_t)MROWS_X * 4;
constexpr size_t WS_SSQR = WS_SSQN + (size_t)MROWS * 8 * 4;
constexpr size_t WS_ROPE8 = WS_SSQR + (size_t)MROWS * 8 * 4;
constexpr size_t WS_ROPE16 = WS_ROPE8 + 64 * 8 * 2 * 4;
constexpr size_t WS_BND = WS_ROPE16 + 64 * 16 * 2 * 4;
constexpr size_t WS_MISC_END = WS_BND + 256;
static_assert(WS_MISC_END <= 6 * MiB, "misc region");
constexpr size_t WS_WIN = 6 * MiB;
constexpr size_t WS_WUQ = WS_WIN + (size_t)2816 * 1024 * 2;
constexpr size_t WS_WUKV = WS_WUQ + (size_t)768 * 384 * 2;
constexpr size_t WS_WOUT0 = WS_WUKV + (size_t)1024 * 256 * 2;
constexpr size_t WS_WOUT1 = WS_WOUT0 + (size_t)1024 * 1024 * 2;
constexpr size_t WS_W_END = WS_WOUT1 + (size_t)1024 * 1024 * 2;
static_assert(WS_W_END <= 17 * MiB, "weight region");
constexpr size_t WS_G = 17 * MiB;
constexpr size_t WS_X = WS_G + 48 * MiB;
constexpr size_t WS_RQ = WS_X, WS_RK = WS_X + 12 * MiB, WS_RV = WS_X + 24 * MiB, WS_QW = WS_X;
constexpr size_t WS_Q = WS_X + 48 * MiB;
constexpr size_t WS_QR = WS_Q, WS_CQ = WS_Q + 36 * MiB, WS_AODD = WS_Q;
constexpr size_t WS_URS = WS_CQ;
constexpr size_t WS_CKVN = WS_Q + 54 * MiB;
constexpr size_t WS_KR = WS_CKVN + 13 * MiB;
constexpr size_t WS_KV = WS_KR + (size_t)MROWS_X * 32 * 2;
constexpr size_t WS_KIMG = WS_KV, WS_VIMG = WS_KV + 39 * MiB, WS_AEVEN = WS_KV;
constexpr size_t WS_KWIMG = WS_KV + 39 * MiB, WS_VWIMG = WS_KV + 52 * MiB;
constexpr size_t WS_URP = WS_KV + 65 * MiB;
constexpr size_t WS_END = WS_URP + 8 * MiB;
static_assert(WS_END <= 256 * MiB, "workspace map exceeds 256 MiB");

typedef unsigned short bf16_t;

struct Params {
    const float* in[N_INPUTS];
    float* out;
    unsigned char* ws;
    int ph_lo, ph_hi;
};

__device__ __forceinline__ float bf2f(bf16_t b) { return __uint_as_float((unsigned)b << 16); }
__device__ __forceinline__ bf16_t f2bf(float f) { unsigned u = __float_as_uint(f); return (bf16_t)((u + 0x7fffu + ((u >> 16) & 1u)) >> 16); }
__device__ __forceinline__ float bfr(float f) { return bf2f(f2bf(f)); }
__device__ __forceinline__ float silu_f(float x) { return x / (1.f + __expf(-x)); }

__device__ __forceinline__ int p2d64(int p) { return 32 * ((p >> 3) & 1) + 16 * ((p >> 2) & 1) + 4 * (p >> 4) + (p & 3); }
__device__ __forceinline__ int d2p64(int d) { return 16 * ((d >> 2) & 3) + 8 * (d >> 5) + 4 * ((d >> 4) & 1) + (d & 3); }
__device__ __forceinline__ int o2j32(int o) { const int grp = o >> 3, w = o & 7; return 16 * (grp >> 1) + 4 * (grp & 1) + (w & 3) + 8 * (w >> 2); }
__device__ __forceinline__ int j2o32(int j) { return 8 * (2 * (j >> 4) + ((j >> 2) & 1)) + 4 * ((j >> 3) & 1) + (j & 3); }

struct RowInfo { int cond; int b; int t; bool sample; };
__device__ __forceinline__ RowInfo row_info(int row) {
    RowInfo r;
    if (row < NP_ROWS) { r.cond = 4; r.b = row >> 8; r.t = row & 255; r.sample = false; }
    else { const int rs = row - NP_ROWS; r.b = rs >> 12; r.t = rs & 4095; r.cond = r.b; r.sample = true; }
    return r;
}
__device__ __forceinline__ int kv_tile(int R, int head, int H, int& kin) {
    if (R < NP_ROWS) { const int b = R >> 8, key = R & 255; kin = key & 63; return (b * H + head) * 4 + (key >> 6); }
    int b, key;
    if (R < MROWS) { const int rs = R - NP_ROWS; b = rs >> 12; key = 512 + (rs & 4095); }
    else { const int rc = R - MROWS; b = rc >> 9; key = rc & 511; }
    kin = key & 63; return 32 * H * 4 + (b * H + head) * 72 + (key >> 6);
}
__device__ __forceinline__ int kv_seq_tile0(bool sample, int b, int head, int H) { return sample ? 32 * H * 4 + (b * H + head) * 72 : (b * H + head) * 4; }
#define NVF(name) __device__ void name(const Params& P, int layer, long gt, long gn)

__device__ __forceinline__ const float* cond_vec(const Params& P, int c) { return c < 4 ? P.in[I_C] + c * 1024 : P.in[I_CCTX]; }
__device__ __forceinline__ float* ws_f32(const Params& P, size_t off) { return (float*)(P.ws + off); }
__device__ __forceinline__ bf16_t* ws_bf(const Params& P, size_t off) { return (bf16_t*)(P.ws + off); }
__device__ __forceinline__ const float* y_row(const Params& P, int layer, int row) {
    if (layer == 0) return row < NP_ROWS ? P.in[I_XP] + (size_t)row * DM : P.in[I_XS] + (size_t)(row - NP_ROWS) * DM;
    return P.out + (size_t)row * DM;
}
__device__ __forceinline__ float log_gamma(const Params& P, int layer, int dir, int head) { return -__expf(P.in[I_DECAY][(layer >> 1) * 8 + dir * 4 + head]); }

NVF(nv_mod) {
    float* mod = ws_f32(P, WS_MOD);
    for (long i = gt; i < 4L * 5 * 3072; i += gn) {
        const int j = (int)(i % 3072), c = (int)((i / 3072) % 5), l = (int)(i / (3072 * 5));
        const float* cv = cond_vec(P, c); const float* w = P.in[I_ADAW] + (size_t)l * 1024 * 3072 + j;
        float s = 0.f;
        for (int k = 0; k < 1024; ++k) s += silu_f(cv[k]) * w[(size_t)k * 3072];
        mod[i] = s + P.in[I_ADAB][l * 3072 + j];
    }
    float* r8 = ws_f32(P, WS_ROPE8); float* r16 = ws_f32(P, WS_ROPE16);
    for (long i = gt; i < 64 * 8; i += gn) { const int pos = (int)(i >> 3), f = (int)(i & 7); const float inv = powf(10000.f, -(float)f / 8.f), a = (float)pos * inv; r8[2 * i] = cosf(a); r8[2 * i + 1] = sinf(a); }
    for (long i = gt; i < 64 * 16; i += gn) { const int pos = (int)(i >> 4), f = (int)(i & 15); const float inv = powf(10000.f, -(float)f / 16.f), a = (float)pos * inv; r16[2 * i] = cosf(a); r16[2 * i + 1] = sinf(a); }
}
NVF(nv_gs) {
    float* gs = ws_f32(P, WS_GS); const float* mod = ws_f32(P, WS_MOD);
    for (long i = gt; i < 4L * 5 * 1024; i += gn) { const int k = (int)(i & 1023), c = (int)((i >> 10) % 5), l = (int)(i / 5120); gs[i] = P.in[I_NORMG][l * 1024 + k] * (1.f + mod[(l * 5 + c) * 3072 + 1024 + k]); }
    if (gt == 0) {
        float* bnd = ws_f32(P, WS_BND);
        for (int i = 0; i < 2; ++i) {
            float mq = 0.f, mk = 0.f; for (int d = 0; d < 96; ++d) { mq = fmaxf(mq, fabsf(P.in[I_QHG][i * 96 + d])); mk = fmaxf(mk, fabsf(P.in[I_KHG][i * 96 + d])); }
            bnd[i] = sqrtf(96.f) * LOG2E * mq * mk;
        }
        for (int i = 0; i < 2; ++i) {
            float mq = 0.f, mk = 0.f; for (int d = 0; d < 64; ++d) { mq = fmaxf(mq, fabsf(P.in[I_WQHG][i * 64 + d])); mk = fmaxf(mk, fabsf(P.in[I_WKHG][i * 64 + d])); }
            bnd[8 + i] = mq; bnd[10 + i] = mk;
        }
    }
}
NVF(nv_bias) {
    float* bias = ws_f32(P, WS_BIAS); const float* mod = ws_f32(P, WS_MOD);
    for (long i = gt; i < 4L * 5 * 2816; i += gn) {
        const int col = (int)(i % 2816), c = (int)((i / 2816) % 5), l = (int)(i / (2816 * 5));
        const int N = (l & 1) ? WIN_IN : AB_IN; float s = 0.f;
        if (col < N) { const float* w = ((l & 1) ? P.in[I_WWIN] : P.in[I_ABWIN]) + (size_t)(l >> 1) * 1024 * N + col; const float* sh = mod + (l * 5 + c) * 3072;
            for (int k = 0; k < 1024; ++k) s += sh[k] * w[(size_t)k * N]; }
        bias[i] = s;
    }
}
NVF(nv_prepA) {
    bf16_t* A = ws_bf(P, (layer & 1) ? WS_AODD : WS_AEVEN); float* SS = ws_f32(P, WS_SS);
    const float* mod = ws_f32(P, WS_MOD);
    for (long row = gt; row < MROWS; row += gn) {
        const RowInfo ri = row_info((int)row); const float* y = y_row(P, layer, (int)row);
        const float* sc = mod + (layer * 5 + ri.cond) * 3072 + 1024; const float* g = P.in[I_NORMG] + layer * 1024;
        float s = 0.f;
        for (int k = 0; k < 1024; ++k) { const float v = y[k]; s += v * v; A[(size_t)row * 1024 + k] = f2bf(v * g[k] * (1.f + sc[k])); }
        SS[row * 16] = s; for (int j = 1; j < 16; ++j) SS[row * 16 + j] = 0.f;
    }
}
__device__ __forceinline__ float row_rstd(const float* SS, int row) { float s = 0.f; for (int j = 0; j < 16; ++j) s += SS[row * 16 + j]; return 1.0f / sqrtf(s * (1.f / 1024.f) + EPS); }

NVF(nv_in_even) {
    const bf16_t* A = ws_bf(P, WS_AEVEN); const float* SS = ws_f32(P, WS_SS); const float* W = P.in[I_ABWIN] + (size_t)(layer >> 1) * 1024 * AB_IN;
    const float* bias = ws_f32(P, WS_BIAS);
    bf16_t *CQ = ws_bf(P, WS_CQ), *CKVN = ws_bf(P, WS_CKVN), *KR = ws_bf(P, WS_KR), *G = ws_bf(P, WS_G), *RQ = ws_bf(P, WS_RQ), *RK = ws_bf(P, WS_RK), *RV = ws_bf(P, WS_RV);
    float* okr = P.out + (layer == 0 ? O_L0KR : O_L2KR);
    for (long i = gt; i < (long)(MROWS / 4) * AB_IN; i += gn) {
        const int col = (int)(i % AB_IN), r0 = (int)(i / AB_IN) * 4;
        float acc[4] = {0.f, 0.f, 0.f, 0.f};
        for (int k = 0; k < 1024; ++k) { const float w = bfr(W[(size_t)k * AB_IN + col]);
#pragma unroll
            for (int r = 0; r < 4; ++r) acc[r] += bf2f(A[(size_t)(r0 + r) * 1024 + k]) * w; }
#pragma unroll
        for (int r = 0; r < 4; ++r) {
            const int row = r0 + r; const RowInfo ri = row_info(row);
            const float v = acc[r] * row_rstd(SS, row) + bias[(layer * 5 + ri.cond) * 2816 + col];
            if (col < 384) CQ[(size_t)row * 384 + col] = f2bf(v);
            else if (col < 640) CKVN[(size_t)row * 256 + col - 384] = f2bf(v);
            else if (col < 672) { const int j = col - 640; KR[(size_t)row * 32 + j2o32(j)] = f2bf(v); if (!ri.sample) okr[(size_t)row * 32 + j] = v; }
            else if (col < 1184) G[(size_t)row * 1024 + col - 672] = f2bf(silu_f(v));
            else if (col < 1440) { const int x = col - 1184; RQ[(size_t)row * 256 + (x >> 6) * 64 + d2p64(x & 63)] = f2bf(v); }
            else if (col < 1696) { const int x = col - 1440; RK[(size_t)row * 256 + (x >> 6) * 64 + d2p64(x & 63)] = f2bf(v); }
            else if (col < 2208) RV[(size_t)row * 512 + col - 1696] = f2bf(v);
            else G[(size_t)row * 1024 + 512 + col - 2208] = f2bf(silu_f(v));
        }
    }
}
NVF(nv_post_even) {
    bf16_t *CQ = ws_bf(P, WS_CQ), *CKVN = ws_bf(P, WS_CKVN), *KR = ws_bf(P, WS_KR), *RQ = ws_bf(P, WS_RQ), *RK = ws_bf(P, WS_RK);
    float *sscq = ws_f32(P, WS_SSCQ), *sskr = ws_f32(P, WS_SSKR); const float* r16 = ws_f32(P, WS_ROPE16);
    const float* gkv = P.in[I_KVNG] + (layer >> 1) * 256; float* ockv = P.out + (layer == 0 ? O_L0CKV : O_L2CKV);
    for (long row = gt; row < MROWS; row += gn) {
        const RowInfo ri = row_info((int)row);
        float s = 0.f; for (int k = 0; k < 384; ++k) { const float v = bf2f(CQ[row * 384 + k]); s += v * v; }
        sscq[row * 2] = s; sscq[row * 2 + 1] = 0.f;
        s = 0.f; for (int k = 0; k < 32; ++k) { const float v = bf2f(KR[row * 32 + k]); s += v * v; }
        sskr[row] = s;
        s = 0.f; for (int k = 0; k < 256; ++k) { const float v = bf2f(CKVN[row * 256 + k]); s += v * v; }
        const float rs = 1.0f / sqrtf(s * (1.f / 256.f) + EPS);
        for (int k = 0; k < 256; ++k) { const float v = bf2f(CKVN[row * 256 + k]) * rs * gkv[k]; CKVN[row * 256 + k] = f2bf(v); if (!ri.sample) ockv[row * 256 + k] = v; }
        const int pr = ri.t >> 6, pc = ri.t & 63;
        for (int a = 0; a < 2; ++a) { bf16_t* X = a ? RK : RQ; const float scl = a ? 1.f : 0.125f;
            for (int h = 0; h < 4; ++h) for (int half = 0; half < 2; ++half) for (int f = 0; f < 16; ++f) {
                const int d1 = 32 * half + f, d2 = d1 + 16; bf16_t* p1 = X + row * 256 + h * 64 + d2p64(d1); bf16_t* p2 = X + row * 256 + h * 64 + d2p64(d2);
                float x1 = bf2f(*p1) * scl, x2 = bf2f(*p2) * scl;
                if (ri.sample) { const int pos = half ? pc : pr; const float c = r16[(pos * 16 + f) * 2], sn = r16[(pos * 16 + f) * 2 + 1]; const float y1 = x1 * c - x2 * sn, y2 = x1 * sn + x2 * c; x1 = y1; x2 = y2; }
                *p1 = f2bf(x1); *p2 = f2bf(x2); } }
    }
}
NVF(nv_ctx_even) {
    const float* cckv = P.in[layer == 0 ? I_C0CKV : I_C2CKV]; const float* ckr = P.in[layer == 0 ? I_C0KR : I_C2KR];
    bf16_t *CKVN = ws_bf(P, WS_CKVN), *KR = ws_bf(P, WS_KR); float* sskr = ws_f32(P, WS_SSKR);
    for (long i = gt; i < (long)CTX_ROWS * 256; i += gn) CKVN[(size_t)MROWS * 256 + i] = f2bf(cckv[i]);
    for (long rc = gt; rc < CTX_ROWS; rc += gn) { float s = 0.f;
        for (int j = 0; j < 32; ++j) { const bf16_t v = f2bf(ckr[rc * 32 + j]); KR[(size_t)(MROWS + rc) * 32 + j2o32(j)] = v; s += bf2f(v) * bf2f(v); }
        sskr[MROWS + rc] = s; }
}
NVF(nv_uq) {
    const bf16_t* CQ = ws_bf(P, WS_CQ); bf16_t* QR = ws_bf(P, WS_QR); const float* W = P.in[I_WUQ] + (size_t)(layer >> 1) * 384 * 768; const float* gq = P.in[I_QNG] + (layer >> 1) * 384;
    for (long i = gt; i < (long)MROWS * 768; i += gn) {
        const int sp = (int)(i % 96), head = (int)((i / 96) & 7); const long row = i / 768;
        const int dd = sp < 64 ? sp : 64 + o2j32(sp - 64), col = head * 96 + dd; float z = 0.f;
        for (int k = 0; k < 384; ++k) z += bf2f(CQ[row * 384 + k]) * bfr(gq[k] * W[(size_t)k * 768 + col]);
        QR[i] = f2bf(z);
    }
}
NVF(nv_uq_ss) {
    const bf16_t* QR = ws_bf(P, WS_QR); const float* sscq = ws_f32(P, WS_SSCQ); float *ssqn = ws_f32(P, WS_SSQN), *ssqr = ws_f32(P, WS_SSQR);
    for (long i = gt; i < (long)MROWS * 8; i += gn) { const long row = i >> 3; float a = 0.f, b = 0.f;
        for (int s = 0; s < 64; ++s) { const float v = bf2f(QR[i * 96 + s]); a += v * v; }
        for (int s = 64; s < 96; ++s) { const float v = bf2f(QR[i * 96 + s]); b += v * v; }
        ssqn[i] = a + 96.f * EPS * ((sscq[row * 2] + sscq[row * 2 + 1]) * (1.f / 384.f) + EPS); ssqr[i] = b; }
}
NVF(nv_ukv) {
    const bf16_t* CKVN = ws_bf(P, WS_CKVN); const float* W = P.in[I_WUKV] + (size_t)(layer >> 1) * 256 * 1024;
    unsigned char* KI = P.ws + WS_KIMG; unsigned char* VI = P.ws + WS_VIMG;
    for (long i = gt; i < (long)MROWS_X * 1024; i += gn) {
        const int feat = (int)(i & 1023), head = feat >> 7, r = feat & 127; const int R = (int)(i >> 10); float v = 0.f;
        for (int k = 0; k < 256; ++k) v += bf2f(CKVN[(size_t)R * 256 + k]) * bfr(W[(size_t)k * 1024 + feat]);
        int kin; const int tile = kv_tile(R, head, 8, kin);
        if (r < 64) *(bf16_t*)(KI + (size_t)tile * 12288 + (r >> 3) * 1024 + kin * 16 + (r & 7) * 2) = f2bf(v);
        else { const int dv = r - 64; *(bf16_t*)(VI + (size_t)tile * 8192 + (dv >> 5) * 4096 + kin * 64 + (dv & 31) * 2) = f2bf(v); }
    }
}
NVF(nv_k_post) {
    const bf16_t* KR = ws_bf(P, WS_KR); const float* sskr = ws_f32(P, WS_SSKR); const float* gk = P.in[I_KHG] + (layer >> 1) * 96; const float* r8 = ws_f32(P, WS_ROPE8);
    unsigned char* KI = P.ws + WS_KIMG;
    for (long i = gt; i < (long)MROWS_X * 8; i += gn) {
        const int R = (int)(i >> 3), head = (int)(i & 7); int kin; const int tile = kv_tile(R, head, 8, kin);
        unsigned char* base = KI + (size_t)tile * 12288 + kin * 16;
        float s = sskr[R];
        for (int d = 0; d < 64; ++d) { const float v = bf2f(*(bf16_t*)(base + (d >> 3) * 1024 + (d & 7) * 2)); s += v * v; }
        const float rs = 1.0f / sqrtf(s * (1.f / 96.f) + EPS);
        for (int d = 0; d < 64; ++d) { bf16_t* p = (bf16_t*)(base + (d >> 3) * 1024 + (d & 7) * 2); *p = f2bf(bf2f(*p) * rs * gk[d]); }
        const bool lat = (R >= NP_ROWS && R < MROWS); const int t = (R - NP_ROWS) & 4095, pr = t >> 6, pc = t & 63;
        for (int half = 0; half < 2; ++half) for (int f = 0; f < 8; ++f) {
            const int j1 = 16 * half + f, j2 = j1 + 8; const int o1 = j2o32(j1), o2 = j2o32(j2);
            float x1 = bf2f(KR[(size_t)R * 32 + o1]) * rs * gk[64 + j1], x2 = bf2f(KR[(size_t)R * 32 + o2]) * rs * gk[64 + j2];
            if (lat) { const int pos = half ? pc : pr; const float c = r8[(pos * 8 + f) * 2], sn = r8[(pos * 8 + f) * 2 + 1]; const float y1 = x1 * c - x2 * sn, y2 = x1 * sn + x2 * c; x1 = y1; x2 = y2; }
            *(bf16_t*)(base + ((64 + o1) >> 3) * 1024 + (o1 & 7) * 2) = f2bf(x1); *(bf16_t*)(base + ((64 + o2) >> 3) * 1024 + (o2 & 7) * 2) = f2bf(x2); }
    }
}
__device__ __forceinline__ int chunk_row0(int c) { return c < 64 ? (c >> 1) * 256 + (c & 1) * 128 : NP_ROWS + ((c - 64) >> 5) * 4096 + ((c - 64) & 31) * 128; }
__device__ __forceinline__ unsigned char* ur_ptr(const Params& P, int c, int head, int dir) { return c < 64 ? P.ws + WS_URP + (size_t)((c * 4 + head) * 2 + dir) * 16384 : P.ws + WS_URS + (size_t)(((c - 64) * 4 + head) * 2 + dir) * 16384; }
__device__ __forceinline__ size_t ur_el(int p, int dv) { return (size_t)(dv >> 5) * 4096 + p * 64 + (dv & 31) * 2; }
NVF(nv_u) {
    const bf16_t *RK = ws_bf(P, WS_RK), *RV = ws_bf(P, WS_RV);
    for (long i = gt; i < 192L * 4 * 2 * 8192; i += gn) {
        const int dv = (int)(i & 127), p = (int)((i >> 7) & 63), dir = (int)((i >> 13) & 1), head = (int)((i >> 14) & 3), c = (int)(i >> 16);
        const float lg = log_gamma(P, layer, dir, head); const int r0 = chunk_row0(c); float s = 0.f;
        for (int t = 0; t < 128; ++t) { const float w = __expf(lg * (float)(dir ? t : 127 - t)); s += bfr(bf2f(RK[(size_t)(r0 + t) * 256 + head * 64 + p]) * w) * bf2f(RV[(size_t)(r0 + t) * 512 + head * 128 + dv]); }
        *(bf16_t*)(ur_ptr(P, c, head, dir) + ur_el(p, dv)) = f2bf(s);
    }
}
NVF(nv_scan) {
    float* orf = P.out + (layer == 0 ? O_L0RF : O_L2RF); float* orb = P.out + (layer == 0 ? O_L0RB : O_L2RB);
    const float* s0f = P.in[layer == 0 ? I_S0F : I_S2F]; const float* s0b = P.in[layer == 0 ? I_S0B : I_S2B];
    for (long i = gt; i < 36L * 4 * 2 * 8192; i += gn) {
        const int dv = (int)(i & 127), p = (int)((i >> 7) & 63), dir = (int)((i >> 13) & 1), head = (int)((i >> 14) & 3), seq = (int)(i >> 16);
        const float gC = __expf(128.f * log_gamma(P, layer, dir, head)); const size_t el = ur_el(p, dv); const int d = p2d64(p);
        if (seq < 32) {
            bf16_t* u0 = (bf16_t*)(ur_ptr(P, 2 * seq, head, dir) + el); bf16_t* u1 = (bf16_t*)(ur_ptr(P, 2 * seq + 1, head, dir) + el);
            const float a = bf2f(*u0), b = bf2f(*u1);
            if (dir == 0) { orf[((size_t)(seq * 4 + head) * 64 + d) * 128 + dv] = gC * a + b; *u0 = 0; *u1 = f2bf(a); }
            else { orb[((size_t)(seq * 4 + head) * 64 + d) * 128 + dv] = gC * b + a; *u1 = 0; *u0 = f2bf(b); }
        } else {
            const int b = seq - 32; float R = (dir ? s0b : s0f)[((size_t)(b * 4 + head) * 64 + d) * 128 + dv];
            for (int n = 0; n < 32; ++n) { const int c = 64 + b * 32 + (dir ? 31 - n : n); bf16_t* u = (bf16_t*)(ur_ptr(P, c, head, dir) + el); const float uv = bf2f(*u); *u = f2bf(R); R = gC * R + uv; }
        }
    }
}
__device__ __forceinline__ float wave_sum(float v) {
#pragma unroll
    for (int o = 1; o < 64; o <<= 1) v += __shfl_xor(v, o);
    return v;
}
__device__ __forceinline__ float mla_q_at(const Params& P, int layer, int row, int head, int s) {
    const bf16_t* QR = ws_bf(P, WS_QR) + ((size_t)row * 8 + head) * 96; const float* gq = P.in[I_QHG] + (layer >> 1) * 96; const float* r8 = ws_f32(P, WS_ROPE8);
    const float ss = ws_f32(P, WS_SSQN)[row * 8 + head] + ws_f32(P, WS_SSQR)[row * 8 + head]; const float rs = 1.0f / sqrtf(ss * (1.f / 96.f));
    const float qs = 0.10206207261596575f * LOG2E;
    if (s < 64) return bfr(bf2f(QR[s]) * rs * gq[s] * qs);
    const RowInfo ri = row_info(row);
    const int j = o2j32(s - 64), j1 = j & ~8, j2 = j1 + 8, half = j >> 4, f = j & 7;
    const float x1 = bf2f(QR[64 + j2o32(j1)]) * rs * gq[64 + j1], x2 = bf2f(QR[64 + j2o32(j2)]) * rs * gq[64 + j2];
    float c = 1.f, sn = 0.f;
    if (ri.sample) { const int pos = half ? (ri.t & 63) : (ri.t >> 6); c = r8[(pos * 8 + f) * 2]; sn = r8[(pos * 8 + f) * 2 + 1]; }
    const float y = (j & 8) ? (x1 * sn + x2 * c) : (x1 * c - x2 * sn);
    return bfr(y * qs);
}
NVF(nv_mla_attn) {
    const unsigned char* KI = P.ws + WS_KIMG; const unsigned char* VI = P.ws + WS_VIMG; bf16_t* G = ws_bf(P, WS_G); const float bnd = ws_f32(P, WS_BND)[layer >> 1];
    const int lane = (int)(gt & 63);
    for (long it = gt >> 6; it < (long)MROWS * 8; it += gn >> 6) {
        const int row = (int)(it % MROWS), head = (int)(it / MROWS); const RowInfo ri = row_info(row);
        const float q0 = mla_q_at(P, layer, row, head, lane), q1 = lane < 32 ? mla_q_at(P, layer, row, head, 64 + lane) : 0.f;
        float o = 0.f, l = 0.f;
        const int t0 = kv_seq_tile0(ri.sample, ri.b, head, 8), nk = ri.sample ? 4608 : 256;
        for (int key = 0; key < nk; ++key) {
            const unsigned char* kb = KI + (size_t)(t0 + (key >> 6)) * 12288 + (key & 63) * 16; const unsigned char* vb = VI + (size_t)(t0 + (key >> 6)) * 8192 + (key & 63) * 64;
            float s = q0 * bf2f(*(const bf16_t*)(kb + (lane >> 3) * 1024 + (lane & 7) * 2));
            if (lane < 32) s += q1 * bf2f(*(const bf16_t*)(kb + ((64 + lane) >> 3) * 1024 + (lane & 7) * 2));
            s = wave_sum(s);
            const float p = exp2f(s - bnd); l += p;
            o += bfr(p) * bf2f(*(const bf16_t*)(vb + (lane >> 5) * 4096 + (lane & 31) * 2));
        }
        bf16_t* g = G + (size_t)row * 1024 + head * 64 + lane; *g = f2bf(o / l * bf2f(*g));
    }
}
NVF(nv_ret_out) {
    const bf16_t *RQ = ws_bf(P, WS_RQ), *RK = ws_bf(P, WS_RK), *RV = ws_bf(P, WS_RV); bf16_t* G = ws_bf(P, WS_G); const float* gn_ = P.in[I_RNG] + (layer >> 1) * 512;
    const int lane = (int)(gt & 63);
    for (long it = gt >> 6; it < (long)MROWS * 4; it += gn >> 6) {
        const int row = (int)(it % MROWS), head = (int)(it / MROWS);
        const int c = row < NP_ROWS ? row >> 7 : 64 + ((row - NP_ROWS) >> 7); const int ii = row & 127, r0 = chunk_row0(c);
        const float lgf = log_gamma(P, layer, 0, head), lgb = log_gamma(P, layer, 1, head);
        const float ql = bf2f(RQ[(size_t)row * 256 + head * 64 + lane]);
        float o0 = 0.f, o1 = 0.f;
        for (int j = 0; j < 128; ++j) {
            const float s = wave_sum(ql * bf2f(RK[(size_t)(r0 + j) * 256 + head * 64 + lane]));
            const float D = j < ii ? __expf(lgf * (float)(ii - j)) : (j > ii ? __expf(lgb * (float)(j - ii)) : 2.f);
            const float pb = bfr(s * D);
            o0 += pb * bf2f(RV[(size_t)(r0 + j) * 512 + head * 128 + lane]); o1 += pb * bf2f(RV[(size_t)(r0 + j) * 512 + head * 128 + 64 + lane]);
        }
        const float wf = __expf(lgf * (float)(ii + 1)), wb = __expf(lgb * (float)(128 - ii));
        const unsigned char* Rf = ur_ptr(P, c, head, 0); const unsigned char* Rb = ur_ptr(P, c, head, 1);
        for (int p = 0; p < 64; ++p) { const float qp = bf2f(RQ[(size_t)row * 256 + head * 64 + p]); const float qf = bfr(qp * wf), qb = bfr(qp * wb);
            o0 += qf * bf2f(*(const bf16_t*)(Rf + ur_el(p, lane))) + qb * bf2f(*(const bf16_t*)(Rb + ur_el(p, lane)));
            o1 += qf * bf2f(*(const bf16_t*)(Rf + ur_el(p, 64 + lane))) + qb * bf2f(*(const bf16_t*)(Rb + ur_el(p, 64 + lane))); }
        const float mu = wave_sum(o0 + o1) * (1.f / 128.f);
        const float d0 = o0 - mu, d1 = o1 - mu; const float var = wave_sum(d0 * d0 + d1 * d1) * (1.f / 128.f);
        const float rs = 1.0f / sqrtf(var + EPS);
        bf16_t* g = G + (size_t)row * 1024 + 512 + head * 128 + lane;
        g[0] = f2bf(d0 * rs * gn_[head * 128 + lane] * bf2f(g[0])); g[64] = f2bf(d1 * rs * gn_[head * 128 + 64 + lane] * bf2f(g[64]));
    }
}
NVF(nv_out) {
    const bf16_t* G = ws_bf(P, WS_G); const float* W = ((layer & 1) ? P.in[I_WWOUT] : P.in[I_ABWOUT]) + (size_t)(layer >> 1) * 1024 * 1024; const float* mod = ws_f32(P, WS_MOD);
    for (long i = gt; i < (long)(MROWS / 4) * 1024; i += gn) {
        const int col = (int)(i & 1023), r0 = (int)(i >> 10) * 4; float acc[4] = {0.f, 0.f, 0.f, 0.f};
        for (int k = 0; k < 1024; ++k) { const float w = bfr(W[(size_t)k * 1024 + col]);
#pragma unroll
            for (int r = 0; r < 4; ++r) acc[r] += bf2f(G[(size_t)(r0 + r) * 1024 + k]) * w; }
#pragma unroll
        for (int r = 0; r < 4; ++r) { const int row = r0 + r; const RowInfo ri = row_info(row);
            P.out[(size_t)row * 1024 + col] = y_row(P, layer, row)[col] + mod[(layer * 5 + ri.cond) * 3072 + 2048 + col] * acc[r]; }
    }
}
NVF(nv_in_odd) {
    const bf16_t* A = ws_bf(P, WS_AODD); const float* SS = ws_f32(P, WS_SS); const float* W = P.in[I_WWIN] + (size_t)(layer >> 1) * 1024 * WIN_IN; const float* bias = ws_f32(P, WS_BIAS);
    bf16_t *QW = ws_bf(P, WS_QW), *G = ws_bf(P, WS_G); unsigned char* KI = P.ws + WS_KWIMG; unsigned char* VI = P.ws + WS_VWIMG; float* ov = P.out + (layer == 1 ? O_L1V : O_L3V);
    for (long i = gt; i < (long)(MROWS / 4) * WIN_IN; i += gn) {
        const int col = (int)(i % WIN_IN), r0 = (int)(i / WIN_IN) * 4; float acc[4] = {0.f, 0.f, 0.f, 0.f};
        for (int k = 0; k < 1024; ++k) { const float w = bfr(W[(size_t)k * WIN_IN + col]);
#pragma unroll
            for (int r = 0; r < 4; ++r) acc[r] += bf2f(A[(size_t)(r0 + r) * 1024 + k]) * w; }
#pragma unroll
        for (int r = 0; r < 4; ++r) { const int row = r0 + r; const RowInfo ri = row_info(row);
            const float v = acc[r] * row_rstd(SS, row) + bias[(layer * 5 + ri.cond) * 2816 + col];
            if (col < 1024) QW[(size_t)row * 1024 + (col >> 6) * 64 + d2p64(col & 63)] = f2bf(v);
            else if (col < 1280) { const int x = col - 1024, kvh = x >> 6, p = d2p64(x & 63); int kin; const int tile = kv_tile(row, kvh, 4, kin); *(bf16_t*)(KI + (size_t)tile * 8192 + (p >> 3) * 1024 + kin * 16 + (p & 7) * 2) = f2bf(v); }
            else if (col < 1536) { const int x = col - 1280, kvh = x >> 6, dv = x & 63; int kin; const int tile = kv_tile(row, kvh, 4, kin); *(bf16_t*)(VI + (size_t)tile * 8192 + (dv >> 5) * 4096 + kin * 64 + (dv & 31) * 2) = f2bf(v); if (!ri.sample) ov[(size_t)row * 256 + x] = v; }
            else G[(size_t)row * 1024 + col - 1536] = f2bf(silu_f(v)); }
    }
}
NVF(nv_post_odd) {
    bf16_t* QW = ws_bf(P, WS_QW); unsigned char* KI = P.ws + WS_KWIMG; const float* r16 = ws_f32(P, WS_ROPE16); float* ok = P.out + (layer == 1 ? O_L1K : O_L3K);
    const float* gq = P.in[I_WQHG] + (layer >> 1) * 64; const float* gk = P.in[I_WKHG] + (layer >> 1) * 64;
    const int d = (int)(gt & 63), p = d2p64(d);
    for (long it = gt >> 6; it < (long)MROWS * 20; it += gn >> 6) {
        const int row = (int)(it / 20), hh = (int)(it % 20); const RowInfo ri = row_info(row); const bool isq = hh < 16; const int kvh = hh - 16;
        int kin = 0, tile = 0; if (!isq) tile = kv_tile(row, kvh, 4, kin);
        bf16_t* ptr = isq ? QW + (size_t)row * 1024 + hh * 64 + p : (bf16_t*)(KI + (size_t)tile * 8192 + (p >> 3) * 1024 + kin * 16 + (p & 7) * 2);
        float x = bf2f(*ptr);
        const float rs = 1.0f / sqrtf(wave_sum(x * x) * (1.f / 64.f) + EPS);
        x *= rs * (isq ? gq[d] : gk[d]);
        if (!isq && !ri.sample) ok[(size_t)row * 256 + kvh * 64 + d] = x;
        const float xp = __shfl_xor(x, 16);
        if (ri.sample) { const int half = d >> 5, f = d & 15; const int pos = half ? (ri.t & 63) : (ri.t >> 6);
            const float c = r16[(pos * 16 + f) * 2], sn = r16[(pos * 16 + f) * 2 + 1];
            x = (d & 16) ? (xp * sn + x * c) : (x * c - xp * sn); }
        *ptr = f2bf(isq ? x * 0.125f * LOG2E : x);
    }
}
NVF(nv_ctx_odd) {
    const float* ck = P.in[layer == 1 ? I_C1K : I_C3K]; const float* cv = P.in[layer == 1 ? I_C1V : I_C3V]; unsigned char* KI = P.ws + WS_KWIMG; unsigned char* VI = P.ws + WS_VWIMG;
    unsigned* bmax = (unsigned*)ws_f32(P, WS_BND) + 4 + (layer >> 1);
    for (long i = gt; i < (long)CTX_ROWS * 4; i += gn) { const int rc = (int)(i >> 2), kvh = (int)(i & 3); int kin; const int tile = kv_tile(MROWS + rc, kvh, 4, kin); float s = 0.f;
        for (int d = 0; d < 64; ++d) { const int p = d2p64(d); const bf16_t kb = f2bf(ck[(size_t)rc * 256 + kvh * 64 + d]); s += bf2f(kb) * bf2f(kb);
            *(bf16_t*)(KI + (size_t)tile * 8192 + (p >> 3) * 1024 + kin * 16 + (p & 7) * 2) = kb;
            *(bf16_t*)(VI + (size_t)tile * 8192 + (d >> 5) * 4096 + kin * 64 + (d & 31) * 2) = f2bf(cv[(size_t)rc * 256 + kvh * 64 + d]); }
        atomicMax(bmax, __float_as_uint(s)); }
}
NVF(nv_win_attn) {
    const bf16_t* QW = ws_bf(P, WS_QW); const unsigned char* KI = P.ws + WS_KWIMG; const unsigned char* VI = P.ws + WS_VWIMG; bf16_t* G = ws_bf(P, WS_G);
    const float* bf = ws_f32(P, WS_BND); const int li = layer >> 1;
    const float knorm = fmaxf(8.f * bf[10 + li], sqrtf(bf[4 + li])); const float bnd = 0.125f * LOG2E * 8.f * bf[8 + li] * knorm;
    const int lane = (int)(gt & 63);
    for (long it = gt >> 6; it < (long)MROWS * 16; it += gn >> 6) {
        const int row = (int)(it % MROWS), head = (int)(it / MROWS), kvh = head >> 2; const RowInfo ri = row_info(row);
        const float ql = bf2f(QW[(size_t)row * 1024 + head * 64 + lane]);
        float o = 0.f, l = exp2f(P.in[I_SINK][li * 16 + head] * LOG2E - bnd);
        const int t0 = kv_seq_tile0(ri.sample, ri.b, kvh, 4);
        int klo = 0, khi = 256, k2lo = 0, k2hi = 0;
        if (ri.sample) { klo = 0; khi = 512; k2lo = 512 + max(0, ri.t - 128); k2hi = 512 + min(4095, ri.t + 128) + 1; }
        for (int seg = 0; seg < 2; ++seg) { const int a = seg ? k2lo : klo, b = seg ? k2hi : khi;
            for (int key = a; key < b; ++key) {
                const unsigned char* kb = KI + (size_t)(t0 + (key >> 6)) * 8192 + (key & 63) * 16; const unsigned char* vb = VI + (size_t)(t0 + (key >> 6)) * 8192 + (key & 63) * 64;
                const float s = wave_sum(ql * bf2f(*(const bf16_t*)(kb + (lane >> 3) * 1024 + (lane & 7) * 2)));
                const float pp = exp2f(s - bnd); l += pp;
                o += bfr(pp) * bf2f(*(const bf16_t*)(vb + (lane >> 5) * 4096 + (lane & 31) * 2)); } }
        bf16_t* g = G + (size_t)row * 1024 + head * 64 + lane; *g = f2bf(o / l * bf2f(*g));
    }
}
NVF(nv_zero_bnd) { if (gt < 64) ws_f32(P, WS_BND)[gt] = 0.f; }

enum { ST_ZERO = 0, ST_MOD, ST_GS, ST_BIAS, ST_PREPA, ST_IN_EVEN, ST_POST_EVEN, ST_CTX_EVEN, ST_UQ, ST_UQ_SS, ST_UKV, ST_K_POST, ST_U, ST_SCAN, ST_MLA, ST_RET, ST_OUT, ST_IN_ODD, ST_POST_ODD, ST_CTX_ODD, ST_WIN };
__global__ void __launch_bounds__(256) nv_kernel(Params P, int stage, int layer) {
    const long gt = (long)blockIdx.x * blockDim.x + threadIdx.x, gn = (long)gridDim.x * blockDim.x;
    switch (stage) {
        case ST_ZERO: nv_zero_bnd(P, layer, gt, gn); break;
        case ST_MOD: nv_mod(P, layer, gt, gn); break;
        case ST_GS: nv_gs(P, layer, gt, gn); break;
        case ST_BIAS: nv_bias(P, layer, gt, gn); break;
        case ST_PREPA: nv_prepA(P, layer, gt, gn); break;
        case ST_IN_EVEN: nv_in_even(P, layer, gt, gn); break;
        case ST_POST_EVEN: nv_post_even(P, layer, gt, gn); break;
        case ST_CTX_EVEN: nv_ctx_even(P, layer, gt, gn); break;
        case ST_UQ: nv_uq(P, layer, gt, gn); break;
        case ST_UQ_SS: nv_uq_ss(P, layer, gt, gn); break;
        case ST_UKV: nv_ukv(P, layer, gt, gn); break;
        case ST_K_POST: nv_k_post(P, layer, gt, gn); break;
        case ST_U: nv_u(P, layer, gt, gn); break;
        case ST_SCAN: nv_scan(P, layer, gt, gn); break;
        case ST_MLA: nv_mla_attn(P, layer, gt, gn); break;
        case ST_RET: nv_ret_out(P, layer, gt, gn); break;
        case ST_OUT: nv_out(P, layer, gt, gn); break;
        case ST_IN_ODD: nv_in_odd(P, layer, gt, gn); break;
        case ST_POST_ODD: nv_post_odd(P, layer, gt, gn); break;
        case ST_CTX_ODD: nv_ctx_odd(P, layer, gt, gn); break;
        case ST_WIN: nv_win_attn(P, layer, gt, gn); break;
    }
}
extern "C" void kernel_launch(void* const* d_in, const int* in_sizes, int n_in, void* d_out, int out_size, void* d_ws, size_t ws_size, hipStream_t stream) {
    if (n_in != N_INPUTS || ws_size < WS_END || (size_t)out_size != O_END) { fprintf(stderr, "kernel_launch: unexpected shapes (n_in %d, out %d, ws %zu)\n", n_in, out_size, ws_size); return; }
    Params P{};
    for (int i = 0; i < N_INPUTS; ++i) P.in[i] = (const float*)d_in[i];
    P.out = (float*)d_out; P.ws = (unsigned char*)d_ws; P.ph_lo = 0; P.ph_hi = 0;
    auto L = [&](int stage, int layer, int blocks) { hipLaunchKernelGGL(nv_kernel, dim3(blocks), dim3(256), 0, stream, P, stage, layer); };
    const int BIG = 4096;
    L(ST_ZERO, 0, 1); L(ST_MOD, 0, 240); L(ST_GS, 0, 80); L(ST_BIAS, 0, 220);
    for (int l = 0; l < 4; ++l) {
        L(ST_PREPA, l, 96);
        if ((l & 1) == 0) {
            L(ST_CTX_EVEN, l, 512); L(ST_IN_EVEN, l, BIG); L(ST_POST_EVEN, l, 96); L(ST_UQ, l, BIG); L(ST_UQ_SS, l, 768); L(ST_UKV, l, BIG); L(ST_K_POST, l, 832);
            L(ST_U, l, BIG); L(ST_SCAN, l, BIG); L(ST_MLA, l, BIG); L(ST_RET, l, BIG); L(ST_OUT, l, BIG);
        } else {
            L(ST_CTX_ODD, l, 32); L(ST_IN_ODD, l, BIG); L(ST_POST_ODD, l, BIG); L(ST_WIN, l, BIG); L(ST_OUT, l, BIG);
        }
    }
}
```

```cpp
#include <hip/hip_runtime.h>
#include <cstdio>
#include <cstdint>

constexpr int DM = 1024;
constexpr int NP_ROWS = 32 * 256;
constexpr int NS_ROWS = 4 * 4096;
constexpr int MROWS = NP_ROWS + NS_ROWS;
constexpr int CTX_ROWS = 4 * 512;
constexpr int MROWS_X = MROWS + CTX_ROWS;
constexpr float EPS = 1e-6f;
constexpr float LOG2E = 1.4426950408889634f;
constexpr int AB_IN = 2720, WIN_IN = 2560;

enum { I_XP = 0, I_XS, I_C0CKV, I_C0KR, I_S0F, I_S0B, I_C1K, I_C1V, I_C2CKV, I_C2KR, I_S2F, I_S2B, I_C3K, I_C3V, I_C, I_CCTX, I_ADAW, I_ADAB, I_NORMG,
       I_ABWIN, I_QNG, I_WUQ, I_KVNG, I_WUKV, I_QHG, I_KHG, I_DECAY, I_RNG, I_ABWOUT, I_WWIN, I_WQHG, I_WKHG, I_SINK, I_WWOUT, N_INPUTS };

constexpr size_t O_Y = 0;
constexpr size_t O_L0CKV = (size_t)MROWS * DM;
constexpr size_t O_L0KR = O_L0CKV + (size_t)NP_ROWS * 256;
constexpr size_t O_L0RF = O_L0KR + (size_t)NP_ROWS * 32;
constexpr size_t O_L0RB = O_L0RF + (size_t)32 * 4 * 64 * 128;
constexpr size_t O_L1K = O_L0RB + (size_t)32 * 4 * 64 * 128;
constexpr size_t O_L1V = O_L1K + (size_t)NP_ROWS * 256;
constexpr size_t O_L2CKV = O_L1V + (size_t)NP_ROWS * 256;
constexpr size_t O_L2KR = O_L2CKV + (size_t)NP_ROWS * 256;
constexpr size_t O_L2RF = O_L2KR + (size_t)NP_ROWS * 32;
constexpr size_t O_L2RB = O_L2RF + (size_t)32 * 4 * 64 * 128;
constexpr size_t O_L3K = O_L2RB + (size_t)32 * 4 * 64 * 128;
constexpr size_t O_L3V = O_L3K + (size_t)NP_ROWS * 256;
constexpr size_t O_END = O_L3V + (size_t)NP_ROWS * 256;

constexpr size_t MiB = 1u << 20;
constexpr size_t WS_CTL = 0;
constexpr size_t WS_MOD = 1 * MiB;
constexpr size_t WS_GS = WS_MOD + 4 * 5 * 3072 * 4;
constexpr size_t WS_BIAS = WS_GS + 4 * 5 * 1024 * 4;
constexpr size_t WS_BIASL = WS_BIAS + 4 * 5 * 2816 * 4;
constexpr size_t WS_SS = WS_BIASL + 4 * 5 * 2816 * 4;
constexpr size_t WS_SSCQ = WS_SS + (size_t)MROWS * 16 * 4;
constexpr size_t WS_SSKR = WS_SSCQ + (size_t)MROWS * 8 * 4;
constexpr size_t WS_SSQN = WS_SSKR + (size_t)MROWS_X * 4;
constexpr size_t WS_SSQR = WS_SSQN + (size_t)MROWS * 8 * 4;
constexpr size_t WS_ROPE8 = WS_SSQR + (size_t)MROWS * 8 * 4;
constexpr size_t WS_ROPE16 = WS_ROPE8 + 64 * 8 * 2 * 4;
constexpr size_t WS_BND = WS_ROPE16 + 64 * 16 * 2 * 4;
constexpr size_t WS_MISC_END = WS_BND + 256;
static_assert(WS_MISC_END <= 6 * MiB, "misc region");
constexpr size_t WS_WIN = 6 * MiB;
constexpr size_t WS_WUQ = WS_WIN + (size_t)2816 * 1024 * 2;
constexpr size_t WS_WUKV = WS_WUQ + (size_t)768 * 384 * 2;
constexpr size_t WS_WOUT0 = WS_WUKV + (size_t)1024 * 256 * 2;
constexpr size_t WS_WOUT1 = WS_WOUT0 + (size_t)1024 * 1024 * 2;
constexpr size_t WS_W_END = WS_WOUT1 + (size_t)1024 * 1024 * 2;
static_assert(WS_W_END <= 17 * MiB, "weight region");
constexpr size_t WS_G = 17 * MiB;
constexpr size_t WS_X = WS_G + 48 * MiB;
constexpr size_t WS_RQ = WS_X, WS_RK = WS_X + 12 * MiB, WS_RV = WS_X + 24 * MiB, WS_QW = WS_X;
constexpr size_t WS_Q = WS_X + 48 * MiB;
constexpr size_t WS_QR = WS_Q, WS_CQ = WS_Q + 36 * MiB, WS_AODD = WS_Q;
constexpr size_t WS_URS = WS_CQ;
constexpr size_t WS_CKVN = WS_Q + 54 * MiB;
constexpr size_t WS_KR = WS_CKVN + 13 * MiB;
constexpr size_t WS_KV = WS_KR + (size_t)MROWS_X * 32 * 2;
constexpr size_t WS_KIMG = WS_KV, WS_VIMG = WS_KV + 39 * MiB, WS_AEVEN = WS_KV;
constexpr size_t WS_KWIMG = WS_KV + 39 * MiB, WS_VWIMG = WS_KV + 52 * MiB;
constexpr size_t WS_URP = WS_KV + 65 * MiB;
constexpr size_t WS_END = WS_URP + 8 * MiB;
static_assert(WS_END <= 256 * MiB, "workspace map exceeds 256 MiB");

typedef unsigned short bf16_t;

struct Params {
    const float* in[N_INPUTS];
    float* out;
    unsigned char* ws;
    int ph_lo, ph_hi;
};

typedef const __attribute__((address_space(4))) Params CParams;
__device__ __forceinline__ CParams* params_ptr() { CParams* p = (CParams*)__builtin_amdgcn_kernarg_segment_ptr(); asm volatile("" : "+s"(p)); return p; }

__device__ __forceinline__ float bf2f(bf16_t b) { return __uint_as_float((unsigned)b << 16); }
__device__ __forceinline__ bf16_t f2bf(float f) { unsigned u = __float_as_uint(f); return (bf16_t)((u + 0x7fffu + ((u >> 16) & 1u)) >> 16); }
__device__ __forceinline__ float bfr(float f) { return bf2f(f2bf(f)); }
__device__ __forceinline__ float silu_f(float x) { return x / (1.f + __expf(-x)); }

__device__ __forceinline__ int p2d64(int p) { return 32 * ((p >> 3) & 1) + 16 * ((p >> 2) & 1) + 4 * (p >> 4) + (p & 3); }
__device__ __forceinline__ int d2p64(int d) { return 16 * ((d >> 2) & 3) + 8 * (d >> 5) + 4 * ((d >> 4) & 1) + (d & 3); }
__device__ __forceinline__ int o2j32(int o) { const int grp = o >> 3, w = o & 7; return 16 * (grp >> 1) + 4 * (grp & 1) + (w & 3) + 8 * (w >> 2); }
__device__ __forceinline__ int j2o32(int j) { return 8 * (2 * (j >> 4) + ((j >> 2) & 1)) + 4 * ((j >> 3) & 1) + (j & 3); }

struct RowInfo { int cond; int b; int t; bool sample; };
__device__ __forceinline__ RowInfo row_info(int row) {
    RowInfo r;
    if (row < NP_ROWS) { r.cond = 4; r.b = row >> 8; r.t = row & 255; r.sample = false; }
    else { const int rs = row - NP_ROWS; r.b = rs >> 12; r.t = rs & 4095; r.cond = r.b; r.sample = true; }
    return r;
}
__device__ __forceinline__ int kv_tile(int R, int head, int H, int& kin) {
    if (R < NP_ROWS) { const int b = R >> 8, key = R & 255; kin = key & 63; return (b * H + head) * 4 + (key >> 6); }
    int b, key;
    if (R < MROWS) { const int rs = R - NP_ROWS; b = rs >> 12; key = 512 + (rs & 4095); }
    else { const int rc = R - MROWS; b = rc >> 9; key = rc & 511; }
    kin = key & 63; return 32 * H * 4 + (b * H + head) * 72 + (key >> 6);
}
__device__ __forceinline__ int kv_seq_tile0(bool sample, int b, int head, int H) { return sample ? 32 * H * 4 + (b * H + head) * 72 : (b * H + head) * 4; }

template <int K> __device__ __forceinline__ float xor_shfl(float v) { static_assert(K < 32, "xor_shfl"); return __int_as_float(__builtin_amdgcn_ds_swizzle(__float_as_int(v), (K << 10) | 0x1f)); }
__device__ __forceinline__ float sum_halves(float v) { auto r = __builtin_amdgcn_permlane32_swap(__float_as_uint(v), __float_as_uint(v), false, false); return __uint_as_float(r[0]) + __uint_as_float(r[1]); }
__device__ __forceinline__ float wave_sum(float v) { v += xor_shfl<1>(v); v += xor_shfl<2>(v); v += xor_shfl<4>(v); v += xor_shfl<8>(v); v += xor_shfl<16>(v); return sum_halves(v); }

__device__ __forceinline__ int lane_id() { return (int)__builtin_amdgcn_mbcnt_hi(~0u, __builtin_amdgcn_mbcnt_lo(~0u, 0u)); }

#define NVF(name) __device__ void name(CParams& P, int layer, long gt, long gn)

__device__ __forceinline__ const float* cond_vec(CParams& P, int c) { return c < 4 ? P.in[I_C] + c * 1024 : P.in[I_CCTX]; }
__device__ __forceinline__ float* ws_f32(CParams& P, size_t off) { return (float*)(P.ws + off); }
__device__ __forceinline__ bf16_t* ws_bf(CParams& P, size_t off) { return (bf16_t*)(P.ws + off); }
__device__ __forceinline__ const float* y_row(CParams& P, int layer, int row) {
    if (layer == 0) return row < NP_ROWS ? P.in[I_XP] + (size_t)row * DM : P.in[I_XS] + (size_t)(row - NP_ROWS) * DM;
    return P.out + (size_t)row * DM;
}
__device__ __forceinline__ float log_gamma(CParams& P, int layer, int dir, int head) { return -__expf(P.in[I_DECAY][(layer >> 1) * 8 + dir * 4 + head]); }

NVF(nv_mod) {
    float* mod = ws_f32(P, WS_MOD);
    for (long i = gt; i < 4L * 5 * 3072; i += gn) {
        const int j = (int)(i % 3072), c = (int)((i / 3072) % 5), l = (int)(i / (3072 * 5));
        const float* cv = cond_vec(P, c); const float* w = P.in[I_ADAW] + (size_t)l * 1024 * 3072 + j;
        float s = 0.f;
        for (int k = 0; k < 1024; ++k) s += silu_f(cv[k]) * w[(size_t)k * 3072];
        mod[i] = s + P.in[I_ADAB][l * 3072 + j];
    }
    float* r8 = ws_f32(P, WS_ROPE8); float* r16 = ws_f32(P, WS_ROPE16);
    for (long i = gt; i < 64 * 8; i += gn) { const int pos = (int)(i >> 3), f = (int)(i & 7); const float inv = powf(10000.f, -(float)f / 8.f), a = (float)pos * inv; r8[2 * i] = cosf(a); r8[2 * i + 1] = sinf(a); }
    for (long i = gt; i < 64 * 16; i += gn) { const int pos = (int)(i >> 4), f = (int)(i & 15); const float inv = powf(10000.f, -(float)f / 16.f), a = (float)pos * inv; r16[2 * i] = cosf(a); r16[2 * i + 1] = sinf(a); }
}
NVF(nv_gs) {
    float* gs = ws_f32(P, WS_GS); const float* mod = ws_f32(P, WS_MOD);
    for (long i = gt; i < 4L * 5 * 1024; i += gn) { const int k = (int)(i & 1023), c = (int)((i >> 10) % 5), l = (int)(i / 5120); gs[i] = P.in[I_NORMG][l * 1024 + k] * (1.f + mod[(l * 5 + c) * 3072 + 1024 + k]); }
    if (gt == 0) {
        float* bnd = ws_f32(P, WS_BND);
        for (int i = 0; i < 2; ++i) {
            float mq = 0.f, mk = 0.f; for (int d = 0; d < 96; ++d) { mq = fmaxf(mq, fabsf(P.in[I_QHG][i * 96 + d])); mk = fmaxf(mk, fabsf(P.in[I_KHG][i * 96 + d])); }
            bnd[i] = sqrtf(96.f) * LOG2E * mq * mk;
        }
        for (int i = 0; i < 2; ++i) {
            float mq = 0.f, mk = 0.f; for (int d = 0; d < 64; ++d) { mq = fmaxf(mq, fabsf(P.in[I_WQHG][i * 64 + d])); mk = fmaxf(mk, fabsf(P.in[I_WKHG][i * 64 + d])); }
            bnd[8 + i] = mq; bnd[10 + i] = mk;
        }
    }
}
NVF(nv_bias) {
    float* bias = ws_f32(P, WS_BIAS); const float* mod = ws_f32(P, WS_MOD);
    for (long i = gt; i < 4L * 5 * 2816; i += gn) {
        const int col = (int)(i % 2816), c = (int)((i / 2816) % 5), l = (int)(i / (2816 * 5));
        const int N = (l & 1) ? WIN_IN : AB_IN; float s = 0.f;
        if (col < N) { const float* w = ((l & 1) ? P.in[I_WWIN] : P.in[I_ABWIN]) + (size_t)(l >> 1) * 1024 * N + col; const float* sh = mod + (l * 5 + c) * 3072;
            for (int k = 0; k < 1024; ++k) s += sh[k] * w[(size_t)k * N]; }
        bias[i] = s;
    }
}
NVF(nv_prepA) {
    bf16_t* A = ws_bf(P, (layer & 1) ? WS_AODD : WS_AEVEN); float* SS = ws_f32(P, WS_SS);
    const float* mod = ws_f32(P, WS_MOD);
    for (long row = gt; row < MROWS; row += gn) {
        const RowInfo ri = row_info((int)row); const float* y = y_row(P, layer, (int)row);
        const float* sc = mod + (layer * 5 + ri.cond) * 3072 + 1024; const float* g = P.in[I_NORMG] + layer * 1024;
        float s = 0.f;
        for (int k = 0; k < 1024; ++k) { const float v = y[k]; s += v * v; A[(size_t)row * 1024 + k] = f2bf(v * g[k] * (1.f + sc[k])); }
        SS[row * 16] = s; for (int j = 1; j < 16; ++j) SS[row * 16 + j] = 0.f;
    }
}
__device__ __forceinline__ float row_rstd(const float* SS, int row) { float s = 0.f; for (int j = 0; j < 16; ++j) s += SS[row * 16 + j]; return 1.0f / sqrtf(s * (1.f / 1024.f) + EPS); }

NVF(nv_in_even) {
    const bf16_t* A = ws_bf(P, WS_AEVEN); const float* SS = ws_f32(P, WS_SS); const float* W = P.in[I_ABWIN] + (size_t)(layer >> 1) * 1024 * AB_IN;
    const float* bias = ws_f32(P, WS_BIAS);
    bf16_t *CQ = ws_bf(P, WS_CQ), *CKVN = ws_bf(P, WS_CKVN), *KR = ws_bf(P, WS_KR), *G = ws_bf(P, WS_G), *RQ = ws_bf(P, WS_RQ), *RK = ws_bf(P, WS_RK), *RV = ws_bf(P, WS_RV);
    float* okr = P.out + (layer == 0 ? O_L0KR : O_L2KR);
    for (long i = gt; i < (long)(MROWS / 4) * AB_IN; i += gn) {
        const int col = (int)(i % AB_IN), r0 = (int)(i / AB_IN) * 4;
        float acc[4] = {0.f, 0.f, 0.f, 0.f};
        for (int k = 0; k < 1024; ++k) { const float w = bfr(W[(size_t)k * AB_IN + col]);
#pragma unroll
            for (int r = 0; r < 4; ++r) acc[r] += bf2f(A[(size_t)(r0 + r) * 1024 + k]) * w; }
#pragma unroll
        for (int r = 0; r < 4; ++r) {
            const int row = r0 + r; const RowInfo ri = row_info(row);
            const float v = acc[r] * row_rstd(SS, row) + bias[(layer * 5 + ri.cond) * 2816 + col];
            if (col < 384) CQ[(size_t)row * 384 + col] = f2bf(v);
            else if (col < 640) CKVN[(size_t)row * 256 + col - 384] = f2bf(v);
            else if (col < 672) { const int j = col - 640; KR[(size_t)row * 32 + j2o32(j)] = f2bf(v); if (!ri.sample) okr[(size_t)row * 32 + j] = v; }
            else if (col < 1184) G[(size_t)row * 1024 + col - 672] = f2bf(silu_f(v));
            else if (col < 1440) { const int x = col - 1184; RQ[(size_t)row * 256 + (x >> 6) * 64 + d2p64(x & 63)] = f2bf(v); }
            else if (col < 1696) { const int x = col - 1440; RK[(size_t)row * 256 + (x >> 6) * 64 + d2p64(x & 63)] = f2bf(v); }
            else if (col < 2208) RV[(size_t)row * 512 + col - 1696] = f2bf(v);
            else G[(size_t)row * 1024 + 512 + col - 2208] = f2bf(silu_f(v));
        }
    }
}
NVF(nv_post_even) {
    bf16_t *CQ = ws_bf(P, WS_CQ), *CKVN = ws_bf(P, WS_CKVN), *KR = ws_bf(P, WS_KR), *RQ = ws_bf(P, WS_RQ), *RK = ws_bf(P, WS_RK);
    float *sscq = ws_f32(P, WS_SSCQ), *sskr = ws_f32(P, WS_SSKR); const float* r16 = ws_f32(P, WS_ROPE16);
    const float* gkv = P.in[I_KVNG] + (layer >> 1) * 256; float* ockv = P.out + (layer == 0 ? O_L0CKV : O_L2CKV);
    for (long row = gt; row < MROWS; row += gn) {
        const RowInfo ri = row_info((int)row);
        float s = 0.f; for (int k = 0; k < 384; ++k) { const float v = bf2f(CQ[row * 384 + k]); s += v * v; }
        sscq[row * 8] = s; for (int j = 1; j < 8; ++j) sscq[row * 8 + j] = 0.f;
        s = 0.f; for (int k = 0; k < 32; ++k) { const float v = bf2f(KR[row * 32 + k]); s += v * v; }
        sskr[row] = s;
        s = 0.f; for (int k = 0; k < 256; ++k) { const float v = bf2f(CKVN[row * 256 + k]); s += v * v; }
        const float rs = 1.0f / sqrtf(s * (1.f / 256.f) + EPS);
        for (int k = 0; k < 256; ++k) { const float v = bf2f(CKVN[row * 256 + k]) * rs * gkv[k]; CKVN[row * 256 + k] = f2bf(v); if (!ri.sample) ockv[row * 256 + k] = v; }
        const int pr = ri.t >> 6, pc = ri.t & 63;
        for (int a = 0; a < 2; ++a) { bf16_t* X = a ? RK : RQ; const float scl = a ? 1.f : 0.125f;
            for (int h = 0; h < 4; ++h) for (int half = 0; half < 2; ++half) for (int f = 0; f < 16; ++f) {
                const int d1 = 32 * half + f, d2 = d1 + 16; bf16_t* p1 = X + row * 256 + h * 64 + d2p64(d1); bf16_t* p2 = X + row * 256 + h * 64 + d2p64(d2);
                float x1 = bf2f(*p1) * scl, x2 = bf2f(*p2) * scl;
                if (ri.sample) { const int pos = half ? pc : pr; const float c = r16[(pos * 16 + f) * 2], sn = r16[(pos * 16 + f) * 2 + 1]; const float y1 = x1 * c - x2 * sn, y2 = x1 * sn + x2 * c; x1 = y1; x2 = y2; }
                *p1 = f2bf(x1); *p2 = f2bf(x2); } }
    }
}
NVF(nv_ctx_even) {
    const float* cckv = P.in[layer == 0 ? I_C0CKV : I_C2CKV]; const float* ckr = P.in[layer == 0 ? I_C0KR : I_C2KR];
    bf16_t *CKVN = ws_bf(P, WS_CKVN), *KR = ws_bf(P, WS_KR); float* sskr = ws_f32(P, WS_SSKR);
    for (long i = gt; i < (long)CTX_ROWS * 256; i += gn) CKVN[(size_t)MROWS * 256 + i] = f2bf(cckv[i]);
    for (long rc = gt; rc < CTX_ROWS; rc += gn) { float s = 0.f;
        for (int j = 0; j < 32; ++j) { const bf16_t v = f2bf(ckr[rc * 32 + j]); KR[(size_t)(MROWS + rc) * 32 + j2o32(j)] = v; s += bf2f(v) * bf2f(v); }
        sskr[MROWS + rc] = s; }
}
NVF(nv_uq) {
    const bf16_t* CQ = ws_bf(P, WS_CQ); bf16_t* QR = ws_bf(P, WS_QR); const float* W = P.in[I_WUQ] + (size_t)(layer >> 1) * 384 * 768; const float* gq = P.in[I_QNG] + (layer >> 1) * 384;
    for (long i = gt; i < (long)MROWS * 768; i += gn) {
        const int sp = (int)(i % 96), head = (int)((i / 96) & 7); const long row = i / 768;
        const int dd = sp < 64 ? sp : 64 + o2j32(sp - 64), col = head * 96 + dd; float z = 0.f;
        for (int k = 0; k < 384; ++k) z += bf2f(CQ[row * 384 + k]) * bfr(gq[k] * W[(size_t)k * 768 + col]);
        QR[i] = f2bf(z);
    }
}
NVF(nv_uq_ss) {
    const bf16_t* QR = ws_bf(P, WS_QR); const float* sscq = ws_f32(P, WS_SSCQ); float *ssqn = ws_f32(P, WS_SSQN), *ssqr = ws_f32(P, WS_SSQR);
    for (long i = gt; i < (long)MROWS * 8; i += gn) { const long row = i >> 3; float a = 0.f, b = 0.f;
        for (int s = 0; s < 64; ++s) { const float v = bf2f(QR[i * 96 + s]); a += v * v; }
        for (int s = 64; s < 96; ++s) { const float v = bf2f(QR[i * 96 + s]); b += v * v; }
        float c = 0.f; for (int j = 0; j < 8; ++j) c += sscq[row * 8 + j];
        ssqn[i] = a + 96.f * EPS * (c * (1.f / 384.f) + EPS); ssqr[i] = b; }
}
NVF(nv_ukv) {
    const bf16_t* CKVN = ws_bf(P, WS_CKVN); const float* W = P.in[I_WUKV] + (size_t)(layer >> 1) * 256 * 1024;
    unsigned char* KI = P.ws + WS_KIMG; unsigned char* VI = P.ws + WS_VIMG;
    for (long i = gt; i < (long)MROWS_X * 1024; i += gn) {
        const int feat = (int)(i & 1023), head = feat >> 7, r = feat & 127; const int R = (int)(i >> 10); float v = 0.f;
        for (int k = 0; k < 256; ++k) v += bf2f(CKVN[(size_t)R * 256 + k]) * bfr(W[(size_t)k * 1024 + feat]);
        int kin; const int tile = kv_tile(R, head, 8, kin);
        if (r < 64) *(bf16_t*)(KI + (size_t)tile * 12288 + (r >> 3) * 1024 + kin * 16 + (r & 7) * 2) = f2bf(v);
        else { const int dv = r - 64; *(bf16_t*)(VI + (size_t)tile * 8192 + (dv >> 5) * 4096 + kin * 64 + (dv & 31) * 2) = f2bf(v); }
    }
}
NVF(nv_k_post) {
    const bf16_t* KR = ws_bf(P, WS_KR); const float* sskr = ws_f32(P, WS_SSKR); const float* gk = P.in[I_KHG] + (layer >> 1) * 96; const float* r8 = ws_f32(P, WS_ROPE8);
    unsigned char* KI = P.ws + WS_KIMG;
    for (long i = gt; i < (long)MROWS_X * 8; i += gn) {
        const int R = (int)(i >> 3), head = (int)(i & 7); int kin; const int tile = kv_tile(R, head, 8, kin);
        unsigned char* base = KI + (size_t)tile * 12288 + kin * 16;
        float s = sskr[R];
        for (int d = 0; d < 64; ++d) { const float v = bf2f(*(bf16_t*)(base + (d >> 3) * 1024 + (d & 7) * 2)); s += v * v; }
        const float rs = 1.0f / sqrtf(s * (1.f / 96.f) + EPS);
        for (int d = 0; d < 64; ++d) { bf16_t* p = (bf16_t*)(base + (d >> 3) * 1024 + (d & 7) * 2); *p = f2bf(bf2f(*p) * rs * gk[d]); }
        const bool lat = (R >= NP_ROWS && R < MROWS); const int t = (R - NP_ROWS) & 4095, pr = t >> 6, pc = t & 63;
        for (int half = 0; half < 2; ++half) for (int f = 0; f < 8; ++f) {
            const int j1 = 16 * half + f, j2 = j1 + 8; const int o1 = j2o32(j1), o2 = j2o32(j2);
            float x1 = bf2f(KR[(size_t)R * 32 + o1]) * rs * gk[64 + j1], x2 = bf2f(KR[(size_t)R * 32 + o2]) * rs * gk[64 + j2];
            if (lat) { const int pos = half ? pc : pr; const float c = r8[(pos * 8 + f) * 2], sn = r8[(pos * 8 + f) * 2 + 1]; const float y1 = x1 * c - x2 * sn, y2 = x1 * sn + x2 * c; x1 = y1; x2 = y2; }
            *(bf16_t*)(base + ((64 + o1) >> 3) * 1024 + (o1 & 7) * 2) = f2bf(x1); *(bf16_t*)(base + ((64 + o2) >> 3) * 1024 + (o2 & 7) * 2) = f2bf(x2); }
    }
}
__device__ __forceinline__ int chunk_row0(int c) { return c < 64 ? (c >> 1) * 256 + (c & 1) * 128 : NP_ROWS + ((c - 64) >> 5) * 4096 + ((c - 64) & 31) * 128; }
__device__ __forceinline__ unsigned char* ur_ptr(CParams& P, int c, int head, int dir) { return c < 64 ? P.ws + WS_URP + (size_t)((c * 4 + head) * 2 + dir) * 16384 : P.ws + WS_URS + (size_t)(((c - 64) * 4 + head) * 2 + dir) * 16384; }
__device__ __forceinline__ size_t ur_el(int p, int dv) { return (size_t)(dv >> 5) * 4096 + p * 64 + (dv & 31) * 2; }
NVF(nv_u) {
    const bf16_t *RK = ws_bf(P, WS_RK), *RV = ws_bf(P, WS_RV);
    for (long i = gt; i < 192L * 4 * 2 * 8192; i += gn) {
        const int dv = (int)(i & 127), p = (int)((i >> 7) & 63), dir = (int)((i >> 13) & 1), head = (int)((i >> 14) & 3), c = (int)(i >> 16);
        const float lg = log_gamma(P, layer, dir, head); const int r0 = chunk_row0(c); float s = 0.f;
        for (int t = 0; t < 128; ++t) { const float w = __expf(lg * (float)(dir ? t : 127 - t)); s += bfr(bf2f(RK[(size_t)(r0 + t) * 256 + head * 64 + p]) * w) * bf2f(RV[(size_t)(r0 + t) * 512 + head * 128 + dv]); }
        *(bf16_t*)(ur_ptr(P, c, head, dir) + ur_el(p, dv)) = f2bf(s);
    }
}
NVF(nv_scan) {
    float* orf = P.out + (layer == 0 ? O_L0RF : O_L2RF); float* orb = P.out + (layer == 0 ? O_L0RB : O_L2RB);
    const float* s0f = P.in[layer == 0 ? I_S0F : I_S2F]; const float* s0b = P.in[layer == 0 ? I_S0B : I_S2B];
    for (long i = gt; i < 36L * 4 * 2 * 8192; i += gn) {
        const int dv = (int)(i & 127), p = (int)((i >> 7) & 63), dir = (int)((i >> 13) & 1), head = (int)((i >> 14) & 3), seq = (int)(i >> 16);
        const float gC = __expf(128.f * log_gamma(P, layer, dir, head)); const size_t el = ur_el(p, dv); const int d = p2d64(p);
        if (seq < 32) {
            bf16_t* u0 = (bf16_t*)(ur_ptr(P, 2 * seq, head, dir) + el); bf16_t* u1 = (bf16_t*)(ur_ptr(P, 2 * seq + 1, head, dir) + el);
            const float a = bf2f(*u0), b = bf2f(*u1);
            if (dir == 0) { orf[((size_t)(seq * 4 + head) * 64 + d) * 128 + dv] = gC * a + b; *u0 = 0; *u1 = f2bf(a); }
            else { orb[((size_t)(seq * 4 + head) * 64 + d) * 128 + dv] = gC * b + a; *u1 = 0; *u0 = f2bf(b); }
        } else {
            const int b = seq - 32; float R = (dir ? s0b : s0f)[((size_t)(b * 4 + head) * 64 + d) * 128 + dv];
            for (int n = 0; n < 32; ++n) { const int c = 64 + b * 32 + (dir ? 31 - n : n); bf16_t* u = (bf16_t*)(ur_ptr(P, c, head, dir) + el); const float uv = bf2f(*u); *u = f2bf(R); R = gC * R + uv; }
        }
    }
}
__device__ __forceinline__ float mla_q_at(CParams& P, int layer, int row, int head, int s) {
    const bf16_t* QR = ws_bf(P, WS_QR) + ((size_t)row * 8 + head) * 96; const float* gq = P.in[I_QHG] + (layer >> 1) * 96; const float* r8 = ws_f32(P, WS_ROPE8);
    const float ss = ws_f32(P, WS_SSQN)[row * 8 + head] + ws_f32(P, WS_SSQR)[row * 8 + head]; const float rs = 1.0f / sqrtf(ss * (1.f / 96.f));
    const float qs = 0.10206207261596575f * LOG2E;
    if (s < 64) return bfr(bf2f(QR[s]) * rs * gq[s] * qs);
    const RowInfo ri = row_info(row);
    const int j = o2j32(s - 64), j1 = j & ~8, j2 = j1 + 8, half = j >> 4, f = j & 7;
    const float x1 = bf2f(QR[64 + j2o32(j1)]) * rs * gq[64 + j1], x2 = bf2f(QR[64 + j2o32(j2)]) * rs * gq[64 + j2];
    float c = 1.f, sn = 0.f;
    if (ri.sample) { const int pos = half ? (ri.t & 63) : (ri.t >> 6); c = r8[(pos * 8 + f) * 2]; sn = r8[(pos * 8 + f) * 2 + 1]; }
    const float y = (j & 8) ? (x1 * sn + x2 * c) : (x1 * c - x2 * sn);
    return bfr(y * qs);
}
NVF(nv_mla_attn) {
    const unsigned char* KI = P.ws + WS_KIMG; const unsigned char* VI = P.ws + WS_VIMG; bf16_t* G = ws_bf(P, WS_G); const float bnd = ws_f32(P, WS_BND)[layer >> 1];
    const int lane = (int)(gt & 63);
    for (long it = gt >> 6; it < (long)MROWS * 8; it += gn >> 6) {
        const int row = (int)(it % MROWS), head = (int)(it / MROWS); const RowInfo ri = row_info(row);
        const float q0 = mla_q_at(P, layer, row, head, lane), q1 = lane < 32 ? mla_q_at(P, layer, row, head, 64 + lane) : 0.f;
        float o = 0.f, l = 0.f;
        const int t0 = kv_seq_tile0(ri.sample, ri.b, head, 8), nk = ri.sample ? 4608 : 256;
        for (int key = 0; key < nk; ++key) {
            const unsigned char* kb = KI + (size_t)(t0 + (key >> 6)) * 12288 + (key & 63) * 16; const unsigned char* vb = VI + (size_t)(t0 + (key >> 6)) * 8192 + (key & 63) * 64;
            float s = q0 * bf2f(*(const bf16_t*)(kb + (lane >> 3) * 1024 + (lane & 7) * 2));
            if (lane < 32) s += q1 * bf2f(*(const bf16_t*)(kb + ((64 + lane) >> 3) * 1024 + (lane & 7) * 2));
            s = wave_sum(s);
            const float p = exp2f(s - bnd); l += p;
            o += bfr(p) * bf2f(*(const bf16_t*)(vb + (lane >> 5) * 4096 + (lane & 31) * 2));
        }
        bf16_t* g = G + (size_t)row * 1024 + head * 64 + lane; *g = f2bf(o / l * bf2f(*g));
    }
}
NVF(nv_ret_out) {
    const bf16_t *RQ = ws_bf(P, WS_RQ), *RK = ws_bf(P, WS_RK), *RV = ws_bf(P, WS_RV); bf16_t* G = ws_bf(P, WS_G); const float* gn_ = P.in[I_RNG] + (layer >> 1) * 512;
    const int lane = (int)(gt & 63);
    for (long it = gt >> 6; it < (long)MROWS * 4; it += gn >> 6) {
        const int row = (int)(it % MROWS), head = (int)(it / MROWS);
        const int c = row < NP_ROWS ? row >> 7 : 64 + ((row - NP_ROWS) >> 7); const int ii = row & 127, r0 = chunk_row0(c);
        const float lgf = log_gamma(P, layer, 0, head), lgb = log_gamma(P, layer, 1, head);
        const float ql = bf2f(RQ[(size_t)row * 256 + head * 64 + lane]);
        float o0 = 0.f, o1 = 0.f;
        for (int j = 0; j < 128; ++j) {
            const float s = wave_sum(ql * bf2f(RK[(size_t)(r0 + j) * 256 + head * 64 + lane]));
            const float D = j < ii ? __expf(lgf * (float)(ii - j)) : (j > ii ? __expf(lgb * (float)(j - ii)) : 2.f);
            const float pb = bfr(s * D);
            o0 += pb * bf2f(RV[(size_t)(r0 + j) * 512 + head * 128 + lane]); o1 += pb * bf2f(RV[(size_t)(r0 + j) * 512 + head * 128 + 64 + lane]);
        }
        const float wf = __expf(lgf * (float)(ii + 1)), wb = __expf(lgb * (float)(128 - ii));
        const unsigned char* Rf = ur_ptr(P, c, head, 0); const unsigned char* Rb = ur_ptr(P, c, head, 1);
        for (int p = 0; p < 64; ++p) { const float qp = bf2f(RQ[(size_t)row * 256 + head * 64 + p]); const float qf = bfr(qp * wf), qb = bfr(qp * wb);
            o0 += qf * bf2f(*(const bf16_t*)(Rf + ur_el(p, lane))) + qb * bf2f(*(const bf16_t*)(Rb + ur_el(p, lane)));
            o1 += qf * bf2f(*(const bf16_t*)(Rf + ur_el(p, 64 + lane))) + qb * bf2f(*(const bf16_t*)(Rb + ur_el(p, 64 + lane))); }
        const float mu = wave_sum(o0 + o1) * (1.f / 128.f);
        const float d0 = o0 - mu, d1 = o1 - mu; const float var = wave_sum(d0 * d0 + d1 * d1) * (1.f / 128.f);
        const float rs = 1.0f / sqrtf(var + EPS);
        bf16_t* g = G + (size_t)row * 1024 + 512 + head * 128 + lane;
        g[0] = f2bf(d0 * rs * gn_[head * 128 + lane] * bf2f(g[0])); g[64] = f2bf(d1 * rs * gn_[head * 128 + 64 + lane] * bf2f(g[64]));
    }
}
NVF(nv_out) {
    const bf16_t* G = ws_bf(P, WS_G); const float* W = ((layer & 1) ? P.in[I_WWOUT] : P.in[I_ABWOUT]) + (size_t)(layer >> 1) * 1024 * 1024; const float* mod = ws_f32(P, WS_MOD);
    for (long i = gt; i < (long)(MROWS / 4) * 1024; i += gn) {
        const int col = (int)(i & 1023), r0 = (int)(i >> 10) * 4; float acc[4] = {0.f, 0.f, 0.f, 0.f};
        for (int k = 0; k < 1024; ++k) { const float w = bfr(W[(size_t)k * 1024 + col]);
#pragma unroll
            for (int r = 0; r < 4; ++r) acc[r] += bf2f(G[(size_t)(r0 + r) * 1024 + k]) * w; }
#pragma unroll
        for (int r = 0; r < 4; ++r) { const int row = r0 + r; const RowInfo ri = row_info(row);
            P.out[(size_t)row * 1024 + col] = y_row(P, layer, row)[col] + mod[(layer * 5 + ri.cond) * 3072 + 2048 + col] * acc[r]; }
    }
}
NVF(nv_in_odd) {
    const bf16_t* A = ws_bf(P, WS_AODD); const float* SS = ws_f32(P, WS_SS); const float* W = P.in[I_WWIN] + (size_t)(layer >> 1) * 1024 * WIN_IN; const float* bias = ws_f32(P, WS_BIAS);
    bf16_t *QW = ws_bf(P, WS_QW), *G = ws_bf(P, WS_G); unsigned char* KI = P.ws + WS_KWIMG; unsigned char* VI = P.ws + WS_VWIMG; float* ov = P.out + (layer == 1 ? O_L1V : O_L3V);
    for (long i = gt; i < (long)(MROWS / 4) * WIN_IN; i += gn) {
        const int col = (int)(i % WIN_IN), r0 = (int)(i / WIN_IN) * 4; float acc[4] = {0.f, 0.f, 0.f, 0.f};
        for (int k = 0; k < 1024; ++k) { const float w = bfr(W[(size_t)k * WIN_IN + col]);
#pragma unroll
            for (int r = 0; r < 4; ++r) acc[r] += bf2f(A[(size_t)(r0 + r) * 1024 + k]) * w; }
#pragma unroll
        for (int r = 0; r < 4; ++r) { const int row = r0 + r; const RowInfo ri = row_info(row);
            const float v = acc[r] * row_rstd(SS, row) + bias[(layer * 5 + ri.cond) * 2816 + col];
            if (col < 1024) QW[(size_t)row * 1024 + (col >> 6) * 64 + d2p64(col & 63)] = f2bf(v);
            else if (col < 1280) { const int x = col - 1024, kvh = x >> 6, p = d2p64(x & 63); int kin; const int tile = kv_tile(row, kvh, 4, kin); *(bf16_t*)(KI + (size_t)tile * 8192 + (p >> 3) * 1024 + kin * 16 + (p & 7) * 2) = f2bf(v); }
            else if (col < 1536) { const int x = col - 1280, kvh = x >> 6, dv = x & 63; int kin; const int tile = kv_tile(row, kvh, 4, kin); *(bf16_t*)(VI + (size_t)tile * 8192 + (dv >> 5) * 4096 + kin * 64 + (dv & 31) * 2) = f2bf(v); if (!ri.sample) ov[(size_t)row * 256 + x] = v; }
            else G[(size_t)row * 1024 + col - 1536] = f2bf(silu_f(v)); }
    }
}
NVF(nv_post_odd) {
    bf16_t* QW = ws_bf(P, WS_QW); unsigned char* KI = P.ws + WS_KWIMG; const float* r16 = ws_f32(P, WS_ROPE16); float* ok = P.out + (layer == 1 ? O_L1K : O_L3K);
    const float* gq = P.in[I_WQHG] + (layer >> 1) * 64; const float* gk = P.in[I_WKHG] + (layer >> 1) * 64;
    const int d = (int)(gt & 63), p = d2p64(d);
    for (long it = gt >> 6; it < (long)MROWS * 20; it += gn >> 6) {
        const int row = (int)(it / 20), hh = (int)(it % 20); const RowInfo ri = row_info(row); const bool isq = hh < 16; const int kvh = hh - 16;
        int kin = 0, tile = 0; if (!isq) tile = kv_tile(row, kvh, 4, kin);
        bf16_t* ptr = isq ? QW + (size_t)row * 1024 + hh * 64 + p : (bf16_t*)(KI + (size_t)tile * 8192 + (p >> 3) * 1024 + kin * 16 + (p & 7) * 2);
        float x = bf2f(*ptr);
        const float rs = 1.0f / sqrtf(wave_sum(x * x) * (1.f / 64.f) + EPS);
        x *= rs * (isq ? gq[d] : gk[d]);
        if (!isq && !ri.sample) ok[(size_t)row * 256 + kvh * 64 + d] = x;
        const float xp = xor_shfl<16>(x);
        if (ri.sample) { const int half = d >> 5, f = d & 15; const int pos = half ? (ri.t & 63) : (ri.t >> 6);
            const float c = r16[(pos * 16 + f) * 2], sn = r16[(pos * 16 + f) * 2 + 1];
            x = (d & 16) ? (xp * sn + x * c) : (x * c - xp * sn); }
        *ptr = f2bf(isq ? x * 0.125f * LOG2E : x);
    }
}
NVF(nv_ctx_odd) {
    const float* ck = P.in[layer == 1 ? I_C1K : I_C3K]; const float* cv = P.in[layer == 1 ? I_C1V : I_C3V]; unsigned char* KI = P.ws + WS_KWIMG; unsigned char* VI = P.ws + WS_VWIMG;
    unsigned* bmax = (unsigned*)ws_f32(P, WS_BND) + 4 + (layer >> 1);
    for (long i = gt; i < (long)CTX_ROWS * 4; i += gn) { const int rc = (int)(i >> 2), kvh = (int)(i & 3); int kin; const int tile = kv_tile(MROWS + rc, kvh, 4, kin); float s = 0.f;
        for (int d = 0; d < 64; ++d) { const int p = d2p64(d); const bf16_t kb = f2bf(ck[(size_t)rc * 256 + kvh * 64 + d]); s += bf2f(kb) * bf2f(kb);
            *(bf16_t*)(KI + (size_t)tile * 8192 + (p >> 3) * 1024 + kin * 16 + (p & 7) * 2) = kb;
            *(bf16_t*)(VI + (size_t)tile * 8192 + (d >> 5) * 4096 + kin * 64 + (d & 31) * 2) = f2bf(cv[(size_t)rc * 256 + kvh * 64 + d]); }
        atomicMax(bmax, __float_as_uint(s)); }
}
NVF(nv_win_attn) {
    const bf16_t* QW = ws_bf(P, WS_QW); const unsigned char* KI = P.ws + WS_KWIMG; const unsigned char* VI = P.ws + WS_VWIMG; bf16_t* G = ws_bf(P, WS_G);
    const float* bf = ws_f32(P, WS_BND); const int li = layer >> 1;
    const float knorm = fmaxf(8.f * bf[10 + li], sqrtf(bf[4 + li])); const float bnd = 0.125f * LOG2E * 8.f * bf[8 + li] * knorm;
    const int lane = (int)(gt & 63);
    for (long it = gt >> 6; it < (long)MROWS * 16; it += gn >> 6) {
        const int row = (int)(it % MROWS), head = (int)(it / MROWS), kvh = head >> 2; const RowInfo ri = row_info(row);
        const float ql = bf2f(QW[(size_t)row * 1024 + head * 64 + lane]);
        float o = 0.f, l = exp2f(P.in[I_SINK][li * 16 + head] * LOG2E - bnd);
        const int t0 = kv_seq_tile0(ri.sample, ri.b, kvh, 4);
        int klo = 0, khi = 256, k2lo = 0, k2hi = 0;
        if (ri.sample) { klo = 0; khi = 512; k2lo = 512 + max(0, ri.t - 128); k2hi = 512 + min(4095, ri.t + 128) + 1; }
        for (int seg = 0; seg < 2; ++seg) { const int a = seg ? k2lo : klo, b = seg ? k2hi : khi;
            for (int key = a; key < b; ++key) {
                const unsigned char* kb = KI + (size_t)(t0 + (key >> 6)) * 8192 + (key & 63) * 16; const unsigned char* vb = VI + (size_t)(t0 + (key >> 6)) * 8192 + (key & 63) * 64;
                const float s = wave_sum(ql * bf2f(*(const bf16_t*)(kb + (lane >> 3) * 1024 + (lane & 7) * 2)));
                const float pp = exp2f(s - bnd); l += pp;
                o += bfr(pp) * bf2f(*(const bf16_t*)(vb + (lane >> 5) * 4096 + (lane & 31) * 2)); } }
        bf16_t* g = G + (size_t)row * 1024 + head * 64 + lane; *g = f2bf(o / l * bf2f(*g));
    }
}
NVF(nv_zero_bnd) { if (gt < 64) ws_f32(P, WS_BND)[gt] = 0.f; }

namespace pg8 {
#define PG8_LAS __attribute__((address_space(3)))
typedef short bf16x8 __attribute__((ext_vector_type(8)));
typedef float f32x4 __attribute__((ext_vector_type(4)));
typedef unsigned u32x4 __attribute__((ext_vector_type(4)));
constexpr int BM = 256, BK = 64, HALF = 128, HTB = HALF * BK * 2  , STAGE_BYTES = 8 * HTB, NXCD = 8, WGM = 8;

__host__ __device__ __forceinline__ int lds_byte(int r, int c) { const int st = (r >> 4) * 2 + (c >> 5), rr = r & 15, cc = c & 31, ob = rr * 64 + cc * 2; return st * 1024 + (ob ^ (((ob >> 9) & 1) << 5)); }
__host__ __device__ __forceinline__ void stage_rc(int b, int& R, int& C) { const int st = b / 1024, sb = b % 1024, swz = sb ^ (((sb >> 9) & 1) << 5); R = (st >> 1) * 16 + swz / 64; C = (st & 1) * 32 + (swz % 64) / 2; }
__host__ __device__ __forceinline__ int perm32(int rho) { const int n = rho >> 4, i = rho & 15; return 8 * (i >> 2) + 4 * n + (i & 3); }

struct Unit { int pm, pn; };
struct Gemm { const bf16_t* A; const bf16_t* Bt; int M, N, K, lda; };

struct StaticOrder {
    int nM, nN, nwg, G, c;
    __host__ __device__ void init(int M, int N, int G_, int c_) { nM = M / BM; nN = N / BM; nwg = nM * nN; G = G_; c = c_; }
    __host__ __device__ bool next(int i, Unit& u) const {
        const long L = (long)i * G + c; if (L >= nwg) return false;
        int wgid = (int)L; { const int q = nwg / NXCD, r = nwg % NXCD, xcd = wgid % NXCD, off = wgid / NXCD; wgid = (xcd < r ? xcd * (q + 1) : r * (q + 1) + (xcd - r) * q) + off; }
        const int nig = WGM * nN, gid = wgid / nig, fm = gid * WGM, gsz = (nM - fm) < WGM ? (nM - fm) : WGM;
        u.pm = fm + ((wgid % nig) % gsz); u.pn = (wgid % nig) / gsz; return true;
    }
    __device__ __forceinline__ void a_ready(const Unit&) const {}
    __device__ __forceinline__ void done(const Unit&) const {}
};

template <class Epi, class Sched, bool ALIGN_EPI = false, bool SP2 = false>
__device__ __forceinline__ void gemm_phase(PG8_LAS unsigned char* lds, const Gemm g, const Sched& S, const Epi& E, int wave_s) {
    int ws_ = wave_s; asm volatile("" : "+s"(ws_)); int ln_ = lane_id(); asm volatile("" : "+v"(ln_)); const int wid = ws_, lane = ln_, tid = wid * 64 + lane, wr = wid >> 2, wc = wid & 3, fr = lane & 15, fq = lane >> 4;
    const int K = g.K, nt = K / BK;
    unsigned voffA[2], voffB[2];
#pragma unroll
    for (int i = 0; i < 2; ++i) { int R, C; stage_rc(tid * 16 + i * 8192, R, C); const int Rb = Epi::PERM ? ((R & ~31) + perm32(R & 31)) : R;
        voffA[i] = (unsigned)(R * g.lda + C) * 2u; voffB[i] = (unsigned)(Rb * K + C) * 2u; }
    const size_t kstep = (size_t)(BK * 2);
    const size_t hstepA = (size_t)HALF * g.lda * 2, hstepB = (size_t)HALF * K * 2;
    const size_t tstepA = 2 * hstepA, tstepB = 2 * hstepB;
    const unsigned ldsw = (unsigned)wid * 1024u;
    const int aoff = lds_byte(wr * 64 + fr, fq * 8), boff = lds_byte(wc * 32 + fr, fq * 8);
#define PG8_SA(b, h) (((b) * 2 + (h)) * HTB)
#define PG8_SB(b, h) ((4 + (b) * 2 + (h)) * HTB)
#define PG8_STAGE(bufoff, gbase, voff) do { _Pragma("unroll") for (int _i = 0; _i < 2; ++_i) \
        __builtin_amdgcn_global_load_lds((const unsigned*)((const char*)(gbase) + (voff)[_i]), (PG8_LAS unsigned*)(lds + (bufoff) + ldsw + _i * 8192), 16, 0, 0); } while (0)
#define PG8_LDA(dst, b, h) do { _Pragma("unroll") for (int m = 0; m < 4; ++m) _Pragma("unroll") for (int k = 0; k < 2; ++k) dst[m][k] = *(const PG8_LAS bf16x8*)(lds + PG8_SA(b, h) + aoff + m * 2048 + k * 1024); } while (0)
#define PG8_LDB(dst, b, h) do { _Pragma("unroll") for (int n = 0; n < 2; ++n) _Pragma("unroll") for (int k = 0; k < 2; ++k) dst[n][k] = *(const PG8_LAS bf16x8*)(lds + PG8_SB(b, h) + boff + n * 2048 + k * 1024); } while (0)
#define PG8_MMA(ai, bj, At, Bt) do { __builtin_amdgcn_s_setprio(1); _Pragma("unroll") for (int m = 0; m < 4; ++m) _Pragma("unroll") for (int n = 0; n < 2; ++n) _Pragma("unroll") for (int k = 0; k < 2; ++k) \
        acc[ai][bj][m][n] = __builtin_amdgcn_mfma_f32_16x16x32_bf16(Bt[n][k], At[m][k], acc[ai][bj][m][n], 0, 0, 0); __builtin_amdgcn_s_setprio(0); } while (0)
#define PG8_WAIT_V(n) asm volatile("s_waitcnt vmcnt(" #n ")" ::: "memory")
#define PG8_WAIT_L(n) asm volatile("s_waitcnt lgkmcnt(" #n ")" ::: "memory")
#define PG8_BAR __builtin_amdgcn_s_barrier()
#define PG8_SCHED __builtin_amdgcn_sched_barrier(0)
    Unit cur, nxt; int ui = 0;
    if (!S.next(0, cur)) return;
    f32x4 acc[2][2][4][2];
#pragma unroll
    for (int a = 0; a < 2; ++a)
#pragma unroll
        for (int b = 0; b < 2; ++b)
#pragma unroll
            for (int m = 0; m < 4; ++m)
#pragma unroll
                for (int n = 0; n < 2; ++n) acc[a][b][m][n] = (f32x4){0.f, 0.f, 0.f, 0.f};
    bf16x8 At[4][2], B0[2][2], B1[2][2];
    const char* cA = (const char*)g.A + (size_t)cur.pm * tstepA; const char* cB = (const char*)g.Bt + (size_t)cur.pn * tstepB;
    S.a_ready(cur);
    if constexpr (SP2) {
        PG8_STAGE(PG8_SB(0, 0), cB, voffB); PG8_STAGE(PG8_SB(0, 1), cB + hstepB, voffB); PG8_STAGE(PG8_SA(0, 0), cA, voffA); PG8_STAGE(PG8_SA(0, 1), cA + hstepA, voffA);
        if (wr == 1) PG8_BAR;
        PG8_WAIT_V(2); PG8_BAR;
        PG8_STAGE(PG8_SB(1, 0), cB + kstep, voffB); PG8_STAGE(PG8_SA(1, 0), cA + kstep, voffA); PG8_STAGE(PG8_SB(1, 1), cB + hstepB + kstep, voffB);
        PG8_WAIT_V(6); PG8_BAR;
    } else {
        PG8_STAGE(PG8_SB(0, 0), cB, voffB); PG8_STAGE(PG8_SA(0, 0), cA, voffA); PG8_STAGE(PG8_SB(0, 1), cB + hstepB, voffB); PG8_STAGE(PG8_SA(0, 1), cA + hstepA, voffA);
        if (wr == 1) PG8_BAR;
        PG8_WAIT_V(4); PG8_BAR;
        PG8_STAGE(PG8_SB(1, 0), cB + kstep, voffB); PG8_STAGE(PG8_SA(1, 0), cA + kstep, voffA); PG8_STAGE(PG8_SB(1, 1), cB + hstepB + kstep, voffB);
        PG8_WAIT_V(6); PG8_BAR;
    }
    for (;;) {
        const bool has_next = S.next(ui + 1, nxt);
        const char* nA = has_next ? (const char*)g.A + (size_t)nxt.pm * tstepA : cA; const char* nB = has_next ? (const char*)g.Bt + (size_t)nxt.pn * tstepB : cB;
        for (int t = 0; t < nt; t += 2) {
            const bool last = (t == nt - 2);
            const char* a1 = cA + (size_t)(t + 1) * kstep;
            const char* a2 = last ? nA : cA + (size_t)(t + 2) * kstep; const char* b2 = last ? nB : cB + (size_t)(t + 2) * kstep;
            const char* a3 = a2 + kstep; const char* b3 = b2 + kstep;
            if (last && has_next) S.a_ready(nxt);
            if constexpr (SP2) {
            PG8_LDB(B0, 0, 0); PG8_LDB(B1, 0, 1); PG8_SCHED; PG8_LDA(At, 0, 0); PG8_STAGE(PG8_SA(1, 1), a1 + hstepA, voffA);
            PG8_WAIT_V(8); PG8_WAIT_L(0); PG8_BAR; PG8_MMA(0, 0, At, B0); PG8_MMA(0, 1, At, B1); PG8_BAR; PG8_SCHED;
            PG8_LDA(At, 0, 1); PG8_STAGE(PG8_SB(0, 0), b2, voffB); PG8_STAGE(PG8_SB(0, 1), b2 + hstepB, voffB); PG8_STAGE(PG8_SA(0, 0), a2, voffA);
            PG8_WAIT_V(8); PG8_WAIT_L(0); PG8_BAR; PG8_MMA(1, 0, At, B0); PG8_MMA(1, 1, At, B1); PG8_BAR; PG8_SCHED;
            PG8_LDB(B0, 1, 0); PG8_LDB(B1, 1, 1); PG8_SCHED; PG8_LDA(At, 1, 0); PG8_STAGE(PG8_SA(0, 1), a2 + hstepA, voffA);
            PG8_WAIT_V(8); PG8_WAIT_L(0); PG8_BAR; PG8_MMA(0, 0, At, B0); PG8_MMA(0, 1, At, B1); PG8_BAR; PG8_SCHED;
            PG8_LDA(At, 1, 1); PG8_STAGE(PG8_SB(1, 0), b3, voffB); PG8_STAGE(PG8_SB(1, 1), b3 + hstepB, voffB); PG8_STAGE(PG8_SA(1, 0), a3, voffA);
            PG8_WAIT_V(8); PG8_WAIT_L(0); PG8_BAR; PG8_MMA(1, 0, At, B0); PG8_MMA(1, 1, At, B1); PG8_BAR; PG8_SCHED;
            } else {
            PG8_LDB(B0, 0, 0); PG8_SCHED; PG8_LDA(At, 0, 0); PG8_STAGE(PG8_SA(1, 1), a1 + hstepA, voffA);
            PG8_WAIT_L(8); PG8_BAR; PG8_WAIT_L(0); PG8_MMA(0, 0, At, B0); PG8_BAR; PG8_SCHED;
            PG8_LDB(B1, 0, 1); PG8_STAGE(PG8_SB(0, 0), b2, voffB);
            PG8_BAR; PG8_WAIT_L(0); PG8_MMA(0, 1, At, B1); PG8_BAR;
            PG8_LDA(At, 0, 1); PG8_STAGE(PG8_SA(0, 0), a2, voffA);
            PG8_BAR; PG8_WAIT_L(0); PG8_MMA(1, 0, At, B0); PG8_BAR; PG8_SCHED;
            PG8_STAGE(PG8_SB(0, 1), b2 + hstepB, voffB);
            PG8_WAIT_V(6); PG8_BAR; PG8_MMA(1, 1, At, B1); PG8_BAR;
            PG8_LDB(B0, 1, 0); PG8_SCHED; PG8_LDA(At, 1, 0); PG8_STAGE(PG8_SA(0, 1), a2 + hstepA, voffA);
            PG8_WAIT_L(8); PG8_BAR; PG8_WAIT_L(0); PG8_MMA(0, 0, At, B0); PG8_BAR; PG8_SCHED;
            PG8_LDB(B1, 1, 1); PG8_STAGE(PG8_SB(1, 0), b3, voffB);
            PG8_BAR; PG8_WAIT_L(0); PG8_MMA(0, 1, At, B1); PG8_BAR;
            PG8_LDA(At, 1, 1); PG8_STAGE(PG8_SA(1, 0), a3, voffA);
            PG8_BAR; PG8_WAIT_L(0); PG8_MMA(1, 0, At, B0); PG8_BAR; PG8_SCHED;
            PG8_STAGE(PG8_SB(1, 1), b3 + hstepB, voffB);
            PG8_WAIT_V(6); PG8_BAR; PG8_MMA(1, 1, At, B1); PG8_BAR;
            }
        }
        if constexpr (ALIGN_EPI) { if (wr == 0) PG8_BAR; }
        if constexpr (!Epi::AFTER_DRAIN) { E(acc, cur, wr, wc, fr, fq); S.done(cur); }
        if (!has_next) break;
#pragma unroll
        for (int a = 0; a < 2; ++a)
#pragma unroll
            for (int b = 0; b < 2; ++b)
#pragma unroll
                for (int m = 0; m < 4; ++m)
#pragma unroll
                    for (int n = 0; n < 2; ++n) acc[a][b][m][n] = (f32x4){0.f, 0.f, 0.f, 0.f};
        cur = nxt; cA = nA; cB = nB; ++ui;
        if constexpr (ALIGN_EPI) { if (wr == 1) PG8_BAR; }
    }
    PG8_WAIT_V(0);
    if constexpr (!ALIGN_EPI) { if (wr == 0) PG8_BAR; }
    PG8_BAR;
    if constexpr (Epi::AFTER_DRAIN) { E.fused(acc, cur, wr, wc, fr, fq, lds, wid, lane); S.done(cur); }
#undef PG8_SA
#undef PG8_SB
#undef PG8_STAGE
#undef PG8_LDA
#undef PG8_LDB
#undef PG8_MMA
#undef PG8_WAIT_V
#undef PG8_WAIT_L
#undef PG8_BAR
#undef PG8_SCHED
}
}
#define LAS __attribute__((address_space(3)))
typedef float f32x4 __attribute__((ext_vector_type(4)));
typedef unsigned u32x4 __attribute__((ext_vector_type(4)));
typedef unsigned u32x2 __attribute__((ext_vector_type(2)));
constexpr int NWAVES = 8, NTHREADS = 512;
constexpr int RING_BYTES = 131072, EPI_OFF = RING_BYTES, EPI_BYTES = 8192, MISC_OFF = EPI_OFF + EPI_BYTES, LDS_BYTES = 147456;

__device__ __forceinline__ unsigned pk2(float lo, float hi) { return (unsigned)f2bf(lo) | ((unsigned)f2bf(hi) << 16); }
__device__ __forceinline__ u32x4 pk8(const f32x4& a, const f32x4& b) { u32x4 r; r.x = pk2(a[0], a[1]); r.y = pk2(a[2], a[3]); r.z = pk2(b[0], b[1]); r.w = pk2(b[2], b[3]); return r; }
__device__ __forceinline__ float sum4sq(const f32x4& a) { return (a[0] * a[0] + a[1] * a[1]) + (a[2] * a[2] + a[3] * a[3]); }
__device__ __forceinline__ float fq_sum(float s) { s += xor_shfl<16>(s); return sum_halves(s); }

struct LDec { int pn, bj, wc, nn, fq, e, f, w, d; };
__device__ __forceinline__ LDec ldec(int n) { LDec r; r.pn = n >> 8; const int L = n & 255; r.bj = L >> 7; r.wc = (L >> 5) & 3; r.nn = (L >> 4) & 1; r.fq = (L >> 2) & 3; r.e = L & 3;
    r.f = 128 * r.bj + 32 * r.wc + 8 * r.fq + 4 * r.nn + r.e;
    r.w = 16 * r.fq + 8 * r.bj + 4 * r.nn + r.e;
    r.d = 32 * r.bj + 16 * r.nn + 4 * r.fq + r.e;
    return r; }
enum { MAP_OUT = 0, MAP_IN_ODD, MAP_IN_EVEN, MAP_UQ, MAP_UKV };
__device__ __forceinline__ int srccol(int map, int n) {
    const LDec r = ldec(n);
    switch (map) {
        case MAP_OUT: return r.pn * 256 + r.f;
        case MAP_IN_ODD:
            if (r.pn < 4) return (4 * r.pn + r.wc) * 64 + r.d;
            if (r.pn == 4) return 1024 + r.wc * 64 + r.d;
            if (r.pn == 5) return 1280 + r.wc * 64 + r.w;
            return 1536 + (r.pn - 6) * 256 + r.f;
        case MAP_IN_EVEN:
            switch (r.pn) {
                case 0: return r.f;
                case 1: if (r.bj == 0) return 256 + r.f; return r.wc == 0 ? 640 + o2j32(8 * r.fq + 4 * r.nn + r.e) : -1;
                case 2: return 384 + r.f;
                case 3: case 4: return 672 + (r.pn - 3) * 256 + r.f;
                case 5: case 6: return 2208 + (r.pn - 5) * 256 + r.f;
                case 7: return 1184 + r.wc * 64 + r.d;
                case 8: return 1440 + r.wc * 64 + r.d;
                default: return 1696 + (2 * (r.pn - 9) + (r.wc >> 1)) * 128 + 64 * (r.wc & 1) + r.w;
            }
        case MAP_UQ:
            if (r.pn < 2) return (4 * r.pn + r.wc) * 96 + r.w;
            return (2 * r.wc + (r.w >> 5)) * 96 + 64 + o2j32(r.w & 31);
        default:
            if (r.pn < 2) return (4 * r.pn + r.wc) * 128 + r.w;
            return (4 * (r.pn - 2) + r.wc) * 128 + 64 + r.w;
    }
}
__device__ __forceinline__ void prep_item(const float* W, int K, int Nsrc, bf16_t* WT, int map, const float* kscale, LAS float* scr, int item, int lane) {
    const int nblk_k = K / 64, nb = item / nblk_k, kb = item % nblk_k, k0 = 64 * kb, n0 = 32 * nb;
    const int sc = srccol(map, n0 + (lane & 31));
#pragma unroll 8
    for (int i = 0; i < 32; ++i) { const int kk = 2 * i + (lane >> 5); float v = 0.f; if (sc >= 0) { v = W[(size_t)(k0 + kk) * Nsrc + sc]; if (kscale) v *= kscale[k0 + kk]; } scr[kk * 33 + (lane & 31)] = v; }
    asm volatile("s_waitcnt lgkmcnt(0)" ::: "memory");
    const int c = lane & 7;
#pragma unroll
    for (int j = 0; j < 4; ++j) { const int n = (lane >> 3) + 8 * j; const LAS float* s = scr + (8 * c) * 33 + n;
        u32x4 o; o.x = pk2(s[0 * 33], s[1 * 33]); o.y = pk2(s[2 * 33], s[3 * 33]); o.z = pk2(s[4 * 33], s[5 * 33]); o.w = pk2(s[6 * 33], s[7 * 33]);
        *(u32x4*)(WT + (size_t)(n0 + n) * K + k0 + 8 * c) = o; }
    asm volatile("s_waitcnt lgkmcnt(0)" ::: "memory");
}
__device__ __forceinline__ void prep_layer_weights(CParams& P, int layer, LAS float* scr, int gw, int ngw, int lane) {
    const int li = layer >> 1;
    if (layer & 1) {
        const int nIn = (2560 / 32) * 16, nOut = (1024 / 32) * 16;
        for (int it = gw; it < nIn + nOut; it += ngw) {
            if (it < nIn) prep_item(P.in[I_WWIN] + (size_t)li * 1024 * WIN_IN, 1024, WIN_IN, ws_bf(P, WS_WIN), MAP_IN_ODD, nullptr, scr, it, lane);
            else prep_item(P.in[I_WWOUT] + (size_t)li * 1024 * 1024, 1024, 1024, ws_bf(P, layer & 1 ? WS_WOUT1 : WS_WOUT0), MAP_OUT, nullptr, scr, it - nIn, lane);
        }
    } else {
        const int nIn = (2816 / 32) * 16, nOut = (1024 / 32) * 16, nUq = (768 / 32) * 6, nUkv = (1024 / 32) * 4;
        for (int it = gw; it < nIn + nOut + nUq + nUkv; it += ngw) {
            int r = it;
            if (r < nIn) { prep_item(P.in[I_ABWIN] + (size_t)li * 1024 * AB_IN, 1024, AB_IN, ws_bf(P, WS_WIN), MAP_IN_EVEN, nullptr, scr, r, lane); continue; } r -= nIn;
            if (r < nOut) { prep_item(P.in[I_ABWOUT] + (size_t)li * 1024 * 1024, 1024, 1024, ws_bf(P, WS_WOUT0), MAP_OUT, nullptr, scr, r, lane); continue; } r -= nOut;
            if (r < nUq) { prep_item(P.in[I_WUQ] + (size_t)li * 384 * 768, 384, 768, ws_bf(P, WS_WUQ), MAP_UQ, P.in[I_QNG] + li * 384, scr, r, lane); continue; } r -= nUq;
            prep_item(P.in[I_WUKV] + (size_t)li * 256 * 1024, 256, 1024, ws_bf(P, WS_WUKV), MAP_UKV, nullptr, scr, r, lane);
        }
    }
}
__device__ void fast_biasL(CParams& P, long gt, long gn) {
    float* biasl = ws_f32(P, WS_BIASL); const float* mod = ws_f32(P, WS_MOD);
    for (long i = gt; i < 4L * 5 * 2816; i += gn) {
        const int n = (int)(i % 2816), c = (int)((i / 2816) % 5), l = (int)(i / (2816 * 5));
        const int N = (l & 1) ? WIN_IN : AB_IN; float s = 0.f;
        const int sc = (n < ((l & 1) ? 2560 : 2816)) ? srccol((l & 1) ? MAP_IN_ODD : MAP_IN_EVEN, n) : -1;
        if (sc >= 0) { const float* w = ((l & 1) ? P.in[I_WWIN] : P.in[I_ABWIN]) + (size_t)(l >> 1) * 1024 * N + sc; const float* sh = mod + (l * 5 + c) * 3072;
            for (int k = 0; k < 1024; ++k) s += sh[k] * w[(size_t)k * N]; }
        biasl[i] = s;
    }
}

#define EPI_ROW(ai, m) (u.pm * 256 + (ai) * 128 + wr * 64 + (m) * 16 + fr)
typedef f32x4 AccT[2][2][4][2];

struct EpiOut {
    static constexpr bool PERM = false, AFTER_DRAIN = false;
    CParams* Pp; int layer;
    __device__ __forceinline__ void operator()(const AccT& acc, const pg8::Unit& u, int wr, int wc, int fr_, int fq_) const {
        int fr = fr_, fq = fq_; asm volatile("" : "+v"(fr), "+v"(fq));
        CParams* Pl = Pp; asm volatile("" : "+s"(Pl)); CParams& P = *Pl;
        const int cond = u.pm < 32 ? 4 : (u.pm - 32) >> 4;
        const float* gate = ws_f32(P, WS_MOD) + (layer * 5 + cond) * 3072 + 2048; const float* gsn = ws_f32(P, WS_GS) + ((layer + 1) * 5 + cond) * 1024;
        bf16_t* An = ws_bf(P, (layer & 1) ? WS_AEVEN : WS_AODD); float* SS = ws_f32(P, WS_SS);
        float ssq[2][4];
#pragma unroll
        for (int ai = 0; ai < 2; ++ai)
#pragma unroll
            for (int m = 0; m < 4; ++m) ssq[ai][m] = 0.f;
#pragma unroll
        for (int bj = 0; bj < 2; ++bj) {
            const int col = u.pn * 256 + 128 * bj + 32 * wc + 8 * fq;
            const f32x4 g0 = *(const f32x4*)(gate + col), g1 = *(const f32x4*)(gate + col + 4);
            f32x4 s0 = {0.f, 0.f, 0.f, 0.f}, s1 = s0; if (layer < 3) { s0 = *(const f32x4*)(gsn + col); s1 = *(const f32x4*)(gsn + col + 4); }
#pragma unroll
            for (int ai = 0; ai < 2; ++ai)
#pragma unroll
                for (int m = 0; m < 4; ++m) {
                    const int row = EPI_ROW(ai, m); const float* yo = y_row(P, layer, row) + col; float* yn = P.out + (size_t)row * 1024 + col;
                    const f32x4 y0 = *(const f32x4*)(yo) + g0 * acc[ai][bj][m][0], y1 = *(const f32x4*)(yo + 4) + g1 * acc[ai][bj][m][1];
                    *(f32x4*)(yn) = y0; *(f32x4*)(yn + 4) = y1; ssq[ai][m] += sum4sq(y0) + sum4sq(y1);
                    if (layer < 3) *(u32x4*)(An + (size_t)row * 1024 + col) = pk8(y0 * s0, y1 * s1);
                    if (m & 1) asm volatile("" ::: "memory");
                }
        }
        if (layer < 3) {
#pragma unroll
            for (int ai = 0; ai < 2; ++ai)
#pragma unroll
                for (int m = 0; m < 4; ++m) { const float s = fq_sum(ssq[ai][m]); if (fq == 0) SS[EPI_ROW(ai, m) * 16 + u.pn * 4 + wc] = s; }
        }
    }
};

__device__ __forceinline__ void rope4(f32x4& x0, f32x4& x1, const float* cs) {
    const f32x4 a = *(const f32x4*)cs, b = *(const f32x4*)(cs + 4);
    const f32x4 c = {a[0], a[2], b[0], b[2]}, s = {a[1], a[3], b[1], b[3]};
    const f32x4 y0 = x0 * c - x1 * s, y1 = x0 * s + x1 * c; x0 = y0; x1 = y1;
}

template <bool ODD> struct EpiIn {
    static constexpr bool PERM = false, AFTER_DRAIN = false;
    CParams* Pp; int layer; LAS float* xch;
    __device__ __forceinline__ void operator()(const AccT& acc, const pg8::Unit& u, int wr, int wc, int fr_, int fq_) const {
        int fr = fr_, fq = fq_; asm volatile("" : "+v"(fr), "+v"(fq));
        CParams* Pl = Pp; asm volatile("" : "+s"(Pl)); CParams& P = *Pl;
        const int pn = u.pn; const bool sample = u.pm >= 32; const int cond = sample ? (u.pm - 32) >> 4 : 4; const int li = layer >> 1;
        const float* SS = ws_f32(P, WS_SS); const float* biasl = ws_f32(P, WS_BIASL) + (layer * 5 + cond) * 2816 + pn * 256;
        const float* r16 = ws_f32(P, WS_ROPE16);
        f32x4 bv[2][2];
#pragma unroll
        for (int bj = 0; bj < 2; ++bj)
#pragma unroll
            for (int n = 0; n < 2; ++n) bv[bj][n] = *(const f32x4*)(biasl + 128 * bj + 32 * wc + 16 * n + 4 * fq);
        enum { K_NAT_G, K_ROPEHEAD, K_V, K_CQ0, K_CQ1, K_CKV, K_RV };
        int kind; bf16_t* gdst = nullptr;
        if (ODD) { kind = pn < 5 ? K_ROPEHEAD : (pn == 5 ? K_V : K_NAT_G); if (pn >= 6) gdst = ws_bf(P, WS_G) + (pn - 6) * 256; }
        else { kind = pn == 0 ? K_CQ0 : pn == 1 ? K_CQ1 : pn == 2 ? K_CKV : pn < 7 ? K_NAT_G : pn < 9 ? K_ROPEHEAD : K_RV; if (pn >= 3 && pn < 7) gdst = ws_bf(P, WS_G) + (pn - 3) * 256; }
        const float* hg = nullptr; f32x4 hgv[2][2];
        if (ODD && pn < 5) { hg = (pn < 4 ? P.in[I_WQHG] : P.in[I_WKHG]) + li * 64;
#pragma unroll
            for (int bj = 0; bj < 2; ++bj)
#pragma unroll
                for (int n = 0; n < 2; ++n) hgv[bj][n] = *(const f32x4*)(hg + 32 * bj + 16 * n + 4 * fq); }
        if (!ODD && kind == K_CKV) {
#pragma unroll
            for (int ai = 0; ai < 2; ++ai)
#pragma unroll
                for (int m = 0; m < 4; ++m) { const int row = EPI_ROW(ai, m); const float rs = row_rstd(SS, row); float s = 0.f;
#pragma unroll
                    for (int bj = 0; bj < 2; ++bj)
#pragma unroll
                        for (int n = 0; n < 2; ++n) s += sum4sq(acc[ai][bj][m][n] * rs + bv[bj][n]);
                    s = fq_sum(s); if (fq == 0) xch[(ai * 128 + wr * 64 + m * 16 + fr) * 4 + wc] = s; }
            asm volatile("s_waitcnt lgkmcnt(0)" ::: "memory"); __builtin_amdgcn_s_barrier(); asm volatile("" ::: "memory");
        }
#pragma unroll
        for (int ai = 0; ai < 2; ++ai)
#pragma unroll
            for (int m = 0; m < 4; ++m) {
                const int row = EPI_ROW(ai, m); const float rs = row_rstd(SS, row);
                f32x4 v[2][2];
#pragma unroll
                for (int bj = 0; bj < 2; ++bj)
#pragma unroll
                    for (int n = 0; n < 2; ++n) v[bj][n] = acc[ai][bj][m][n] * rs + bv[bj][n];
                const int t = (row - NP_ROWS) & 4095, pr = t >> 6, pc = t & 63;
                if (kind == K_NAT_G) {
#pragma unroll
                    for (int bj = 0; bj < 2; ++bj) { f32x4 a = v[bj][0], b = v[bj][1];
#pragma unroll
                        for (int e = 0; e < 4; ++e) { a[e] = silu_f(a[e]); b[e] = silu_f(b[e]); }
                        *(u32x4*)(gdst + (size_t)row * 1024 + 128 * bj + 32 * wc + 8 * fq) = pk8(a, b); }
                } else if (kind == K_ROPEHEAD) {
                    if (ODD) {
                        float s = 0.f;
#pragma unroll
                        for (int bj = 0; bj < 2; ++bj) s += sum4sq(v[bj][0]) + sum4sq(v[bj][1]);
                        s = fq_sum(s); const float hr = 1.0f / sqrtf(s * (1.f / 64.f) + EPS);
#pragma unroll
                        for (int bj = 0; bj < 2; ++bj)
#pragma unroll
                            for (int n = 0; n < 2; ++n) v[bj][n] = v[bj][n] * hr * hgv[bj][n];
                        if (pn == 4 && !sample) { float* ok = P.out + (layer == 1 ? O_L1K : O_L3K) + (size_t)row * 256 + wc * 64;
#pragma unroll
                            for (int bj = 0; bj < 2; ++bj)
#pragma unroll
                                for (int n = 0; n < 2; ++n) *(f32x4*)(ok + 32 * bj + 16 * n + 4 * fq) = v[bj][n]; }
                        if (sample) { rope4(v[0][0], v[0][1], r16 + (pr * 16 + 4 * fq) * 2); rope4(v[1][0], v[1][1], r16 + (pc * 16 + 4 * fq) * 2); }
                        if (pn < 4) { const float qs = 0.125f * LOG2E; bf16_t* q = ws_bf(P, WS_QW) + (size_t)row * 1024 + (4 * pn + wc) * 64 + 16 * fq;
                            *(u32x4*)(q) = pk8(v[0][0] * qs, v[0][1] * qs); *(u32x4*)(q + 8) = pk8(v[1][0] * qs, v[1][1] * qs);
                        } else { int kin; const int tile = kv_tile(row, wc, 4, kin); unsigned char* kb = P.ws + WS_KWIMG + (size_t)tile * 8192 + kin * 16;
                            *(u32x4*)(kb + (2 * fq) * 1024) = pk8(v[0][0], v[0][1]); *(u32x4*)(kb + (2 * fq + 1) * 1024) = pk8(v[1][0], v[1][1]); }
                    } else {
                        if (pn == 7) {
#pragma unroll
                            for (int bj = 0; bj < 2; ++bj) { v[bj][0] = v[bj][0] * 0.125f; v[bj][1] = v[bj][1] * 0.125f; } }
                        if (sample) { rope4(v[0][0], v[0][1], r16 + (pr * 16 + 4 * fq) * 2); rope4(v[1][0], v[1][1], r16 + (pc * 16 + 4 * fq) * 2); }
                        bf16_t* q = ws_bf(P, pn == 7 ? WS_RQ : WS_RK) + (size_t)row * 256 + wc * 64 + 16 * fq;
                        *(u32x4*)(q) = pk8(v[0][0], v[0][1]); *(u32x4*)(q + 8) = pk8(v[1][0], v[1][1]);
                    }
                } else if (kind == K_V) {
                    if (!sample) { float* ov = P.out + (layer == 1 ? O_L1V : O_L3V) + (size_t)row * 256 + wc * 64 + 16 * fq;
#pragma unroll
                        for (int bj = 0; bj < 2; ++bj) { *(f32x4*)(ov + 8 * bj) = v[bj][0]; *(f32x4*)(ov + 8 * bj + 4) = v[bj][1]; } }
                    int kin; const int tile = kv_tile(row, wc, 4, kin); unsigned char* vb = P.ws + WS_VWIMG + (size_t)tile * 8192 + (fq >> 1) * 4096 + kin * 64 + (fq & 1) * 32;
                    *(u32x4*)(vb) = pk8(v[0][0], v[0][1]); *(u32x4*)(vb + 16) = pk8(v[1][0], v[1][1]);
                } else if (kind == K_CQ0 || kind == K_CQ1) {
                    bf16_t* cq = ws_bf(P, WS_CQ) + (size_t)row * 384; float* sscq = ws_f32(P, WS_SSCQ);
                    if (kind == K_CQ0) {
#pragma unroll
                        for (int bj = 0; bj < 2; ++bj) *(u32x4*)(cq + 128 * bj + 32 * wc + 8 * fq) = pk8(v[bj][0], v[bj][1]);
                        float s = sum4sq(v[0][0]) + sum4sq(v[0][1]) + sum4sq(v[1][0]) + sum4sq(v[1][1]); s = fq_sum(s); if (fq == 0) sscq[row * 8 + wc] = s;
                    } else {
                        *(u32x4*)(cq + 256 + 32 * wc + 8 * fq) = pk8(v[0][0], v[0][1]);
                        float s = sum4sq(v[0][0]) + sum4sq(v[0][1]); s = fq_sum(s); if (fq == 0) sscq[row * 8 + 4 + wc] = s;
                        if (wc == 0) {
                            *(u32x4*)(ws_bf(P, WS_KR) + (size_t)row * 32 + 8 * fq) = pk8(v[1][0], v[1][1]);
                            float s2 = sum4sq(v[1][0]) + sum4sq(v[1][1]); s2 = fq_sum(s2); if (fq == 0) ws_f32(P, WS_SSKR)[row] = s2;
                            if (!sample) { float* okr = P.out + (layer == 0 ? O_L0KR : O_L2KR) + (size_t)row * 32 + 16 * (fq >> 1) + 4 * (fq & 1); *(f32x4*)(okr) = v[1][0]; *(f32x4*)(okr + 8) = v[1][1]; }
                        }
                    }
                } else if (kind == K_CKV) {
                    const LAS float* xr = xch + (ai * 128 + wr * 64 + m * 16 + fr) * 4; const float s = (xr[0] + xr[1]) + (xr[2] + xr[3]);
                    const float cr = 1.0f / sqrtf(s * (1.f / 256.f) + EPS); const float* gkv = P.in[I_KVNG] + li * 256;
#pragma unroll
                    for (int bj = 0; bj < 2; ++bj) { const int col = 128 * bj + 32 * wc + 8 * fq;
                        const f32x4 a = v[bj][0] * cr * *(const f32x4*)(gkv + col), b = v[bj][1] * cr * *(const f32x4*)(gkv + col + 4);
                        *(u32x4*)(ws_bf(P, WS_CKVN) + (size_t)row * 256 + col) = pk8(a, b);
                        if (!sample) { float* oc = P.out + (layer == 0 ? O_L0CKV : O_L2CKV) + (size_t)row * 256 + col; *(f32x4*)(oc) = a; *(f32x4*)(oc + 4) = b; } }
                } else {
                    bf16_t* rv = ws_bf(P, WS_RV) + (size_t)row * 512 + (2 * (pn - 9) + (wc >> 1)) * 128 + 64 * (wc & 1) + 16 * fq;
                    *(u32x4*)(rv) = pk8(v[0][0], v[0][1]); *(u32x4*)(rv + 8) = pk8(v[1][0], v[1][1]);
                }
            }
        if (!ODD && kind == K_CKV) { asm volatile("s_waitcnt lgkmcnt(0)" ::: "memory"); __builtin_amdgcn_s_barrier(); asm volatile("" ::: "memory"); }
    }
};

struct EpiUq {
    static constexpr bool PERM = false, AFTER_DRAIN = false;
    CParams* Pp; int layer;
    __device__ __forceinline__ void operator()(const AccT& acc, const pg8::Unit& u, int wr, int wc, int fr_, int fq_) const {
        int fr = fr_, fq = fq_; asm volatile("" : "+v"(fr), "+v"(fq));
        CParams* Pl = Pp; asm volatile("" : "+s"(Pl)); CParams& P = *Pl;
        bf16_t* QR = ws_bf(P, WS_QR); const float* sscq = ws_f32(P, WS_SSCQ);
#pragma unroll
        for (int ai = 0; ai < 2; ++ai)
#pragma unroll
            for (int m = 0; m < 4; ++m) { const int row = EPI_ROW(ai, m);
                float s = sum4sq(acc[ai][0][m][0]) + sum4sq(acc[ai][0][m][1]) + sum4sq(acc[ai][1][m][0]) + sum4sq(acc[ai][1][m][1]);
                if (u.pn < 2) { const int head = 4 * u.pn + wc; bf16_t* q = QR + ((size_t)row * 8 + head) * 96 + 16 * fq;
                    *(u32x4*)(q) = pk8(acc[ai][0][m][0], acc[ai][0][m][1]); *(u32x4*)(q + 8) = pk8(acc[ai][1][m][0], acc[ai][1][m][1]);
                    s = fq_sum(s);
                    if (fq == 0) { float c = 0.f;
#pragma unroll
                        for (int j = 0; j < 8; ++j) c += sscq[row * 8 + j];
                        ws_f32(P, WS_SSQN)[row * 8 + head] = s + 96.f * EPS * (c * (1.f / 384.f) + EPS); }
                } else { const int head = 2 * wc + (fq >> 1); bf16_t* q = QR + ((size_t)row * 8 + head) * 96 + 64 + 16 * (fq & 1);
                    *(u32x4*)(q) = pk8(acc[ai][0][m][0], acc[ai][0][m][1]); *(u32x4*)(q + 8) = pk8(acc[ai][1][m][0], acc[ai][1][m][1]);
                    s += xor_shfl<16>(s);
                    if ((fq & 1) == 0) ws_f32(P, WS_SSQR)[row * 8 + head] = s; }
            }
    }
};

struct EpiUkv {
    static constexpr bool PERM = false, AFTER_DRAIN = false;
    CParams* Pp; int layer;
    __device__ __forceinline__ void operator()(const AccT& acc, const pg8::Unit& u, int wr, int wc, int fr_, int fq_) const {
        int fr = fr_, fq = fq_; asm volatile("" : "+v"(fr), "+v"(fq));
        CParams* Pl = Pp; asm volatile("" : "+s"(Pl)); CParams& P = *Pl;
        const int li = layer >> 1; const float* gk = P.in[I_KHG] + li * 96; const float* r8 = ws_f32(P, WS_ROPE8); const float* sskr = ws_f32(P, WS_SSKR); const bf16_t* KR = ws_bf(P, WS_KR);
        const bool lat = (u.pm >= 32 && u.pm < 96);
#pragma unroll
        for (int ai = 0; ai < 2; ++ai)
#pragma unroll
            for (int m = 0; m < 4; ++m) { const int R = EPI_ROW(ai, m);
                if (u.pn < 2) { const int head = 4 * u.pn + wc; int kin; const int tile = kv_tile(R, head, 8, kin); unsigned char* kb = P.ws + WS_KIMG + (size_t)tile * 12288 + kin * 16;
                    float s = sum4sq(acc[ai][0][m][0]) + sum4sq(acc[ai][0][m][1]) + sum4sq(acc[ai][1][m][0]) + sum4sq(acc[ai][1][m][1]);
                    s = fq_sum(s) + sskr[R]; const float rs = 1.0f / sqrtf(s * (1.f / 96.f) + EPS);
#pragma unroll
                    for (int bj = 0; bj < 2; ++bj) { const float* g = gk + 16 * fq + 8 * bj;
                        *(u32x4*)(kb + (2 * fq + bj) * 1024) = pk8(acc[ai][bj][m][0] * rs * *(const f32x4*)(g), acc[ai][bj][m][1] * rs * *(const f32x4*)(g + 4)); }
                    const u32x4 kr = *(const u32x4*)(KR + (size_t)R * 32 + 8 * fq); const int jb = 16 * (fq >> 1) + 4 * (fq & 1);
                    f32x4 x1 = {__uint_as_float(kr.x << 16), __uint_as_float(kr.x & 0xffff0000u), __uint_as_float(kr.y << 16), __uint_as_float(kr.y & 0xffff0000u)};
                    f32x4 x2 = {__uint_as_float(kr.z << 16), __uint_as_float(kr.z & 0xffff0000u), __uint_as_float(kr.w << 16), __uint_as_float(kr.w & 0xffff0000u)};
                    x1 = x1 * rs * *(const f32x4*)(gk + 64 + jb); x2 = x2 * rs * *(const f32x4*)(gk + 64 + jb + 8);
                    if (lat) { const int t = (R - NP_ROWS) & 4095; const int pos = (fq >> 1) ? (t & 63) : (t >> 6); rope4(x1, x2, r8 + (pos * 8 + 4 * (fq & 1)) * 2); }
                    *(u32x4*)(kb + (8 + fq) * 1024) = pk8(x1, x2);
                } else { const int head = 4 * (u.pn - 2) + wc; int kin; const int tile = kv_tile(R, head, 8, kin);
                    unsigned char* vb = P.ws + WS_VIMG + (size_t)tile * 8192 + (fq >> 1) * 4096 + kin * 64 + (fq & 1) * 32;
                    *(u32x4*)(vb) = pk8(acc[ai][0][m][0], acc[ai][0][m][1]); *(u32x4*)(vb + 16) = pk8(acc[ai][1][m][0], acc[ai][1][m][1]); }
            }
    }
};
typedef __attribute__((address_space(1))) unsigned gu32;
#define XB_TMO      128
#define XB_XCNT(j)  (256  + 64 * (j))
#define XB_XSUB(j)  (1280 + 64 * (j))
#define XB_XGEN(j)  (2304 + 64 * (j))
#define XB_TOP      3328
#define XB_TOPGEN   3392
#define XCD_BAR_WORDS 3456
#define XB_SPIN_CAP (1u << 26)
__device__ __forceinline__ unsigned xb_ld(unsigned* p)              { return __hip_atomic_load(p, __ATOMIC_RELAXED, __HIP_MEMORY_SCOPE_AGENT); }
__device__ __forceinline__ unsigned xb_add(unsigned* p, unsigned v) { return __hip_atomic_fetch_add(p, v, __ATOMIC_RELAXED, __HIP_MEMORY_SCOPE_AGENT); }
__device__ __forceinline__ unsigned xb_xcc_id() { return (unsigned)__builtin_amdgcn_s_getreg((3 << 11) | 20) & 0xFu; }
#define XB_SPIN(cond, bar) do { unsigned _sp = 0; while (cond) { __builtin_amdgcn_s_sleep(1); \
    if ((++_sp & 255u) == 0u) { if (xb_ld(&(bar)[XB_TMO])) break; if (_sp > XB_SPIN_CAP) { atomicAdd(&(bar)[XB_TMO], 1u); break; } } } } while (0)
struct XcdBarrier { unsigned* bar; unsigned x; volatile LAS unsigned* st; };
__device__ __forceinline__ XcdBarrier xcd_barrier_post(unsigned* bar, volatile LAS unsigned* st, bool t0) {
    XcdBarrier b; b.bar = bar; b.x = xb_xcc_id(); b.st = st;
    if (t0) (void)xb_add(&bar[XB_XCNT(b.x)], 1u);
    return b;
}
__device__ __forceinline__ void xcd_barrier_complete(unsigned* bar, unsigned x, unsigned& nloc, unsigned& nx) {
    const unsigned G = gridDim.x * gridDim.y * gridDim.z;
    unsigned sum, cnt, mine, sp = 0u;
    for (;;) {
        sum = 0u; cnt = 0u; mine = 0u;
#pragma unroll
        for (unsigned j = 0; j < 16; ++j) { const unsigned c = xb_ld(&bar[XB_XCNT(j)]); sum += c; cnt += (c > 0u) ? 1u : 0u; mine = (j == x) ? c : mine; }
        if (sum == G) break;
        __builtin_amdgcn_s_sleep(1);
        if ((++sp & 255u) == 0u) { if (xb_ld(&bar[XB_TMO])) break; if (sp > XB_SPIN_CAP) { atomicAdd(&bar[XB_TMO], 1u); break; } }
    }
    nloc = mine > 0u ? mine : 1u; nx = cnt > 0u ? cnt : 1u;
}
__device__ __forceinline__ void xcd_barrier(const XcdBarrier& b, bool t0) {
    asm volatile("s_waitcnt vmcnt(0)" ::: "memory");
    __syncthreads();
    if (t0) {
        unsigned* bar = b.bar;
        __builtin_amdgcn_s_waitcnt(0);
        unsigned nloc = b.st[0], nx = b.st[1];
        if (nloc == 0u) { xcd_barrier_complete(bar, b.x, nloc, nx); b.st[0] = nloc; b.st[1] = nx; }
        const unsigned old = xb_add(&bar[XB_XSUB(b.x)], 1u);
        const unsigned gen = old / nloc;
        if (old + 1u == (gen + 1u) * nloc) {
            __builtin_amdgcn_fence(__ATOMIC_RELEASE, "agent");
            asm volatile("s_waitcnt vmcnt(0)" ::: "memory");
            const unsigned og = xb_add(&bar[XB_TOP], 1u);
            const unsigned tg = og / nx;
            if (og + 1u == (tg + 1u) * nx) xb_add(&bar[XB_TOPGEN], 1u);
            else XB_SPIN(xb_ld(&bar[XB_TOPGEN]) == tg, bar);
            __builtin_amdgcn_fence(__ATOMIC_ACQUIRE, "agent");
            xb_add(&bar[XB_XGEN(b.x)], 1u);
            asm volatile("s_waitcnt vmcnt(0)" ::: "memory");
        } else {
            XB_SPIN(xb_ld(&bar[XB_XGEN(b.x)]) == gen, bar);
            __builtin_amdgcn_fence(__ATOMIC_ACQUIRE, "agent");
            asm volatile("s_waitcnt vmcnt(0)" ::: "memory");
        }
    }
    __syncthreads();
}

#ifndef FAST_OUT
#define FAST_OUT 1
#endif
#ifndef FAST_IN_ODD
#define FAST_IN_ODD 1
#endif
#ifndef FAST_IN_EVEN
#define FAST_IN_EVEN 1
#endif
#ifndef FAST_UQ
#define FAST_UQ 1
#endif
#ifndef FAST_UKV
#define FAST_UKV 1
#endif

enum { K_P0 = 0, K_P1, K_E_IN, K_E_POST, K_E_UQ, K_E_UQSS, K_E_UKV, K_E_KPOST, K_E_SCAN, K_E_ATTN, K_E_OUT, K_E_PREPA, K_O_IN, K_O_POST, K_O_ATTN, K_O_OUT, K_O_PREPA };
template <int KIND, int LAYER> __device__ __forceinline__ void run_phase(LAS unsigned char* L, int wave_s) {
    constexpr int kind = KIND, layer = LAYER;
    CParams* Pq = params_ptr();
#define P (*Pq)
    int ws_ = wave_s; asm volatile("" : "+s"(ws_)); int ln_ = lane_id(); asm volatile("" : "+v"(ln_));
    const int wave = ws_, lane = ln_, tid = wave * 64 + lane;
    const int G = gridDim.x; const long gn = (long)G * NTHREADS, gt = (long)blockIdx.x * NTHREADS + tid; const int gw = blockIdx.x * NWAVES + wave, ngw = G * NWAVES;
    LAS float* wscr = (LAS float*)(L + wave * 16384);
    LAS float* xch = (LAS float*)(L + EPI_OFF);
    (void)lane; (void)gw; (void)ngw; (void)gt; (void)gn; (void)wscr; (void)xch;
    if constexpr (kind == K_P0) {
        nv_zero_bnd(P, 0, gt, gn); nv_mod(P, 0, gt, gn); prep_layer_weights(P, 0, wscr, gw, ngw, lane); nv_ctx_even(P, 0, gt, gn);
    } else if constexpr (kind == K_P1) {
        nv_gs(P, 0, gt, gn); nv_bias(P, 0, gt, gn); fast_biasL(P, gt, gn); nv_prepA(P, 0, gt, gn);
    } else if constexpr (kind == K_E_IN) {
#if FAST_IN_EVEN
        pg8::Gemm g{ws_bf(P, WS_AEVEN), ws_bf(P, WS_WIN), MROWS, 2816, 1024, 1024}; pg8::StaticOrder S; S.init(MROWS, 2816, G, (int)blockIdx.x);
        EpiIn<false> E{Pq, layer, xch}; pg8::gemm_phase<EpiIn<false>, pg8::StaticOrder, true, true>(L, g, S, E, wave_s);
#else
        nv_in_even(P, layer, gt, gn);
#endif
    } else if constexpr (kind == K_E_POST) { nv_post_even(P, layer, gt, gn);
    } else if constexpr (kind == K_E_UQ) {
#if FAST_UQ
        pg8::Gemm g{ws_bf(P, WS_CQ), ws_bf(P, WS_WUQ), MROWS, 768, 384, 384}; pg8::StaticOrder S; S.init(MROWS, 768, G, (int)blockIdx.x);
        EpiUq E{Pq, layer}; pg8::gemm_phase<EpiUq, pg8::StaticOrder, true, true>(L, g, S, E, wave_s);
#else
        nv_uq(P, layer, gt, gn);
#endif
    } else if constexpr (kind == K_E_UQSS) { nv_uq_ss(P, layer, gt, gn);
    } else if constexpr (kind == K_E_UKV) {
#if FAST_UKV
        { pg8::Gemm g{ws_bf(P, WS_CKVN), ws_bf(P, WS_WUKV), MROWS_X, 1024, 256, 256}; pg8::StaticOrder S; S.init(MROWS_X, 1024, G, (int)blockIdx.x);
          EpiUkv E{Pq, layer}; pg8::gemm_phase<EpiUkv, pg8::StaticOrder, true, true>(L, g, S, E, wave_s); }
#else
        nv_ukv(P, layer, gt, gn);
#endif
        nv_u(P, layer, gt, gn);
    } else if constexpr (kind == K_E_KPOST) { nv_k_post(P, layer, gt, gn);
    } else if constexpr (kind == K_E_SCAN) { nv_scan(P, layer, gt, gn);
    } else if constexpr (kind == K_E_ATTN) { nv_mla_attn(P, layer, gt, gn); nv_ret_out(P, layer, gt, gn);
    } else if constexpr (kind == K_O_IN) {
#if FAST_IN_ODD
        pg8::Gemm g{ws_bf(P, WS_AODD), ws_bf(P, WS_WIN), MROWS, 2560, 1024, 1024}; pg8::StaticOrder S; S.init(MROWS, 2560, G, (int)blockIdx.x);
        EpiIn<true> E{Pq, layer, xch}; pg8::gemm_phase<EpiIn<true>, pg8::StaticOrder, true, true>(L, g, S, E, wave_s);
#else
        nv_in_odd(P, layer, gt, gn);
#endif
    } else if constexpr (kind == K_O_POST) { nv_post_odd(P, layer, gt, gn);
    } else if constexpr (kind == K_O_ATTN) { nv_win_attn(P, layer, gt, gn);
    } else if constexpr (kind == K_E_OUT || kind == K_O_OUT) {
        if constexpr (layer < 3) { prep_layer_weights(P, layer + 1, wscr, gw, ngw, lane); if constexpr ((layer + 1) & 1) nv_ctx_odd(P, layer + 1, gt, gn); else nv_ctx_even(P, layer + 1, gt, gn); }
        __syncthreads();
#if FAST_OUT
        pg8::Gemm g{ws_bf(P, WS_G), ws_bf(P, (layer & 1) ? WS_WOUT1 : WS_WOUT0), MROWS, 1024, 1024, 1024}; pg8::StaticOrder S; S.init(MROWS, 1024, G, (int)blockIdx.x);
        EpiOut E{Pq, layer}; pg8::gemm_phase<EpiOut, pg8::StaticOrder, true, true>(L, g, S, E, wave_s);
#else
        nv_out(P, layer, gt, gn);
#endif
    } else {   nv_prepA(P, layer + 1, gt, gn); }
#undef P
}
__device__ __forceinline__ void grid_bar(volatile LAS unsigned* MISC, int wave_s) {
    CParams* Pb = params_ptr(); XcdBarrier bar; bar.bar = (unsigned*)(Pb->ws + WS_CTL) + 4096; bar.x = xb_xcc_id(); bar.st = MISC + 8; xcd_barrier(bar, wave_s == 0 && lane_id() == 0);
}
#define PH(kind, layer) do { run_phase<kind, layer>(L, wave_s); grid_bar(MISC, wave_s); } while (0)
template <int LAYER> __device__ __forceinline__ void even_layer(LAS unsigned char* L, volatile LAS unsigned* MISC, int wave_s) {
    PH(K_E_IN, LAYER);
    if constexpr (!FAST_IN_EVEN) PH(K_E_POST, LAYER);
    PH(K_E_UQ, LAYER);
    if constexpr (!FAST_UQ) PH(K_E_UQSS, LAYER);
    PH(K_E_UKV, LAYER);
    if constexpr (!FAST_UKV) PH(K_E_KPOST, LAYER);
    PH(K_E_SCAN, LAYER);
    PH(K_E_ATTN, LAYER);
    PH(K_E_OUT, LAYER);
    if constexpr (!FAST_OUT) PH(K_E_PREPA, LAYER);
}
template <int LAYER> __device__ __forceinline__ void odd_layer(LAS unsigned char* L, volatile LAS unsigned* MISC, int wave_s) {
    PH(K_O_IN, LAYER);
    if constexpr (!FAST_IN_ODD) PH(K_O_POST, LAYER);
    PH(K_O_ATTN, LAYER);
    if constexpr (LAYER == 3) { run_phase<K_O_OUT, LAYER>(L, wave_s); }
    else { PH(K_O_OUT, LAYER); if constexpr (!FAST_OUT) PH(K_O_PREPA, LAYER); }
}
__global__ void __launch_bounds__(NTHREADS, 2) mk_fwd(Params P_) {
    extern __shared__ __attribute__((aligned(16))) unsigned char lds[];
    LAS unsigned char* L = (LAS unsigned char*)lds;
    volatile LAS unsigned* MISC = (volatile LAS unsigned*)(L + MISC_OFF);
    const int wave_s = __builtin_amdgcn_readfirstlane(threadIdx.x >> 6);
    if (wave_s == 0 && lane_id() < 32) MISC[lane_id()] = 0u;
    __syncthreads();
    { CParams* P0 = params_ptr(); (void)xcd_barrier_post((unsigned*)(P0->ws + WS_CTL) + 4096, MISC + 8, wave_s == 0 && lane_id() == 0); }
    PH(K_P0, 0); PH(K_P1, 0);
    even_layer<0>(L, MISC, wave_s); odd_layer<1>(L, MISC, wave_s); even_layer<2>(L, MISC, wave_s); odd_layer<3>(L, MISC, wave_s);
}
extern "C" void kernel_launch(void* const* d_in, const int* in_sizes, int n_in, void* d_out, int out_size, void* d_ws, size_t ws_size, hipStream_t stream) {
    if (n_in != N_INPUTS || ws_size < WS_END || (size_t)out_size != O_END) { fprintf(stderr, "kernel_launch: unexpected shapes (n_in %d, out %d, ws %zu)\n", n_in, out_size, ws_size); return; }
    static int grid = 0;
    if (grid == 0) {
        int dev = 0, cus = 0;
        if (hipGetDevice(&dev) != hipSuccess || hipDeviceGetAttribute(&cus, hipDeviceAttributeMultiprocessorCount, dev) != hipSuccess) { grid = -1; return; }
        if (hipFuncSetAttribute((const void*)mk_fwd, hipFuncAttributeMaxDynamicSharedMemorySize, LDS_BYTES) != hipSuccess) { grid = -1; return; }
        grid = cus;
    }
    if (grid < 0) return;
    (void)hipMemsetAsync((char*)d_ws + WS_CTL, 0, 1 * MiB, stream);
    Params P{};
    for (int i = 0; i < N_INPUTS; ++i) P.in[i] = (const float*)d_in[i];
    P.out = (float*)d_out; P.ws = (unsigned char*)d_ws; P.ph_lo = 0; P.ph_hi = 0;
    hipLaunchKernelGGL(mk_fwd, dim3(grid), dim3(NTHREADS), LDS_BYTES, stream, P);
}
```

```cpp
#include <hip/hip_runtime.h>
#include <cstdio>
#include <cstdint>

constexpr int DM = 1024;
constexpr int NP_ROWS = 32 * 256;
constexpr int NS_ROWS = 4 * 4096;
constexpr int MROWS = NP_ROWS + NS_ROWS;
constexpr int CTX_ROWS = 4 * 512;
constexpr int MROWS_X = MROWS + CTX_ROWS;
constexpr float EPS = 1e-6f;
constexpr float LOG2E = 1.4426950408889634f;
constexpr int AB_IN = 2720, WIN_IN = 2560;

enum { I_XP = 0, I_XS, I_C0CKV, I_C0KR, I_S0F, I_S0B, I_C1K, I_C1V, I_C2CKV, I_C2KR, I_S2F, I_S2B, I_C3K, I_C3V, I_C, I_CCTX, I_ADAW, I_ADAB, I_NORMG,
       I_ABWIN, I_QNG, I_WUQ, I_KVNG, I_WUKV, I_QHG, I_KHG, I_DECAY, I_RNG, I_ABWOUT, I_WWIN, I_WQHG, I_WKHG, I_SINK, I_WWOUT, N_INPUTS };

constexpr size_t O_Y = 0;
constexpr size_t O_L0CKV = (size_t)MROWS * DM;
constexpr size_t O_L0KR = O_L0CKV + (size_t)NP_ROWS * 256;
constexpr size_t O_L0RF = O_L0KR + (size_t)NP_ROWS * 32;
constexpr size_t O_L0RB = O_L0RF + (size_t)32 * 4 * 64 * 128;
constexpr size_t O_L1K = O_L0RB + (size_t)32 * 4 * 64 * 128;
constexpr size_t O_L1V = O_L1K + (size_t)NP_ROWS * 256;
constexpr size_t O_L2CKV = O_L1V + (size_t)NP_ROWS * 256;
constexpr size_t O_L2KR = O_L2CKV + (size_t)NP_ROWS * 256;
constexpr size_t O_L2RF = O_L2KR + (size_t)NP_ROWS * 32;
constexpr size_t O_L2RB = O_L2RF + (size_t)32 * 4 * 64 * 128;
constexpr size_t O_L3K = O_L2RB + (size_t)32 * 4 * 64 * 128;
constexpr size_t O_L3V = O_L3K + (size_t)NP_ROWS * 256;
constexpr size_t O_END = O_L3V + (size_t)NP_ROWS * 256;

constexpr size_t MiB = 1u << 20;
constexpr size_t WS_CTL = 0;
constexpr size_t WS_MOD = 1 * MiB;
constexpr size_t WS_GS = WS_MOD + 4 * 5 * 3072 * 4;
constexpr size_t WS_BIAS = WS_GS + 4 * 5 * 1024 * 4;
constexpr size_t WS_BIASL = WS_BIAS + 4 * 5 * 2816 * 4;
constexpr size_t WS_SS = WS_BIASL + 4 * 5 * 2816 * 4;
constexpr size_t WS_SSCQ = WS_SS + (size_t)MROWS * 16 * 4;
constexpr size_t WS_SSKR = WS_SSCQ + (size_t)MROWS * 8 * 4;
constexpr size_t WS_SSQN = WS_SSKR + (size_t)MROWS_X * 4;
constexpr size_t WS_SSQR = WS_SSQN + (size_t)MROWS * 8 * 4;
constexpr size_t WS_ROPE8 = WS_SSQR + (size_t)MROWS * 8 * 4;
constexpr size_t WS_ROPE16 = WS_ROPE8 + 64 * 8 * 2 * 4;
constexpr size_t WS_BND = WS_ROPE16 + 64 * 16 * 2 * 4;
constexpr size_t WS_MISC_END = WS_BND + 256;
static_assert(WS_MISC_END <= 6 * MiB, "misc region");
constexpr size_t WS_WIN = 6 * MiB;
constexpr size_t WS_WUQ = WS_WIN + (size_t)2816 * 1024 * 2;
constexpr size_t WS_WUKV = WS_WUQ + (size_t)768 * 384 * 2;
constexpr size_t WS_WOUT0 = WS_WUKV + (size_t)1024 * 256 * 2;
constexpr size_t WS_WOUT1 = WS_WOUT0 + (size_t)1024 * 1024 * 2;
constexpr size_t WS_W_END = WS_WOUT1 + (size_t)1024 * 1024 * 2;
static_assert(WS_W_END <= 17 * MiB, "weight region");
constexpr size_t WS_G = 17 * MiB;
constexpr size_t WS_X = WS_G + 48 * MiB;
constexpr size_t WS_RQ = WS_X, WS_RK = WS_X + 12 * MiB, WS_RV = WS_X + 24 * MiB, WS_QW = WS_X;
constexpr size_t WS_Q = WS_X + 48 * MiB;
constexpr size_t WS_QR = WS_Q, WS_CQ = WS_Q + 36 * MiB, WS_AODD = WS_Q;
constexpr size_t WS_URS = WS_CQ;
constexpr size_t WS_CKVN = WS_Q + 54 * MiB;
constexpr size_t WS_KR = WS_CKVN + 13 * MiB;
constexpr size_t WS_KV = WS_KR + (size_t)MROWS_X * 32 * 2;
constexpr size_t WS_KIMG = WS_KV, WS_VIMG = WS_KV + 39 * MiB, WS_AEVEN = WS_KV;
constexpr size_t WS_KWIMG = WS_KV + 39 * MiB, WS_VWIMG = WS_KV + 52 * MiB;
constexpr size_t WS_URP = WS_KV + 65 * MiB;
constexpr size_t WS_END = WS_URP + 8 * MiB;
static_assert(WS_END <= 256 * MiB, "workspace map exceeds 256 MiB");

typedef unsigned short bf16_t;

struct Params {
    const float* in[N_INPUTS];
    float* out;
    unsigned char* ws;
    int ph_lo, ph_hi;
};

typedef const __attribute__((address_space(4))) Params CParams;
__device__ __forceinline__ CParams* params_ptr() { CParams* p = (CParams*)__builtin_amdgcn_kernarg_segment_ptr(); asm volatile("" : "+s"(p)); return p; }

__device__ __forceinline__ float bf2f(bf16_t b) { return __uint_as_float((unsigned)b << 16); }
__device__ __forceinline__ bf16_t f2bf(float f) { unsigned u = __float_as_uint(f); return (bf16_t)((u + 0x7fffu + ((u >> 16) & 1u)) >> 16); }
__device__ __forceinline__ float bfr(float f) { return bf2f(f2bf(f)); }
__device__ __forceinline__ float silu_f(float x) { return x / (1.f + __expf(-x)); }

__device__ __forceinline__ int p2d64(int p) { return 32 * ((p >> 3) & 1) + 16 * ((p >> 2) & 1) + 4 * (p >> 4) + (p & 3); }
__device__ __forceinline__ int d2p64(int d) { return 16 * ((d >> 2) & 3) + 8 * (d >> 5) + 4 * ((d >> 4) & 1) + (d & 3); }
__device__ __forceinline__ int o2j32(int o) { const int grp = o >> 3, w = o & 7; return 16 * (grp >> 1) + 4 * (grp & 1) + (w & 3) + 8 * (w >> 2); }
__device__ __forceinline__ int j2o32(int j) { return 8 * (2 * (j >> 4) + ((j >> 2) & 1)) + 4 * ((j >> 3) & 1) + (j & 3); }

struct RowInfo { int cond; int b; int t; bool sample; };
__device__ __forceinline__ RowInfo row_info(int row) {
    RowInfo r;
    if (row < NP_ROWS) { r.cond = 4; r.b = row >> 8; r.t = row & 255; r.sample = false; }
    else { const int rs = row - NP_ROWS; r.b = rs >> 12; r.t = rs & 4095; r.cond = r.b; r.sample = true; }
    return r;
}
__device__ __forceinline__ int kv_tile(int R, int head, int H, int& kin) {
    if (R < NP_ROWS) { const int b = R >> 8, key = R & 255; kin = key & 63; return (b * H + head) * 4 + (key >> 6); }
    int b, key;
    if (R < MROWS) { const int rs = R - NP_ROWS; b = rs >> 12; key = 512 + (rs & 4095); }
    else { const int rc = R - MROWS; b = rc >> 9; key = rc & 511; }
    kin = key & 63; return 32 * H * 4 + (b * H + head) * 72 + (key >> 6);
}
__device__ __forceinline__ int kv_seq_tile0(bool sample, int b, int head, int H) { return sample ? 32 * H * 4 + (b * H + head) * 72 : (b * H + head) * 4; }

template <int K> __device__ __forceinline__ float xor_shfl(float v) { static_assert(K < 32, "xor_shfl"); return __int_as_float(__builtin_amdgcn_ds_swizzle(__float_as_int(v), (K << 10) | 0x1f)); }
__device__ __forceinline__ float sum_halves(float v) { auto r = __builtin_amdgcn_permlane32_swap(__float_as_uint(v), __float_as_uint(v), false, false); return __uint_as_float(r[0]) + __uint_as_float(r[1]); }
__device__ __forceinline__ float wave_sum(float v) { v += xor_shfl<1>(v); v += xor_shfl<2>(v); v += xor_shfl<4>(v); v += xor_shfl<8>(v); v += xor_shfl<16>(v); return sum_halves(v); }

__device__ __forceinline__ int lane_id() { return (int)__builtin_amdgcn_mbcnt_hi(~0u, __builtin_amdgcn_mbcnt_lo(~0u, 0u)); }

#define NVF(name) __device__ void name(CParams& P, int layer, long gt, long gn)

__device__ __forceinline__ const float* cond_vec(CParams& P, int c) { return c < 4 ? P.in[I_C] + c * 1024 : P.in[I_CCTX]; }
__device__ __forceinline__ float* ws_f32(CParams& P, size_t off) { return (float*)(P.ws + off); }
__device__ __forceinline__ bf16_t* ws_bf(CParams& P, size_t off) { return (bf16_t*)(P.ws + off); }
__device__ __forceinline__ const float* y_row(CParams& P, int layer, int row) {
    if (layer == 0) return row < NP_ROWS ? P.in[I_XP] + (size_t)row * DM : P.in[I_XS] + (size_t)(row - NP_ROWS) * DM;
    return P.out + (size_t)row * DM;
}
__device__ __forceinline__ float log_gamma(CParams& P, int layer, int dir, int head) { return -__expf(P.in[I_DECAY][(layer >> 1) * 8 + dir * 4 + head]); }

NVF(nv_mod) {
    float* mod = ws_f32(P, WS_MOD);
    for (long i = gt; i < 4L * 5 * 3072; i += gn) {
        const int j = (int)(i % 3072), c = (int)((i / 3072) % 5), l = (int)(i / (3072 * 5));
        const float* cv = cond_vec(P, c); const float* w = P.in[I_ADAW] + (size_t)l * 1024 * 3072 + j;
        float s = 0.f;
        for (int k = 0; k < 1024; ++k) s += silu_f(cv[k]) * w[(size_t)k * 3072];
        mod[i] = s + P.in[I_ADAB][l * 3072 + j];
    }
    float* r8 = ws_f32(P, WS_ROPE8); float* r16 = ws_f32(P, WS_ROPE16);
    for (long i = gt; i < 64 * 8; i += gn) { const int pos = (int)(i >> 3), f = (int)(i & 7); const float inv = powf(10000.f, -(float)f / 8.f), a = (float)pos * inv; r8[2 * i] = cosf(a); r8[2 * i + 1] = sinf(a); }
    for (long i = gt; i < 64 * 16; i += gn) { const int pos = (int)(i >> 4), f = (int)(i & 15); const float inv = powf(10000.f, -(float)f / 16.f), a = (float)pos * inv; r16[2 * i] = cosf(a); r16[2 * i + 1] = sinf(a); }
}
NVF(nv_gs) {
    float* gs = ws_f32(P, WS_GS); const float* mod = ws_f32(P, WS_MOD);
    for (long i = gt; i < 4L * 5 * 1024; i += gn) { const int k = (int)(i & 1023), c = (int)((i >> 10) % 5), l = (int)(i / 5120); gs[i] = P.in[I_NORMG][l * 1024 + k] * (1.f + mod[(l * 5 + c) * 3072 + 1024 + k]); }
    if (gt == 0) {
        float* bnd = ws_f32(P, WS_BND);
        for (int i = 0; i < 2; ++i) {
            float mq = 0.f, mk = 0.f; for (int d = 0; d < 96; ++d) { mq = fmaxf(mq, fabsf(P.in[I_QHG][i * 96 + d])); mk = fmaxf(mk, fabsf(P.in[I_KHG][i * 96 + d])); }
            bnd[i] = sqrtf(96.f) * LOG2E * mq * mk;
        }
        for (int i = 0; i < 2; ++i) {
            float mq = 0.f, mk = 0.f; for (int d = 0; d < 64; ++d) { mq = fmaxf(mq, fabsf(P.in[I_WQHG][i * 64 + d])); mk = fmaxf(mk, fabsf(P.in[I_WKHG][i * 64 + d])); }
            bnd[8 + i] = mq; bnd[10 + i] = mk;
        }
    }
}
NVF(nv_bias) {
    float* bias = ws_f32(P, WS_BIAS); const float* mod = ws_f32(P, WS_MOD);
    for (long i = gt; i < 4L * 5 * 2816; i += gn) {
        const int col = (int)(i % 2816), c = (int)((i / 2816) % 5), l = (int)(i / (2816 * 5));
        const int N = (l & 1) ? WIN_IN : AB_IN; float s = 0.f;
        if (col < N) { const float* w = ((l & 1) ? P.in[I_WWIN] : P.in[I_ABWIN]) + (size_t)(l >> 1) * 1024 * N + col; const float* sh = mod + (l * 5 + c) * 3072;
            for (int k = 0; k < 1024; ++k) s += sh[k] * w[(size_t)k * N]; }
        bias[i] = s;
    }
}
NVF(nv_prepA) {
    bf16_t* A = ws_bf(P, (layer & 1) ? WS_AODD : WS_AEVEN); float* SS = ws_f32(P, WS_SS);
    const float* mod = ws_f32(P, WS_MOD);
    for (long row = gt; row < MROWS; row += gn) {
        const RowInfo ri = row_info((int)row); const float* y = y_row(P, layer, (int)row);
        const float* sc = mod + (layer * 5 + ri.cond) * 3072 + 1024; const float* g = P.in[I_NORMG] + layer * 1024;
        float s = 0.f;
        for (int k = 0; k < 1024; ++k) { const float v = y[k]; s += v * v; A[(size_t)row * 1024 + k] = f2bf(v * g[k] * (1.f + sc[k])); }
        SS[row * 16] = s; for (int j = 1; j < 16; ++j) SS[row * 16 + j] = 0.f;
    }
}
__device__ __forceinline__ float row_rstd(const float* SS, int row) { float s = 0.f; for (int j = 0; j < 16; ++j) s += SS[row * 16 + j]; return 1.0f / sqrtf(s * (1.f / 1024.f) + EPS); }

NVF(nv_in_even) {
    const bf16_t* A = ws_bf(P, WS_AEVEN); const float* SS = ws_f32(P, WS_SS); const float* W = P.in[I_ABWIN] + (size_t)(layer >> 1) * 1024 * AB_IN;
    const float* bias = ws_f32(P, WS_BIAS);
    bf16_t *CQ = ws_bf(P, WS_CQ), *CKVN = ws_bf(P, WS_CKVN), *KR = ws_bf(P, WS_KR), *G = ws_bf(P, WS_G), *RQ = ws_bf(P, WS_RQ), *RK = ws_bf(P, WS_RK), *RV = ws_bf(P, WS_RV);
    float* okr = P.out + (layer == 0 ? O_L0KR : O_L2KR);
    for (long i = gt; i < (long)(MROWS / 4) * AB_IN; i += gn) {
        const int col = (int)(i % AB_IN), r0 = (int)(i / AB_IN) * 4;
        float acc[4] = {0.f, 0.f, 0.f, 0.f};
        for (int k = 0; k < 1024; ++k) { const float w = bfr(W[(size_t)k * AB_IN + col]);
#pragma unroll
            for (int r = 0; r < 4; ++r) acc[r] += bf2f(A[(size_t)(r0 + r) * 1024 + k]) * w; }
#pragma unroll
        for (int r = 0; r < 4; ++r) {
            const int row = r0 + r; const RowInfo ri = row_info(row);
            const float v = acc[r] * row_rstd(SS, row) + bias[(layer * 5 + ri.cond) * 2816 + col];
            if (col < 384) CQ[(size_t)row * 384 + col] = f2bf(v);
            else if (col < 640) CKVN[(size_t)row * 256 + col - 384] = f2bf(v);
            else if (col < 672) { const int j = col - 640; KR[(size_t)row * 32 + j2o32(j)] = f2bf(v); if (!ri.sample) okr[(size_t)row * 32 + j] = v; }
            else if (col < 1184) G[(size_t)row * 1024 + col - 672] = f2bf(silu_f(v));
            else if (col < 1440) { const int x = col - 1184; RQ[(size_t)row * 256 + (x >> 6) * 64 + d2p64(x & 63)] = f2bf(v); }
            else if (col < 1696) { const int x = col - 1440; RK[(size_t)row * 256 + (x >> 6) * 64 + d2p64(x & 63)] = f2bf(v); }
            else if (col < 2208) RV[(size_t)row * 512 + col - 1696] = f2bf(v);
            else G[(size_t)row * 1024 + 512 + col - 2208] = f2bf(silu_f(v));
        }
    }
}
NVF(nv_post_even) {
    bf16_t *CQ = ws_bf(P, WS_CQ), *CKVN = ws_bf(P, WS_CKVN), *KR = ws_bf(P, WS_KR), *RQ = ws_bf(P, WS_RQ), *RK = ws_bf(P, WS_RK);
    float *sscq = ws_f32(P, WS_SSCQ), *sskr = ws_f32(P, WS_SSKR); const float* r16 = ws_f32(P, WS_ROPE16);
    const float* gkv = P.in[I_KVNG] + (layer >> 1) * 256; float* ockv = P.out + (layer == 0 ? O_L0CKV : O_L2CKV);
    for (long row = gt; row < MROWS; row += gn) {
        const RowInfo ri = row_info((int)row);
        float s = 0.f; for (int k = 0; k < 384; ++k) { const float v = bf2f(CQ[row * 384 + k]); s += v * v; }
        sscq[row * 8] = s; for (int j = 1; j < 8; ++j) sscq[row * 8 + j] = 0.f;
        s = 0.f; for (int k = 0; k < 32; ++k) { const float v = bf2f(KR[row * 32 + k]); s += v * v; }
        sskr[row] = s;
        s = 0.f; for (int k = 0; k < 256; ++k) { const float v = bf2f(CKVN[row * 256 + k]); s += v * v; }
        const float rs = 1.0f / sqrtf(s * (1.f / 256.f) + EPS);
        for (int k = 0; k < 256; ++k) { const float v = bf2f(CKVN[row * 256 + k]) * rs * gkv[k]; CKVN[row * 256 + k] = f2bf(v); if (!ri.sample) ockv[row * 256 + k] = v; }
        const int pr = ri.t >> 6, pc = ri.t & 63;
        for (int a = 0; a < 2; ++a) { bf16_t* X = a ? RK : RQ; const float scl = a ? 1.f : 0.125f;
            for (int h = 0; h < 4; ++h) for (int half = 0; half < 2; ++half) for (int f = 0; f < 16; ++f) {
                const int d1 = 32 * half + f, d2 = d1 + 16; bf16_t* p1 = X + row * 256 + h * 64 + d2p64(d1); bf16_t* p2 = X + row * 256 + h * 64 + d2p64(d2);
                float x1 = bf2f(*p1) * scl, x2 = bf2f(*p2) * scl;
                if (ri.sample) { const int pos = half ? pc : pr; const float c = r16[(pos * 16 + f) * 2], sn = r16[(pos * 16 + f) * 2 + 1]; const float y1 = x1 * c - x2 * sn, y2 = x1 * sn + x2 * c; x1 = y1; x2 = y2; }
                *p1 = f2bf(x1); *p2 = f2bf(x2); } }
    }
}
NVF(nv_ctx_even) {
    const float* cckv = P.in[layer == 0 ? I_C0CKV : I_C2CKV]; const float* ckr = P.in[layer == 0 ? I_C0KR : I_C2KR];
    bf16_t *CKVN = ws_bf(P, WS_CKVN), *KR = ws_bf(P, WS_KR); float* sskr = ws_f32(P, WS_SSKR);
    for (long i = gt; i < (long)CTX_ROWS * 256; i += gn) CKVN[(size_t)MROWS * 256 + i] = f2bf(cckv[i]);
    for (long rc = gt; rc < CTX_ROWS; rc += gn) { float s = 0.f;
        for (int j = 0; j < 32; ++j) { const bf16_t v = f2bf(ckr[rc * 32 + j]); KR[(size_t)(MROWS + rc) * 32 + j2o32(j)] = v; s += bf2f(v) * bf2f(v); }
        sskr[MROWS + rc] = s; }
}
NVF(nv_uq) {
    const bf16_t* CQ = ws_bf(P, WS_CQ); bf16_t* QR = ws_bf(P, WS_QR); const float* W = P.in[I_WUQ] + (size_t)(layer >> 1) * 384 * 768; const float* gq = P.in[I_QNG] + (layer >> 1) * 384;
    for (long i = gt; i < (long)MROWS * 768; i += gn) {
        const int sp = (int)(i % 96), head = (int)((i / 96) & 7); const long row = i / 768;
        const int dd = sp < 64 ? sp : 64 + o2j32(sp - 64), col = head * 96 + dd; float z = 0.f;
        for (int k = 0; k < 384; ++k) z += bf2f(CQ[row * 384 + k]) * bfr(gq[k] * W[(size_t)k * 768 + col]);
        QR[i] = f2bf(z);
    }
}
NVF(nv_uq_ss) {
    const bf16_t* QR = ws_bf(P, WS_QR); const float* sscq = ws_f32(P, WS_SSCQ); float *ssqn = ws_f32(P, WS_SSQN), *ssqr = ws_f32(P, WS_SSQR);
    for (long i = gt; i < (long)MROWS * 8; i += gn) { const long row = i >> 3; float a = 0.f, b = 0.f;
        for (int s = 0; s < 64; ++s) { const float v = bf2f(QR[i * 96 + s]); a += v * v; }
        for (int s = 64; s < 96; ++s) { const float v = bf2f(QR[i * 96 + s]); b += v * v; }
        float c = 0.f; for (int j = 0; j < 8; ++j) c += sscq[row * 8 + j];
        ssqn[i] = a + 96.f * EPS * (c * (1.f / 384.f) + EPS); ssqr[i] = b; }
}
NVF(nv_ukv) {
    const bf16_t* CKVN = ws_bf(P, WS_CKVN); const float* W = P.in[I_WUKV] + (size_t)(layer >> 1) * 256 * 1024;
    unsigned char* KI = P.ws + WS_KIMG; unsigned char* VI = P.ws + WS_VIMG;
    for (long i = gt; i < (long)MROWS_X * 1024; i += gn) {
        const int feat = (int)(i & 1023), head = feat >> 7, r = feat & 127; const int R = (int)(i >> 10); float v = 0.f;
        for (int k = 0; k < 256; ++k) v += bf2f(CKVN[(size_t)R * 256 + k]) * bfr(W[(size_t)k * 1024 + feat]);
        int kin; const int tile = kv_tile(R, head, 8, kin);
        if (r < 64) *(bf16_t*)(KI + (size_t)tile * 12288 + (r >> 3) * 1024 + kin * 16 + (r & 7) * 2) = f2bf(v);
        else { const int dv = r - 64; *(bf16_t*)(VI + (size_t)tile * 8192 + (dv >> 5) * 4096 + kin * 64 + (dv & 31) * 2) = f2bf(v); }
    }
}
NVF(nv_k_post) {
    const bf16_t* KR = ws_bf(P, WS_KR); const float* sskr = ws_f32(P, WS_SSKR); const float* gk = P.in[I_KHG] + (layer >> 1) * 96; const float* r8 = ws_f32(P, WS_ROPE8);
    unsigned char* KI = P.ws + WS_KIMG;
    for (long i = gt; i < (long)MROWS_X * 8; i += gn) {
        const int R = (int)(i >> 3), head = (int)(i & 7); int kin; const int tile = kv_tile(R, head, 8, kin);
        unsigned char* base = KI + (size_t)tile * 12288 + kin * 16;
        float s = sskr[R];
        for (int d = 0; d < 64; ++d) { const float v = bf2f(*(bf16_t*)(base + (d >> 3) * 1024 + (d & 7) * 2)); s += v * v; }
        const float rs = 1.0f / sqrtf(s * (1.f / 96.f) + EPS);
        for (int d = 0; d < 64; ++d) { bf16_t* p = (bf16_t*)(base + (d >> 3) * 1024 + (d & 7) * 2); *p = f2bf(bf2f(*p) * rs * gk[d]); }
        const bool lat = (R >= NP_ROWS && R < MROWS); const int t = (R - NP_ROWS) & 4095, pr = t >> 6, pc = t & 63;
        for (int half = 0; half < 2; ++half) for (int f = 0; f < 8; ++f) {
            const int j1 = 16 * half + f, j2 = j1 + 8; const int o1 = j2o32(j1), o2 = j2o32(j2);
            float x1 = bf2f(KR[(size_t)R * 32 + o1]) * rs * gk[64 + j1], x2 = bf2f(KR[(size_t)R * 32 + o2]) * rs * gk[64 + j2];
            if (lat) { const int pos = half ? pc : pr; const float c = r8[(pos * 8 + f) * 2], sn = r8[(pos * 8 + f) * 2 + 1]; const float y1 = x1 * c - x2 * sn, y2 = x1 * sn + x2 * c; x1 = y1; x2 = y2; }
            *(bf16_t*)(base + ((64 + o1) >> 3) * 1024 + (o1 & 7) * 2) = f2bf(x1); *(bf16_t*)(base + ((64 + o2) >> 3) * 1024 + (o2 & 7) * 2) = f2bf(x2); }
    }
}
__device__ __forceinline__ int chunk_row0(int c) { return c < 64 ? (c >> 1) * 256 + (c & 1) * 128 : NP_ROWS + ((c - 64) >> 5) * 4096 + ((c - 64) & 31) * 128; }
__device__ __forceinline__ unsigned char* ur_ptr(CParams& P, int c, int head, int dir) { return c < 64 ? P.ws + WS_URP + (size_t)((c * 4 + head) * 2 + dir) * 16384 : P.ws + WS_URS + (size_t)(((c - 64) * 4 + head) * 2 + dir) * 16384; }
__device__ __forceinline__ size_t ur_el(int p, int dv) { return (size_t)(dv >> 5) * 4096 + p * 64 + (dv & 31) * 2; }
NVF(nv_u) {
    const bf16_t *RK = ws_bf(P, WS_RK), *RV = ws_bf(P, WS_RV);
    for (long i = gt; i < 192L * 4 * 2 * 8192; i += gn) {
        const int dv = (int)(i & 127), p = (int)((i >> 7) & 63), dir = (int)((i >> 13) & 1), head = (int)((i >> 14) & 3), c = (int)(i >> 16);
        const float lg = log_gamma(P, layer, dir, head); const int r0 = chunk_row0(c); float s = 0.f;
        for (int t = 0; t < 128; ++t) { const float w = __expf(lg * (float)(dir ? t : 127 - t)); s += bfr(bf2f(RK[(size_t)(r0 + t) * 256 + head * 64 + p]) * w) * bf2f(RV[(size_t)(r0 + t) * 512 + head * 128 + dv]); }
        *(bf16_t*)(ur_ptr(P, c, head, dir) + ur_el(p, dv)) = f2bf(s);
    }
}
NVF(nv_scan) {
    float* orf = P.out + (layer == 0 ? O_L0RF : O_L2RF); float* orb = P.out + (layer == 0 ? O_L0RB : O_L2RB);
    const float* s0f = P.in[layer == 0 ? I_S0F : I_S2F]; const float* s0b = P.in[layer == 0 ? I_S0B : I_S2B];
    for (long i = gt; i < 36L * 4 * 2 * 8192; i += gn) {
        const int dv = (int)(i & 127), p = (int)((i >> 7) & 63), dir = (int)((i >> 13) & 1), head = (int)((i >> 14) & 3), seq = (int)(i >> 16);
        const float gC = __expf(128.f * log_gamma(P, layer, dir, head)); const size_t el = ur_el(p, dv); const int d = p2d64(p);
        if (seq < 32) {
            bf16_t* u0 = (bf16_t*)(ur_ptr(P, 2 * seq, head, dir) + el); bf16_t* u1 = (bf16_t*)(ur_ptr(P, 2 * seq + 1, head, dir) + el);
            const float a = bf2f(*u0), b = bf2f(*u1);
            if (dir == 0) { orf[((size_t)(seq * 4 + head) * 64 + d) * 128 + dv] = gC * a + b; *u0 = 0; *u1 = f2bf(a); }
            else { orb[((size_t)(seq * 4 + head) * 64 + d) * 128 + dv] = gC * b + a; *u1 = 0; *u0 = f2bf(b); }
        } else {
            const int b = seq - 32; float R = (dir ? s0b : s0f)[((size_t)(b * 4 + head) * 64 + d) * 128 + dv];
            for (int n = 0; n < 32; ++n) { const int c = 64 + b * 32 + (dir ? 31 - n : n); bf16_t* u = (bf16_t*)(ur_ptr(P, c, head, dir) + el); const float uv = bf2f(*u); *u = f2bf(R); R = gC * R + uv; }
        }
    }
}
__device__ __forceinline__ float mla_q_at(CParams& P, int layer, int row, int head, int s) {
    const bf16_t* QR = ws_bf(P, WS_QR) + ((size_t)row * 8 + head) * 96; const float* gq = P.in[I_QHG] + (layer >> 1) * 96; const float* r8 = ws_f32(P, WS_ROPE8);
    const float ss = ws_f32(P, WS_SSQN)[row * 8 + head] + ws_f32(P, WS_SSQR)[row * 8 + head]; const float rs = 1.0f / sqrtf(ss * (1.f / 96.f));
    const float qs = 0.10206207261596575f * LOG2E;
    if (s < 64) return bfr(bf2f(QR[s]) * rs * gq[s] * qs);
    const RowInfo ri = row_info(row);
    const int j = o2j32(s - 64), j1 = j & ~8, j2 = j1 + 8, half = j >> 4, f = j & 7;
    const float x1 = bf2f(QR[64 + j2o32(j1)]) * rs * gq[64 + j1], x2 = bf2f(QR[64 + j2o32(j2)]) * rs * gq[64 + j2];
    float c = 1.f, sn = 0.f;
    if (ri.sample) { const int pos = half ? (ri.t & 63) : (ri.t >> 6); c = r8[(pos * 8 + f) * 2]; sn = r8[(pos * 8 + f) * 2 + 1]; }
    const float y = (j & 8) ? (x1 * sn + x2 * c) : (x1 * c - x2 * sn);
    return bfr(y * qs);
}
NVF(nv_mla_attn) {
    const unsigned char* KI = P.ws + WS_KIMG; const unsigned char* VI = P.ws + WS_VIMG; bf16_t* G = ws_bf(P, WS_G); const float bnd = ws_f32(P, WS_BND)[layer >> 1];
    const int lane = (int)(gt & 63);
    for (long it = gt >> 6; it < (long)MROWS * 8; it += gn >> 6) {
        const int row = (int)(it % MROWS), head = (int)(it / MROWS); const RowInfo ri = row_info(row);
        const float q0 = mla_q_at(P, layer, row, head, lane), q1 = lane < 32 ? mla_q_at(P, layer, row, head, 64 + lane) : 0.f;
        float o = 0.f, l = 0.f;
        const int t0 = kv_seq_tile0(ri.sample, ri.b, head, 8), nk = ri.sample ? 4608 : 256;
        for (int key = 0; key < nk; ++key) {
            const unsigned char* kb = KI + (size_t)(t0 + (key >> 6)) * 12288 + (key & 63) * 16; const unsigned char* vb = VI + (size_t)(t0 + (key >> 6)) * 8192 + (key & 63) * 64;
            float s = q0 * bf2f(*(const bf16_t*)(kb + (lane >> 3) * 1024 + (lane & 7) * 2));
            if (lane < 32) s += q1 * bf2f(*(const bf16_t*)(kb + ((64 + lane) >> 3) * 1024 + (lane & 7) * 2));
            s = wave_sum(s);
            const float p = exp2f(s - bnd); l += p;
            o += bfr(p) * bf2f(*(const bf16_t*)(vb + (lane >> 5) * 4096 + (lane & 31) * 2));
        }
        bf16_t* g = G + (size_t)row * 1024 + head * 64 + lane; *g = f2bf(o / l * bf2f(*g));
    }
}
NVF(nv_ret_out) {
    const bf16_t *RQ = ws_bf(P, WS_RQ), *RK = ws_bf(P, WS_RK), *RV = ws_bf(P, WS_RV); bf16_t* G = ws_bf(P, WS_G); const float* gn_ = P.in[I_RNG] + (layer >> 1) * 512;
    const int lane = (int)(gt & 63);
    for (long it = gt >> 6; it < (long)MROWS * 4; it += gn >> 6) {
        const int row = (int)(it % MROWS), head = (int)(it / MROWS);
        const int c = row < NP_ROWS ? row >> 7 : 64 + ((row - NP_ROWS) >> 7); const int ii = row & 127, r0 = chunk_row0(c);
        const float lgf = log_gamma(P, layer, 0, head), lgb = log_gamma(P, layer, 1, head);
        const float ql = bf2f(RQ[(size_t)row * 256 + head * 64 + lane]);
        float o0 = 0.f, o1 = 0.f;
        for (int j = 0; j < 128; ++j) {
            const float s = wave_sum(ql * bf2f(RK[(size_t)(r0 + j) * 256 + head * 64 + lane]));
            const float D = j < ii ? __expf(lgf * (float)(ii - j)) : (j > ii ? __expf(lgb * (float)(j - ii)) : 2.f);
            const float pb = bfr(s * D);
            o0 += pb * bf2f(RV[(size_t)(r0 + j) * 512 + head * 128 + lane]); o1 += pb * bf2f(RV[(size_t)(r0 + j) * 512 + head * 128 + 64 + lane]);
        }
        const float wf = __expf(lgf * (float)(ii + 1)), wb = __expf(lgb * (float)(128 - ii));
        const unsigned char* Rf = ur_ptr(P, c, head, 0); const unsigned char* Rb = ur_ptr(P, c, head, 1);
        for (int p = 0; p < 64; ++p) { const float qp = bf2f(RQ[(size_t)row * 256 + head * 64 + p]); const float qf = bfr(qp * wf), qb = bfr(qp * wb);
            o0 += qf * bf2f(*(const bf16_t*)(Rf + ur_el(p, lane))) + qb * bf2f(*(const bf16_t*)(Rb + ur_el(p, lane)));
            o1 += qf * bf2f(*(const bf16_t*)(Rf + ur_el(p, 64 + lane))) + qb * bf2f(*(const bf16_t*)(Rb + ur_el(p, 64 + lane))); }
        const float mu = wave_sum(o0 + o1) * (1.f / 128.f);
        const float d0 = o0 - mu, d1 = o1 - mu; const float var = wave_sum(d0 * d0 + d1 * d1) * (1.f / 128.f);
        const float rs = 1.0f / sqrtf(var + EPS);
        bf16_t* g = G + (size_t)row * 1024 + 512 + head * 128 + lane;
        g[0] = f2bf(d0 * rs * gn_[head * 128 + lane] * bf2f(g[0])); g[64] = f2bf(d1 * rs * gn_[head * 128 + 64 + lane] * bf2f(g[64]));
    }
}
NVF(nv_out) {
    const bf16_t* G = ws_bf(P, WS_G); const float* W = ((layer & 1) ? P.in[I_WWOUT] : P.in[I_ABWOUT]) + (size_t)(layer >> 1) * 1024 * 1024; const float* mod = ws_f32(P, WS_MOD);
    for (long i = gt; i < (long)(MROWS / 4) * 1024; i += gn) {
        const int col = (int)(i & 1023), r0 = (int)(i >> 10) * 4; float acc[4] = {0.f, 0.f, 0.f, 0.f};
        for (int k = 0; k < 1024; ++k) { const float w = bfr(W[(size_t)k * 1024 + col]);
#pragma unroll
            for (int r = 0; r < 4; ++r) acc[r] += bf2f(G[(size_t)(r0 + r) * 1024 + k]) * w; }
#pragma unroll
        for (int r = 0; r < 4; ++r) { const int row = r0 + r; const RowInfo ri = row_info(row);
            P.out[(size_t)row * 1024 + col] = y_row(P, layer, row)[col] + mod[(layer * 5 + ri.cond) * 3072 + 2048 + col] * acc[r]; }
    }
}
NVF(nv_in_odd) {
    const bf16_t* A = ws_bf(P, WS_AODD); const float* SS = ws_f32(P, WS_SS); const float* W = P.in[I_WWIN] + (size_t)(layer >> 1) * 1024 * WIN_IN; const float* bias = ws_f32(P, WS_BIAS);
    bf16_t *QW = ws_bf(P, WS_QW), *G = ws_bf(P, WS_G); unsigned char* KI = P.ws + WS_KWIMG; unsigned char* VI = P.ws + WS_VWIMG; float* ov = P.out + (layer == 1 ? O_L1V : O_L3V);
    for (long i = gt; i < (long)(MROWS / 4) * WIN_IN; i += gn) {
        const int col = (int)(i % WIN_IN), r0 = (int)(i / WIN_IN) * 4; float acc[4] = {0.f, 0.f, 0.f, 0.f};
        for (int k = 0; k < 1024; ++k) { const float w = bfr(W[(size_t)k * WIN_IN + col]);
#pragma unroll
            for (int r = 0; r < 4; ++r) acc[r] += bf2f(A[(size_t)(r0 + r) * 1024 + k]) * w; }
#pragma unroll
        for (int r = 0; r < 4; ++r) { const int row = r0 + r; const RowInfo ri = row_info(row);
            const float v = acc[r] * row_rstd(SS, row) + bias[(layer * 5 + ri.cond) * 2816 + col];
            if (col < 1024) QW[(size_t)row * 1024 + (col >> 6) * 64 + d2p64(col & 63)] = f2bf(v);
            else if (col < 1280) { const int x = col - 1024, kvh = x >> 6, p = d2p64(x & 63); int kin; const int tile = kv_tile(row, kvh, 4, kin); *(bf16_t*)(KI + (size_t)tile * 8192 + (p >> 3) * 1024 + kin * 16 + (p & 7) * 2) = f2bf(v); }
            else if (col < 1536) { const int x = col - 1280, kvh = x >> 6, dv = x & 63; int kin; const int tile = kv_tile(row, kvh, 4, kin); *(bf16_t*)(VI + (size_t)tile * 8192 + (dv >> 5) * 4096 + kin * 64 + (dv & 31) * 2) = f2bf(v); if (!ri.sample) ov[(size_t)row * 256 + x] = v; }
            else G[(size_t)row * 1024 + col - 1536] = f2bf(silu_f(v)); }
    }
}
NVF(nv_post_odd) {
    bf16_t* QW = ws_bf(P, WS_QW); unsigned char* KI = P.ws + WS_KWIMG; const float* r16 = ws_f32(P, WS_ROPE16); float* ok = P.out + (layer == 1 ? O_L1K : O_L3K);
    const float* gq = P.in[I_WQHG] + (layer >> 1) * 64; const float* gk = P.in[I_WKHG] + (layer >> 1) * 64;
    const int d = (int)(gt & 63), p = d2p64(d);
    for (long it = gt >> 6; it < (long)MROWS * 20; it += gn >> 6) {
        const int row = (int)(it / 20), hh = (int)(it % 20); const RowInfo ri = row_info(row); const bool isq = hh < 16; const int kvh = hh - 16;
        int kin = 0, tile = 0; if (!isq) tile = kv_tile(row, kvh, 4, kin);
        bf16_t* ptr = isq ? QW + (size_t)row * 1024 + hh * 64 + p : (bf16_t*)(KI + (size_t)tile * 8192 + (p >> 3) * 1024 + kin * 16 + (p & 7) * 2);
        float x = bf2f(*ptr);
        const float rs = 1.0f / sqrtf(wave_sum(x * x) * (1.f / 64.f) + EPS);
        x *= rs * (isq ? gq[d] : gk[d]);
        if (!isq && !ri.sample) ok[(size_t)row * 256 + kvh * 64 + d] = x;
        const float xp = xor_shfl<16>(x);
        if (ri.sample) { const int half = d >> 5, f = d & 15; const int pos = half ? (ri.t & 63) : (ri.t >> 6);
            const float c = r16[(pos * 16 + f) * 2], sn = r16[(pos * 16 + f) * 2 + 1];
            x = (d & 16) ? (xp * sn + x * c) : (x * c - xp * sn); }
        *ptr = f2bf(isq ? x * 0.125f * LOG2E : x);
    }
}
NVF(nv_ctx_odd) {
    const float* ck = P.in[layer == 1 ? I_C1K : I_C3K]; const float* cv = P.in[layer == 1 ? I_C1V : I_C3V]; unsigned char* KI = P.ws + WS_KWIMG; unsigned char* VI = P.ws + WS_VWIMG;
    unsigned* bmax = (unsigned*)ws_f32(P, WS_BND) + 4 + (layer >> 1);
    for (long i = gt; i < (long)CTX_ROWS * 4; i += gn) { const int rc = (int)(i >> 2), kvh = (int)(i & 3); int kin; const int tile = kv_tile(MROWS + rc, kvh, 4, kin); float s = 0.f;
        for (int d = 0; d < 64; ++d) { const int p = d2p64(d); const bf16_t kb = f2bf(ck[(size_t)rc * 256 + kvh * 64 + d]); s += bf2f(kb) * bf2f(kb);
            *(bf16_t*)(KI + (size_t)tile * 8192 + (p >> 3) * 1024 + kin * 16 + (p & 7) * 2) = kb;
            *(bf16_t*)(VI + (size_t)tile * 8192 + (d >> 5) * 4096 + kin * 64 + (d & 31) * 2) = f2bf(cv[(size_t)rc * 256 + kvh * 64 + d]); }
        atomicMax(bmax, __float_as_uint(s)); }
}
NVF(nv_win_attn) {
    const bf16_t* QW = ws_bf(P, WS_QW); const unsigned char* KI = P.ws + WS_KWIMG; const unsigned char* VI = P.ws + WS_VWIMG; bf16_t* G = ws_bf(P, WS_G);
    const float* bf = ws_f32(P, WS_BND); const int li = layer >> 1;
    const float knorm = fmaxf(8.f * bf[10 + li], sqrtf(bf[4 + li])); const float bnd = 0.125f * LOG2E * 8.f * bf[8 + li] * knorm;
    const int lane = (int)(gt & 63);
    for (long it = gt >> 6; it < (long)MROWS * 16; it += gn >> 6) {
        const int row = (int)(it % MROWS), head = (int)(it / MROWS), kvh = head >> 2; const RowInfo ri = row_info(row);
        const float ql = bf2f(QW[(size_t)row * 1024 + head * 64 + lane]);
        float o = 0.f, l = exp2f(P.in[I_SINK][li * 16 + head] * LOG2E - bnd);
        const int t0 = kv_seq_tile0(ri.sample, ri.b, kvh, 4);
        int klo = 0, khi = 256, k2lo = 0, k2hi = 0;
        if (ri.sample) { klo = 0; khi = 512; k2lo = 512 + max(0, ri.t - 128); k2hi = 512 + min(4095, ri.t + 128) + 1; }
        for (int seg = 0; seg < 2; ++seg) { const int a = seg ? k2lo : klo, b = seg ? k2hi : khi;
            for (int key = a; key < b; ++key) {
                const unsigned char* kb = KI + (size_t)(t0 + (key >> 6)) * 8192 + (key & 63) * 16; const unsigned char* vb = VI + (size_t)(t0 + (key >> 6)) * 8192 + (key & 63) * 64;
                const float s = wave_sum(ql * bf2f(*(const bf16_t*)(kb + (lane >> 3) * 1024 + (lane & 7) * 2)));
                const float pp = exp2f(s - bnd); l += pp;
                o += bfr(pp) * bf2f(*(const bf16_t*)(vb + (lane >> 5) * 4096 + (lane & 31) * 2)); } }
        bf16_t* g = G + (size_t)row * 1024 + head * 64 + lane; *g = f2bf(o / l * bf2f(*g));
    }
}
NVF(nv_zero_bnd) { if (gt < 64) ws_f32(P, WS_BND)[gt] = 0.f; }

namespace pg8 {
#define PG8_LAS __attribute__((address_space(3)))
typedef short bf16x8 __attribute__((ext_vector_type(8)));
typedef float f32x4 __attribute__((ext_vector_type(4)));
typedef unsigned u32x4 __attribute__((ext_vector_type(4)));
constexpr int BM = 256, BK = 64, HALF = 128, HTB = HALF * BK * 2  , STAGE_BYTES = 8 * HTB, NXCD = 8, WGM = 8;

__host__ __device__ __forceinline__ int lds_byte(int r, int c) { const int st = (r >> 4) * 2 + (c >> 5), rr = r & 15, cc = c & 31, ob = rr * 64 + cc * 2; return st * 1024 + (ob ^ (((ob >> 9) & 1) << 5)); }
__host__ __device__ __forceinline__ void stage_rc(int b, int& R, int& C) { const int st = b / 1024, sb = b % 1024, swz = sb ^ (((sb >> 9) & 1) << 5); R = (st >> 1) * 16 + swz / 64; C = (st & 1) * 32 + (swz % 64) / 2; }
__host__ __device__ __forceinline__ int perm32(int rho) { const int n = rho >> 4, i = rho & 15; return 8 * (i >> 2) + 4 * n + (i & 3); }

struct Unit { int pm, pn; };
struct Gemm { const bf16_t* A; const bf16_t* Bt; int M, N, K, lda; };

struct StaticOrder {
    int nM, nN, nwg, G, c;
    __host__ __device__ void init(int M, int N, int G_, int c_) { nM = M / BM; nN = N / BM; nwg = nM * nN; G = G_; c = c_; }
    __host__ __device__ bool next(int i, Unit& u) const {
        const long L = (long)i * G + c; if (L >= nwg) return false;
        int wgid = (int)L; { const int q = nwg / NXCD, r = nwg % NXCD, xcd = wgid % NXCD, off = wgid / NXCD; wgid = (xcd < r ? xcd * (q + 1) : r * (q + 1) + (xcd - r) * q) + off; }
        const int nig = WGM * nN, gid = wgid / nig, fm = gid * WGM, gsz = (nM - fm) < WGM ? (nM - fm) : WGM;
        u.pm = fm + ((wgid % nig) % gsz); u.pn = (wgid % nig) / gsz; return true;
    }
    __device__ __forceinline__ void a_ready(const Unit&) const {}
    __device__ __forceinline__ void done(const Unit&) const {}
};

template <class Epi, class Sched, bool ALIGN_EPI = false, bool SP2 = false>
__device__ __forceinline__ void gemm_phase(PG8_LAS unsigned char* lds, const Gemm g, const Sched& S, const Epi& E, int wave_s) {
    int ws_ = wave_s; asm volatile("" : "+s"(ws_)); int ln_ = lane_id(); asm volatile("" : "+v"(ln_)); const int wid = ws_, lane = ln_, tid = wid * 64 + lane, wr = wid >> 2, wc = wid & 3, fr = lane & 15, fq = lane >> 4;
    const int K = g.K, nt = K / BK;
    unsigned voffA[2], voffB[2];
#pragma unroll
    for (int i = 0; i < 2; ++i) { int R, C; stage_rc(tid * 16 + i * 8192, R, C); const int Rb = Epi::PERM ? ((R & ~31) + perm32(R & 31)) : R;
        voffA[i] = (unsigned)(R * g.lda + C) * 2u; voffB[i] = (unsigned)(Rb * K + C) * 2u; }
    const size_t kstep = (size_t)(BK * 2);
    const size_t hstepA = (size_t)HALF * g.lda * 2, hstepB = (size_t)HALF * K * 2;
    const size_t tstepA = 2 * hstepA, tstepB = 2 * hstepB;
    const unsigned ldsw = (unsigned)wid * 1024u;
    const int aoff = lds_byte(wr * 64 + fr, fq * 8), boff = lds_byte(wc * 32 + fr, fq * 8);
#define PG8_SA(b, h) (((b) * 2 + (h)) * HTB)
#define PG8_SB(b, h) ((4 + (b) * 2 + (h)) * HTB)
#define PG8_STAGE(bufoff, gbase, voff) do { _Pragma("unroll") for (int _i = 0; _i < 2; ++_i) \
        __builtin_amdgcn_global_load_lds((const unsigned*)((const char*)(gbase) + (voff)[_i]), (PG8_LAS unsigned*)(lds + (bufoff) + ldsw + _i * 8192), 16, 0, 0); } while (0)
#define PG8_LDA(dst, b, h) do { _Pragma("unroll") for (int m = 0; m < 4; ++m) _Pragma("unroll") for (int k = 0; k < 2; ++k) dst[m][k] = *(const PG8_LAS bf16x8*)(lds + PG8_SA(b, h) + aoff + m * 2048 + k * 1024); } while (0)
#define PG8_LDB(dst, b, h) do { _Pragma("unroll") for (int n = 0; n < 2; ++n) _Pragma("unroll") for (int k = 0; k < 2; ++k) dst[n][k] = *(const PG8_LAS bf16x8*)(lds + PG8_SB(b, h) + boff + n * 2048 + k * 1024); } while (0)
#define PG8_MMA(ai, bj, At, Bt) do { __builtin_amdgcn_s_setprio(1); _Pragma("unroll") for (int m = 0; m < 4; ++m) _Pragma("unroll") for (int n = 0; n < 2; ++n) _Pragma("unroll") for (int k = 0; k < 2; ++k) \
        acc[ai][bj][m][n] = __builtin_amdgcn_mfma_f32_16x16x32_bf16(Bt[n][k], At[m][k], acc[ai][bj][m][n], 0, 0, 0); __builtin_amdgcn_s_setprio(0); } while (0)
#define PG8_WAIT_V(n) asm volatile("s_waitcnt vmcnt(" #n ")" ::: "memory")
#define PG8_WAIT_L(n) asm volatile("s_waitcnt lgkmcnt(" #n ")" ::: "memory")
#define PG8_BAR __builtin_amdgcn_s_barrier()
#define PG8_SCHED __builtin_amdgcn_sched_barrier(0)
    Unit cur, nxt; int ui = 0;
    if (!S.next(0, cur)) return;
    f32x4 acc[2][2][4][2];
#pragma unroll
    for (int a = 0; a < 2; ++a)
#pragma unroll
        for (int b = 0; b < 2; ++b)
#pragma unroll
            for (int m = 0; m < 4; ++m)
#pragma unroll
                for (int n = 0; n < 2; ++n) acc[a][b][m][n] = (f32x4){0.f, 0.f, 0.f, 0.f};
    bf16x8 At[4][2], B0[2][2], B1[2][2];
    const char* cA = (const char*)g.A + (size_t)cur.pm * tstepA; const char* cB = (const char*)g.Bt + (size_t)cur.pn * tstepB;
    S.a_ready(cur);
    if constexpr (SP2) {
        PG8_STAGE(PG8_SB(0, 0), cB, voffB); PG8_STAGE(PG8_SB(0, 1), cB + hstepB, voffB); PG8_STAGE(PG8_SA(0, 0), cA, voffA); PG8_STAGE(PG8_SA(0, 1), cA + hstepA, voffA);
        if (wr == 1) PG8_BAR;
        PG8_WAIT_V(2); PG8_BAR;
        PG8_STAGE(PG8_SB(1, 0), cB + kstep, voffB); PG8_STAGE(PG8_SA(1, 0), cA + kstep, voffA); PG8_STAGE(PG8_SB(1, 1), cB + hstepB + kstep, voffB);
        PG8_WAIT_V(6); PG8_BAR;
    } else {
        PG8_STAGE(PG8_SB(0, 0), cB, voffB); PG8_STAGE(PG8_SA(0, 0), cA, voffA); PG8_STAGE(PG8_SB(0, 1), cB + hstepB, voffB); PG8_STAGE(PG8_SA(0, 1), cA + hstepA, voffA);
        if (wr == 1) PG8_BAR;
        PG8_WAIT_V(4); PG8_BAR;
        PG8_STAGE(PG8_SB(1, 0), cB + kstep, voffB); PG8_STAGE(PG8_SA(1, 0), cA + kstep, voffA); PG8_STAGE(PG8_SB(1, 1), cB + hstepB + kstep, voffB);
        PG8_WAIT_V(6); PG8_BAR;
    }
    for (;;) {
        const bool has_next = S.next(ui + 1, nxt);
        const char* nA = has_next ? (const char*)g.A + (size_t)nxt.pm * tstepA : cA; const char* nB = has_next ? (const char*)g.Bt + (size_t)nxt.pn * tstepB : cB;
        for (int t = 0; t < nt; t += 2) {
            const bool last = (t == nt - 2);
            const char* a1 = cA + (size_t)(t + 1) * kstep;
            const char* a2 = last ? nA : cA + (size_t)(t + 2) * kstep; const char* b2 = last ? nB : cB + (size_t)(t + 2) * kstep;
            const char* a3 = a2 + kstep; const char* b3 = b2 + kstep;
            if (last && has_next) S.a_ready(nxt);
            if constexpr (SP2) {
            PG8_LDB(B0, 0, 0); PG8_LDB(B1, 0, 1); PG8_SCHED; PG8_LDA(At, 0, 0); PG8_STAGE(PG8_SA(1, 1), a1 + hstepA, voffA);
            PG8_WAIT_V(8); PG8_WAIT_L(0); PG8_BAR; PG8_MMA(0, 0, At, B0); PG8_MMA(0, 1, At, B1); PG8_BAR; PG8_SCHED;
            PG8_LDA(At, 0, 1); PG8_STAGE(PG8_SB(0, 0), b2, voffB); PG8_STAGE(PG8_SB(0, 1), b2 + hstepB, voffB); PG8_STAGE(PG8_SA(0, 0), a2, voffA);
            PG8_WAIT_V(8); PG8_WAIT_L(0); PG8_BAR; PG8_MMA(1, 0, At, B0); PG8_MMA(1, 1, At, B1); PG8_BAR; PG8_SCHED;
            PG8_LDB(B0, 1, 0); PG8_LDB(B1, 1, 1); PG8_SCHED; PG8_LDA(At, 1, 0); PG8_STAGE(PG8_SA(0, 1), a2 + hstepA, voffA);
            PG8_WAIT_V(8); PG8_WAIT_L(0); PG8_BAR; PG8_MMA(0, 0, At, B0); PG8_MMA(0, 1, At, B1); PG8_BAR; PG8_SCHED;
            PG8_LDA(At, 1, 1); PG8_STAGE(PG8_SB(1, 0), b3, voffB); PG8_STAGE(PG8_SB(1, 1), b3 + hstepB, voffB); PG8_STAGE(PG8_SA(1, 0), a3, voffA);
            PG8_WAIT_V(8); PG8_WAIT_L(0); PG8_BAR; PG8_MMA(1, 0, At, B0); PG8_MMA(1, 1, At, B1); PG8_BAR; PG8_SCHED;
            } else {
            PG8_LDB(B0, 0, 0); PG8_SCHED; PG8_LDA(At, 0, 0); PG8_STAGE(PG8_SA(1, 1), a1 + hstepA, voffA);
            PG8_WAIT_L(8); PG8_BAR; PG8_WAIT_L(0); PG8_MMA(0, 0, At, B0); PG8_BAR; PG8_SCHED;
            PG8_LDB(B1, 0, 1); PG8_STAGE(PG8_SB(0, 0), b2, voffB);
            PG8_BAR; PG8_WAIT_L(0); PG8_MMA(0, 1, At, B1); PG8_BAR;
            PG8_LDA(At, 0, 1); PG8_STAGE(PG8_SA(0, 0), a2, voffA);
            PG8_BAR; PG8_WAIT_L(0); PG8_MMA(1, 0, At, B0); PG8_BAR; PG8_SCHED;
            PG8_STAGE(PG8_SB(0, 1), b2 + hstepB, voffB);
            PG8_WAIT_V(6); PG8_BAR; PG8_MMA(1, 1, At, B1); PG8_BAR;
            PG8_LDB(B0, 1, 0); PG8_SCHED; PG8_LDA(At, 1, 0); PG8_STAGE(PG8_SA(0, 1), a2 + hstepA, voffA);
            PG8_WAIT_L(8); PG8_BAR; PG8_WAIT_L(0); PG8_MMA(0, 0, At, B0); PG8_BAR; PG8_SCHED;
            PG8_LDB(B1, 1, 1); PG8_STAGE(PG8_SB(1, 0), b3, voffB);
            PG8_BAR; PG8_WAIT_L(0); PG8_MMA(0, 1, At, B1); PG8_BAR;
            PG8_LDA(At, 1, 1); PG8_STAGE(PG8_SA(1, 0), a3, voffA);
            PG8_BAR; PG8_WAIT_L(0); PG8_MMA(1, 0, At, B0); PG8_BAR; PG8_SCHED;
            PG8_STAGE(PG8_SB(1, 1), b3 + hstepB, voffB);
            PG8_WAIT_V(6); PG8_BAR; PG8_MMA(1, 1, At, B1); PG8_BAR;
            }
        }
        if constexpr (ALIGN_EPI) { if (wr == 0) PG8_BAR; }
        if constexpr (!Epi::AFTER_DRAIN) { E(acc, cur, wr, wc, fr, fq); S.done(cur); }
        if (!has_next) break;
#pragma unroll
        for (int a = 0; a < 2; ++a)
#pragma unroll
            for (int b = 0; b < 2; ++b)
#pragma unroll
                for (int m = 0; m < 4; ++m)
#pragma unroll
                    for (int n = 0; n < 2; ++n) acc[a][b][m][n] = (f32x4){0.f, 0.f, 0.f, 0.f};
        cur = nxt; cA = nA; cB = nB; ++ui;
        if constexpr (ALIGN_EPI) { if (wr == 1) PG8_BAR; }
    }
    PG8_WAIT_V(0);
    if constexpr (!ALIGN_EPI) { if (wr == 0) PG8_BAR; }
    PG8_BAR;
    if constexpr (Epi::AFTER_DRAIN) { E.fused(acc, cur, wr, wc, fr, fq, lds, wid, lane); S.done(cur); }
#undef PG8_SA
#undef PG8_SB
#undef PG8_STAGE
#undef PG8_LDA
#undef PG8_LDB
#undef PG8_MMA
#undef PG8_WAIT_V
#undef PG8_WAIT_L
#undef PG8_BAR
#undef PG8_SCHED
}
}
#define LAS __attribute__((address_space(3)))
typedef float f32x4 __attribute__((ext_vector_type(4)));
typedef unsigned u32x4 __attribute__((ext_vector_type(4)));
typedef unsigned u32x2 __attribute__((ext_vector_type(2)));
constexpr int NWAVES = 8, NTHREADS = 512;
constexpr int RING_BYTES = 131072, EPI_OFF = RING_BYTES, EPI_BYTES = 8192, MISC_OFF = EPI_OFF + EPI_BYTES, LDS_BYTES = 147456;

typedef float f32x2_t __attribute__((ext_vector_type(2))); typedef __bf16 bf16x2_t __attribute__((ext_vector_type(2)));
__device__ __forceinline__ unsigned pk2(float lo, float hi) { f32x2_t v = {lo, hi}; bf16x2_t b = __builtin_convertvector(v, bf16x2_t); return __builtin_bit_cast(unsigned, b); }
__device__ __forceinline__ u32x4 pk8(const f32x4& a, const f32x4& b) { u32x4 r; r.x = pk2(a[0], a[1]); r.y = pk2(a[2], a[3]); r.z = pk2(b[0], b[1]); r.w = pk2(b[2], b[3]); return r; }
__device__ __forceinline__ float sum4sq(const f32x4& a) { return (a[0] * a[0] + a[1] * a[1]) + (a[2] * a[2] + a[3] * a[3]); }
__device__ __forceinline__ float fq_sum(float s) { s += xor_shfl<16>(s); return sum_halves(s); }

struct LDec { int pn, bj, wc, nn, fq, e, f, w, d; };
__device__ __forceinline__ LDec ldec(int n) { LDec r; r.pn = n >> 8; const int L = n & 255; r.bj = L >> 7; r.wc = (L >> 5) & 3; r.nn = (L >> 4) & 1; r.fq = (L >> 2) & 3; r.e = L & 3;
    r.f = 128 * r.bj + 32 * r.wc + 8 * r.fq + 4 * r.nn + r.e;
    r.w = 16 * r.fq + 8 * r.bj + 4 * r.nn + r.e;
    r.d = 32 * r.bj + 16 * r.nn + 4 * r.fq + r.e;
    return r; }
enum { MAP_OUT = 0, MAP_IN_ODD, MAP_IN_EVEN, MAP_UQ, MAP_UKV };
__device__ __forceinline__ int srccol(int map, int n) {
    const LDec r = ldec(n);
    switch (map) {
        case MAP_OUT: return r.pn * 256 + r.f;
        case MAP_IN_ODD:
            if (r.pn < 4) return (4 * r.pn + r.wc) * 64 + r.d;
            if (r.pn == 4) return 1024 + r.wc * 64 + r.d;
            if (r.pn == 5) return 1280 + r.wc * 64 + r.w;
            return 1536 + (r.pn - 6) * 256 + r.f;
        case MAP_IN_EVEN:
            switch (r.pn) {
                case 0: return r.f;
                case 1: if (r.bj == 0) return 256 + r.f; return r.wc == 0 ? 640 + o2j32(8 * r.fq + 4 * r.nn + r.e) : -1;
                case 2: return 384 + r.f;
                case 3: case 4: return 672 + (r.pn - 3) * 256 + r.f;
                case 5: case 6: return 2208 + (r.pn - 5) * 256 + r.f;
                case 7: return 1184 + r.wc * 64 + r.d;
                case 8: return 1440 + r.wc * 64 + r.d;
                default: return 1696 + (2 * (r.pn - 9) + (r.wc >> 1)) * 128 + 64 * (r.wc & 1) + r.w;
            }
        case MAP_UQ:
            if (r.pn < 2) return (4 * r.pn + r.wc) * 96 + r.w;
            return (2 * r.wc + (r.w >> 5)) * 96 + 64 + o2j32(r.w & 31);
        default:
            if (r.pn < 2) return (4 * r.pn + r.wc) * 128 + r.w;
            return (4 * (r.pn - 2) + r.wc) * 128 + 64 + r.w;
    }
}
__device__ __forceinline__ void prep_item(const float* W, int K, int Nsrc, bf16_t* WT, int map, const float* kscale, LAS float* scr, int item, int lane) {
    const int nblk_k = K / 64, nb = item / nblk_k, kb = item % nblk_k, k0 = 64 * kb, n0 = 32 * nb;
    const int sc = srccol(map, n0 + (lane & 31));
#pragma unroll 8
    for (int i = 0; i < 32; ++i) { const int kk = 2 * i + (lane >> 5); float v = 0.f; if (sc >= 0) { v = W[(size_t)(k0 + kk) * Nsrc + sc]; if (kscale) v *= kscale[k0 + kk]; } scr[kk * 33 + (lane & 31)] = v; }
    asm volatile("s_waitcnt lgkmcnt(0)" ::: "memory");
    const int c = lane & 7;
#pragma unroll
    for (int j = 0; j < 4; ++j) { const int n = (lane >> 3) + 8 * j; const LAS float* s = scr + (8 * c) * 33 + n;
        u32x4 o; o.x = pk2(s[0 * 33], s[1 * 33]); o.y = pk2(s[2 * 33], s[3 * 33]); o.z = pk2(s[4 * 33], s[5 * 33]); o.w = pk2(s[6 * 33], s[7 * 33]);
        *(u32x4*)(WT + (size_t)(n0 + n) * K + k0 + 8 * c) = o; }
    asm volatile("s_waitcnt lgkmcnt(0)" ::: "memory");
}
__device__ __forceinline__ void prep_layer_weights(CParams& P, int layer, LAS float* scr, int gw, int ngw, int lane) {
    const int li = layer >> 1;
    if (layer & 1) {
        const int nIn = (2560 / 32) * 16, nOut = (1024 / 32) * 16;
        for (int it = gw; it < nIn + nOut; it += ngw) {
            if (it < nIn) prep_item(P.in[I_WWIN] + (size_t)li * 1024 * WIN_IN, 1024, WIN_IN, ws_bf(P, WS_WIN), MAP_IN_ODD, nullptr, scr, it, lane);
            else prep_item(P.in[I_WWOUT] + (size_t)li * 1024 * 1024, 1024, 1024, ws_bf(P, layer & 1 ? WS_WOUT1 : WS_WOUT0), MAP_OUT, nullptr, scr, it - nIn, lane);
        }
    } else {
        const int nIn = (2816 / 32) * 16, nOut = (1024 / 32) * 16, nUq = (768 / 32) * 6, nUkv = (1024 / 32) * 4;
        for (int it = gw; it < nIn + nOut + nUq + nUkv; it += ngw) {
            int r = it;
            if (r < nIn) { prep_item(P.in[I_ABWIN] + (size_t)li * 1024 * AB_IN, 1024, AB_IN, ws_bf(P, WS_WIN), MAP_IN_EVEN, nullptr, scr, r, lane); continue; } r -= nIn;
            if (r < nOut) { prep_item(P.in[I_ABWOUT] + (size_t)li * 1024 * 1024, 1024, 1024, ws_bf(P, WS_WOUT0), MAP_OUT, nullptr, scr, r, lane); continue; } r -= nOut;
            if (r < nUq) { prep_item(P.in[I_WUQ] + (size_t)li * 384 * 768, 384, 768, ws_bf(P, WS_WUQ), MAP_UQ, P.in[I_QNG] + li * 384, scr, r, lane); continue; } r -= nUq;
            prep_item(P.in[I_WUKV] + (size_t)li * 256 * 1024, 256, 1024, ws_bf(P, WS_WUKV), MAP_UKV, nullptr, scr, r, lane);
        }
    }
}
__device__ void fast_biasL(CParams& P, long gt, long gn) {
    float* biasl = ws_f32(P, WS_BIASL); const float* mod = ws_f32(P, WS_MOD);
    for (long i = gt; i < 4L * 5 * 2816; i += gn) {
        const int n = (int)(i % 2816), c = (int)((i / 2816) % 5), l = (int)(i / (2816 * 5));
        const int N = (l & 1) ? WIN_IN : AB_IN; float s = 0.f;
        const int sc = (n < ((l & 1) ? 2560 : 2816)) ? srccol((l & 1) ? MAP_IN_ODD : MAP_IN_EVEN, n) : -1;
        if (sc >= 0) { const float* w = ((l & 1) ? P.in[I_WWIN] : P.in[I_ABWIN]) + (size_t)(l >> 1) * 1024 * N + sc; const float* sh = mod + (l * 5 + c) * 3072;
            for (int k = 0; k < 1024; ++k) s += sh[k] * w[(size_t)k * N]; }
        biasl[i] = s;
    }
}

#define EPI_ROW(ai, m) (u.pm * 256 + (ai) * 128 + wr * 64 + (m) * 16 + fr)
typedef f32x4 AccT[2][2][4][2];

struct EpiOut {
    static constexpr bool PERM = false, AFTER_DRAIN = false;
    CParams* Pp; int layer;
    __device__ __forceinline__ void operator()(const AccT& acc, const pg8::Unit& u, int wr, int wc, int fr_, int fq_) const {
        int fr = fr_, fq = fq_; asm volatile("" : "+v"(fr), "+v"(fq));
        CParams* Pl = Pp; asm volatile("" : "+s"(Pl)); CParams& P = *Pl;
        const int cond = u.pm < 32 ? 4 : (u.pm - 32) >> 4;
        const float* gate = ws_f32(P, WS_MOD) + (layer * 5 + cond) * 3072 + 2048; const float* gsn = ws_f32(P, WS_GS) + ((layer + 1) * 5 + cond) * 1024;
        bf16_t* An = ws_bf(P, (layer & 1) ? WS_AEVEN : WS_AODD); float* SS = ws_f32(P, WS_SS);
        float ssq[2][4];
#pragma unroll
        for (int ai = 0; ai < 2; ++ai)
#pragma unroll
            for (int m = 0; m < 4; ++m) ssq[ai][m] = 0.f;
#pragma unroll
        for (int bj = 0; bj < 2; ++bj) {
            const int col = u.pn * 256 + 128 * bj + 32 * wc + 8 * fq;
            const f32x4 g0 = *(const f32x4*)(gate + col), g1 = *(const f32x4*)(gate + col + 4);
            f32x4 s0 = {0.f, 0.f, 0.f, 0.f}, s1 = s0; if (layer < 3) { s0 = *(const f32x4*)(gsn + col); s1 = *(const f32x4*)(gsn + col + 4); }
#pragma unroll
            for (int ai = 0; ai < 2; ++ai)
#pragma unroll
                for (int m = 0; m < 4; ++m) {
                    const int row = EPI_ROW(ai, m); const float* yo = y_row(P, layer, row) + col; float* yn = P.out + (size_t)row * 1024 + col;
                    const f32x4 y0 = *(const f32x4*)(yo) + g0 * acc[ai][bj][m][0], y1 = *(const f32x4*)(yo + 4) + g1 * acc[ai][bj][m][1];
                    *(f32x4*)(yn) = y0; *(f32x4*)(yn + 4) = y1; ssq[ai][m] += sum4sq(y0) + sum4sq(y1);
                    if (layer < 3) *(u32x4*)(An + (size_t)row * 1024 + col) = pk8(y0 * s0, y1 * s1);
                    if (m & 1) asm volatile("" ::: "memory");
                }
        }
        if (layer < 3) {
#pragma unroll
            for (int ai = 0; ai < 2; ++ai)
#pragma unroll
                for (int m = 0; m < 4; ++m) { const float s = fq_sum(ssq[ai][m]); if (fq == 0) SS[EPI_ROW(ai, m) * 16 + u.pn * 4 + wc] = s; }
        }
    }
};

__device__ __forceinline__ void rope4(f32x4& x0, f32x4& x1, const float* cs) {
    const f32x4 a = *(const f32x4*)cs, b = *(const f32x4*)(cs + 4);
    const f32x4 c = {a[0], a[2], b[0], b[2]}, s = {a[1], a[3], b[1], b[3]};
    const f32x4 y0 = x0 * c - x1 * s, y1 = x0 * s + x1 * c; x0 = y0; x1 = y1;
}

template <bool ODD> struct EpiIn {
    static constexpr bool PERM = false, AFTER_DRAIN = false;
    CParams* Pp; int layer; LAS float* xch;
    __device__ __forceinline__ void operator()(const AccT& acc, const pg8::Unit& u, int wr, int wc, int fr_, int fq_) const {
        int fr = fr_, fq = fq_; asm volatile("" : "+v"(fr), "+v"(fq));
        CParams* Pl = Pp; asm volatile("" : "+s"(Pl)); CParams& P = *Pl;
        const int pn = u.pn; const bool sample = u.pm >= 32; const int cond = sample ? (u.pm - 32) >> 4 : 4; const int li = layer >> 1;
        const float* SS = ws_f32(P, WS_SS); const float* biasl = ws_f32(P, WS_BIASL) + (layer * 5 + cond) * 2816 + pn * 256;
        const float* r16 = ws_f32(P, WS_ROPE16);
        f32x4 bv[2][2];
#pragma unroll
        for (int bj = 0; bj < 2; ++bj)
#pragma unroll
            for (int n = 0; n < 2; ++n) bv[bj][n] = *(const f32x4*)(biasl + 128 * bj + 32 * wc + 16 * n + 4 * fq);
        enum { K_NAT_G, K_ROPEHEAD, K_V, K_CQ0, K_CQ1, K_CKV, K_RV };
        int kind; bf16_t* gdst = nullptr;
        if (ODD) { kind = pn < 5 ? K_ROPEHEAD : (pn == 5 ? K_V : K_NAT_G); if (pn >= 6) gdst = ws_bf(P, WS_G) + (pn - 6) * 256; }
        else { kind = pn == 0 ? K_CQ0 : pn == 1 ? K_CQ1 : pn == 2 ? K_CKV : pn < 7 ? K_NAT_G : pn < 9 ? K_ROPEHEAD : K_RV; if (pn >= 3 && pn < 7) gdst = ws_bf(P, WS_G) + (pn - 3) * 256; }
        const float* hg = nullptr; f32x4 hgv[2][2];
        if (ODD && pn < 5) { hg = (pn < 4 ? P.in[I_WQHG] : P.in[I_WKHG]) + li * 64;
#pragma unroll
            for (int bj = 0; bj < 2; ++bj)
#pragma unroll
                for (int n = 0; n < 2; ++n) hgv[bj][n] = *(const f32x4*)(hg + 32 * bj + 16 * n + 4 * fq); }
        if (!ODD && kind == K_CKV) {
#pragma unroll
            for (int ai = 0; ai < 2; ++ai)
#pragma unroll
                for (int m = 0; m < 4; ++m) { const int row = EPI_ROW(ai, m); const float rs = row_rstd(SS, row); float s = 0.f;
#pragma unroll
                    for (int bj = 0; bj < 2; ++bj)
#pragma unroll
                        for (int n = 0; n < 2; ++n) s += sum4sq(acc[ai][bj][m][n] * rs + bv[bj][n]);
                    s = fq_sum(s); if (fq == 0) xch[(ai * 128 + wr * 64 + m * 16 + fr) * 4 + wc] = s; }
            asm volatile("s_waitcnt lgkmcnt(0)" ::: "memory"); __builtin_amdgcn_s_barrier(); asm volatile("" ::: "memory");
        }
#pragma unroll
        for (int ai = 0; ai < 2; ++ai)
#pragma unroll
            for (int m = 0; m < 4; ++m) {
                const int row = EPI_ROW(ai, m); const float rs = row_rstd(SS, row);
                f32x4 v[2][2];
#pragma unroll
                for (int bj = 0; bj < 2; ++bj)
#pragma unroll
                    for (int n = 0; n < 2; ++n) v[bj][n] = acc[ai][bj][m][n] * rs + bv[bj][n];
                const int t = (row - NP_ROWS) & 4095, pr = t >> 6, pc = t & 63;
                if (kind == K_NAT_G) {
#pragma unroll
                    for (int bj = 0; bj < 2; ++bj) { f32x4 a = v[bj][0], b = v[bj][1];
#pragma unroll
                        for (int e = 0; e < 4; ++e) { a[e] = silu_f(a[e]); b[e] = silu_f(b[e]); }
                        *(u32x4*)(gdst + (size_t)row * 1024 + 128 * bj + 32 * wc + 8 * fq) = pk8(a, b); }
                } else if (kind == K_ROPEHEAD) {
                    if (ODD) {
                        float s = 0.f;
#pragma unroll
                        for (int bj = 0; bj < 2; ++bj) s += sum4sq(v[bj][0]) + sum4sq(v[bj][1]);
                        s = fq_sum(s); const float hr = 1.0f / sqrtf(s * (1.f / 64.f) + EPS);
#pragma unroll
                        for (int bj = 0; bj < 2; ++bj)
#pragma unroll
                            for (int n = 0; n < 2; ++n) v[bj][n] = v[bj][n] * hr * hgv[bj][n];
                        if (pn == 4 && !sample) { float* ok = P.out + (layer == 1 ? O_L1K : O_L3K) + (size_t)row * 256 + wc * 64;
#pragma unroll
                            for (int bj = 0; bj < 2; ++bj)
#pragma unroll
                                for (int n = 0; n < 2; ++n) *(f32x4*)(ok + 32 * bj + 16 * n + 4 * fq) = v[bj][n]; }
                        if (sample) { rope4(v[0][0], v[0][1], r16 + (pr * 16 + 4 * fq) * 2); rope4(v[1][0], v[1][1], r16 + (pc * 16 + 4 * fq) * 2); }
                        if (pn < 4) { const float qs = 0.125f * LOG2E; bf16_t* q = ws_bf(P, WS_QW) + (size_t)row * 1024 + (4 * pn + wc) * 64 + 16 * fq;
                            *(u32x4*)(q) = pk8(v[0][0] * qs, v[0][1] * qs); *(u32x4*)(q + 8) = pk8(v[1][0] * qs, v[1][1] * qs);
                        } else { int kin; const int tile = kv_tile(row, wc, 4, kin); unsigned char* kb = P.ws + WS_KWIMG + (size_t)tile * 8192 + kin * 16;
                            *(u32x4*)(kb + (2 * fq) * 1024) = pk8(v[0][0], v[0][1]); *(u32x4*)(kb + (2 * fq + 1) * 1024) = pk8(v[1][0], v[1][1]); }
                    } else {
                        if (pn == 7) {
#pragma unroll
                            for (int bj = 0; bj < 2; ++bj) { v[bj][0] = v[bj][0] * 0.125f; v[bj][1] = v[bj][1] * 0.125f; } }
                        if (sample) { rope4(v[0][0], v[0][1], r16 + (pr * 16 + 4 * fq) * 2); rope4(v[1][0], v[1][1], r16 + (pc * 16 + 4 * fq) * 2); }
                        bf16_t* q = ws_bf(P, pn == 7 ? WS_RQ : WS_RK) + (size_t)row * 256 + wc * 64 + 16 * fq;
                        *(u32x4*)(q) = pk8(v[0][0], v[0][1]); *(u32x4*)(q + 8) = pk8(v[1][0], v[1][1]);
                    }
                } else if (kind == K_V) {
                    if (!sample) { float* ov = P.out + (layer == 1 ? O_L1V : O_L3V) + (size_t)row * 256 + wc * 64 + 16 * fq;
#pragma unroll
                        for (int bj = 0; bj < 2; ++bj) { *(f32x4*)(ov + 8 * bj) = v[bj][0]; *(f32x4*)(ov + 8 * bj + 4) = v[bj][1]; } }
                    int kin; const int tile = kv_tile(row, wc, 4, kin); unsigned char* vb = P.ws + WS_VWIMG + (size_t)tile * 8192 + (fq >> 1) * 4096 + kin * 64 + (fq & 1) * 32;
                    *(u32x4*)(vb) = pk8(v[0][0], v[0][1]); *(u32x4*)(vb + 16) = pk8(v[1][0], v[1][1]);
                } else if (kind == K_CQ0 || kind == K_CQ1) {
                    bf16_t* cq = ws_bf(P, WS_CQ) + (size_t)row * 384; float* sscq = ws_f32(P, WS_SSCQ);
                    if (kind == K_CQ0) {
#pragma unroll
                        for (int bj = 0; bj < 2; ++bj) *(u32x4*)(cq + 128 * bj + 32 * wc + 8 * fq) = pk8(v[bj][0], v[bj][1]);
                        float s = sum4sq(v[0][0]) + sum4sq(v[0][1]) + sum4sq(v[1][0]) + sum4sq(v[1][1]); s = fq_sum(s); if (fq == 0) sscq[row * 8 + wc] = s;
                    } else {
                        *(u32x4*)(cq + 256 + 32 * wc + 8 * fq) = pk8(v[0][0], v[0][1]);
                        float s = sum4sq(v[0][0]) + sum4sq(v[0][1]); s = fq_sum(s); if (fq == 0) sscq[row * 8 + 4 + wc] = s;
                        if (wc == 0) {
                            *(u32x4*)(ws_bf(P, WS_KR) + (size_t)row * 32 + 8 * fq) = pk8(v[1][0], v[1][1]);
                            float s2 = sum4sq(v[1][0]) + sum4sq(v[1][1]); s2 = fq_sum(s2); if (fq == 0) ws_f32(P, WS_SSKR)[row] = s2;
                            if (!sample) { float* okr = P.out + (layer == 0 ? O_L0KR : O_L2KR) + (size_t)row * 32 + 16 * (fq >> 1) + 4 * (fq & 1); *(f32x4*)(okr) = v[1][0]; *(f32x4*)(okr + 8) = v[1][1]; }
                        }
                    }
                } else if (kind == K_CKV) {
                    const LAS float* xr = xch + (ai * 128 + wr * 64 + m * 16 + fr) * 4; const float s = (xr[0] + xr[1]) + (xr[2] + xr[3]);
                    const float cr = 1.0f / sqrtf(s * (1.f / 256.f) + EPS); const float* gkv = P.in[I_KVNG] + li * 256;
#pragma unroll
                    for (int bj = 0; bj < 2; ++bj) { const int col = 128 * bj + 32 * wc + 8 * fq;
                        const f32x4 a = v[bj][0] * cr * *(const f32x4*)(gkv + col), b = v[bj][1] * cr * *(const f32x4*)(gkv + col + 4);
                        *(u32x4*)(ws_bf(P, WS_CKVN) + (size_t)row * 256 + col) = pk8(a, b);
                        if (!sample) { float* oc = P.out + (layer == 0 ? O_L0CKV : O_L2CKV) + (size_t)row * 256 + col; *(f32x4*)(oc) = a; *(f32x4*)(oc + 4) = b; } }
                } else {
                    bf16_t* rv = ws_bf(P, WS_RV) + (size_t)row * 512 + (2 * (pn - 9) + (wc >> 1)) * 128 + 64 * (wc & 1) + 16 * fq;
                    *(u32x4*)(rv) = pk8(v[0][0], v[0][1]); *(u32x4*)(rv + 8) = pk8(v[1][0], v[1][1]);
                }
            }
        if (!ODD && kind == K_CKV) { asm volatile("s_waitcnt lgkmcnt(0)" ::: "memory"); __builtin_amdgcn_s_barrier(); asm volatile("" ::: "memory"); }
    }
};

struct EpiUq {
    static constexpr bool PERM = false, AFTER_DRAIN = false;
    CParams* Pp; int layer;
    __device__ __forceinline__ void operator()(const AccT& acc, const pg8::Unit& u, int wr, int wc, int fr_, int fq_) const {
        int fr = fr_, fq = fq_; asm volatile("" : "+v"(fr), "+v"(fq));
        CParams* Pl = Pp; asm volatile("" : "+s"(Pl)); CParams& P = *Pl;
        bf16_t* QR = ws_bf(P, WS_QR); const float* sscq = ws_f32(P, WS_SSCQ);
#pragma unroll
        for (int ai = 0; ai < 2; ++ai)
#pragma unroll
            for (int m = 0; m < 4; ++m) { const int row = EPI_ROW(ai, m);
                float s = sum4sq(acc[ai][0][m][0]) + sum4sq(acc[ai][0][m][1]) + sum4sq(acc[ai][1][m][0]) + sum4sq(acc[ai][1][m][1]);
                if (u.pn < 2) { const int head = 4 * u.pn + wc; bf16_t* q = QR + ((size_t)row * 8 + head) * 96 + 16 * fq;
                    *(u32x4*)(q) = pk8(acc[ai][0][m][0], acc[ai][0][m][1]); *(u32x4*)(q + 8) = pk8(acc[ai][1][m][0], acc[ai][1][m][1]);
                    s = fq_sum(s);
                    if (fq == 0) { float c = 0.f;
#pragma unroll
                        for (int j = 0; j < 8; ++j) c += sscq[row * 8 + j];
                        ws_f32(P, WS_SSQN)[row * 8 + head] = s + 96.f * EPS * (c * (1.f / 384.f) + EPS); }
                } else { const int head = 2 * wc + (fq >> 1); bf16_t* q = QR + ((size_t)row * 8 + head) * 96 + 64 + 16 * (fq & 1);
                    *(u32x4*)(q) = pk8(acc[ai][0][m][0], acc[ai][0][m][1]); *(u32x4*)(q + 8) = pk8(acc[ai][1][m][0], acc[ai][1][m][1]);
                    s += xor_shfl<16>(s);
                    if ((fq & 1) == 0) ws_f32(P, WS_SSQR)[row * 8 + head] = s; }
            }
    }
};

struct EpiUkv {
    static constexpr bool PERM = false, AFTER_DRAIN = false;
    CParams* Pp; int layer;
    __device__ __forceinline__ void operator()(const AccT& acc, const pg8::Unit& u, int wr, int wc, int fr_, int fq_) const {
        int fr = fr_, fq = fq_; asm volatile("" : "+v"(fr), "+v"(fq));
        CParams* Pl = Pp; asm volatile("" : "+s"(Pl)); CParams& P = *Pl;
        const int li = layer >> 1; const float* gk = P.in[I_KHG] + li * 96; const float* r8 = ws_f32(P, WS_ROPE8); const float* sskr = ws_f32(P, WS_SSKR); const bf16_t* KR = ws_bf(P, WS_KR);
        const bool lat = (u.pm >= 32 && u.pm < 96);
#pragma unroll
        for (int ai = 0; ai < 2; ++ai)
#pragma unroll
            for (int m = 0; m < 4; ++m) { const int R = EPI_ROW(ai, m);
                if (u.pn < 2) { const int head = 4 * u.pn + wc; int kin; const int tile = kv_tile(R, head, 8, kin); unsigned char* kb = P.ws + WS_KIMG + (size_t)tile * 12288 + kin * 16;
                    float s = sum4sq(acc[ai][0][m][0]) + sum4sq(acc[ai][0][m][1]) + sum4sq(acc[ai][1][m][0]) + sum4sq(acc[ai][1][m][1]);
                    s = fq_sum(s) + sskr[R]; const float rs = 1.0f / sqrtf(s * (1.f / 96.f) + EPS);
#pragma unroll
                    for (int bj = 0; bj < 2; ++bj) { const float* g = gk + 16 * fq + 8 * bj;
                        *(u32x4*)(kb + (2 * fq + bj) * 1024) = pk8(acc[ai][bj][m][0] * rs * *(const f32x4*)(g), acc[ai][bj][m][1] * rs * *(const f32x4*)(g + 4)); }
                    const u32x4 kr = *(const u32x4*)(KR + (size_t)R * 32 + 8 * fq); const int jb = 16 * (fq >> 1) + 4 * (fq & 1);
                    f32x4 x1 = {__uint_as_float(kr.x << 16), __uint_as_float(kr.x & 0xffff0000u), __uint_as_float(kr.y << 16), __uint_as_float(kr.y & 0xffff0000u)};
                    f32x4 x2 = {__uint_as_float(kr.z << 16), __uint_as_float(kr.z & 0xffff0000u), __uint_as_float(kr.w << 16), __uint_as_float(kr.w & 0xffff0000u)};
                    x1 = x1 * rs * *(const f32x4*)(gk + 64 + jb); x2 = x2 * rs * *(const f32x4*)(gk + 64 + jb + 8);
                    if (lat) { const int t = (R - NP_ROWS) & 4095; const int pos = (fq >> 1) ? (t & 63) : (t >> 6); rope4(x1, x2, r8 + (pos * 8 + 4 * (fq & 1)) * 2); }
                    *(u32x4*)(kb + (8 + fq) * 1024) = pk8(x1, x2);
                } else { const int head = 4 * (u.pn - 2) + wc; int kin; const int tile = kv_tile(R, head, 8, kin);
                    unsigned char* vb = P.ws + WS_VIMG + (size_t)tile * 8192 + (fq >> 1) * 4096 + kin * 64 + (fq & 1) * 32;
                    *(u32x4*)(vb) = pk8(acc[ai][0][m][0], acc[ai][0][m][1]); *(u32x4*)(vb + 16) = pk8(acc[ai][1][m][0], acc[ai][1][m][1]); }
            }
    }
};
typedef short bf16x8 __attribute__((ext_vector_type(8)));
typedef float f32x16 __attribute__((ext_vector_type(16)));
typedef short v4i16_t __attribute__((ext_vector_type(4)));
__device__ __forceinline__ int crow(int r, int hi) { return (r & 3) + 8 * (r >> 2) + 4 * hi; }
__device__ __forceinline__ v4i16_t vtr(const LAS unsigned char* p) { return __builtin_amdgcn_ds_read_tr16_b64_v4i16((LAS v4i16_t*)p); }
#define ATT_BAR() asm volatile("s_waitcnt vmcnt(0) lgkmcnt(0)\n\ts_barrier" ::: "memory")

constexpr int AT_K0 = 0, AT_KSZ = 12288, AT_V0 = 2 * AT_KSZ, AT_VSZ = 8192, AT_WS = AT_V0 + 2 * AT_VSZ, AT_OST = AT_WS + 8 * 256, AT_END = AT_OST + 8 * 4096;
static_assert(AT_END <= RING_BYTES, "attention LDS map");

struct AttnTiles { const unsigned char* kbase; const unsigned char* vbase; int a0, nA, b0, nB; };

template <int DQK>
__device__ __forceinline__ void attn_unit(LAS unsigned char* lds, const AttnTiles& T, const bf16x8 (&qf)[DQK / 16], float bnd, int maskq, int klo, int qb,
                                          f32x16 (&o)[2], float& lsum, int wave, int lane, int tid) {
    constexpr int KT = DQK * 128;
    constexpr int NS = DQK / 16;
    const int r = lane & 31, hh = lane >> 5;
    const int nT = T.nA + T.nB;
    u32x4 kr0, kr1 = {0u, 0u, 0u, 0u}, vr;
    const bool k2 = (DQK == 96) && (tid < 256);
#define AT_TILE(i) ((i) < T.nA ? T.a0 + (i) : T.b0 + ((i) - T.nA))
#define AT_LOAD(i) do { const int ti_ = AT_TILE(i); const unsigned char* kp_ = T.kbase + (size_t)ti_ * KT; kr0 = *(const u32x4*)(kp_ + tid * 16); \
        if (k2) kr1 = *(const u32x4*)(kp_ + 8192 + tid * 16); vr = *(const u32x4*)(T.vbase + (size_t)ti_ * 8192 + tid * 16); } while (0)
#define AT_STORE(b) do { *(LAS u32x4*)(lds + AT_K0 + (b) * AT_KSZ + tid * 16) = kr0; if (k2) *(LAS u32x4*)(lds + AT_K0 + (b) * AT_KSZ + 8192 + tid * 16) = kr1; \
        *(LAS u32x4*)(lds + AT_V0 + (b) * AT_VSZ + tid * 16) = vr; } while (0)
    f32x16 negb;
#pragma unroll
    for (int i = 0; i < 16; ++i) negb[i] = -bnd;
    AT_LOAD(0); AT_STORE(0); ATT_BAR();
    for (int it = 0; it < nT; ++it) {
        const int cur = it & 1;
        const bool more = it + 1 < nT;
        if (more) AT_LOAD(it + 1);
        const LAS unsigned char* kb = lds + AT_K0 + cur * AT_KSZ + hh * 1024 + r * 16;
        f32x16 p0 = negb, p1 = negb;
#pragma unroll
        for (int s = 0; s < NS; ++s) {
            const bf16x8 k0 = *(const LAS bf16x8*)(kb + s * 2048), k1 = *(const LAS bf16x8*)(kb + s * 2048 + 512);
            p0 = __builtin_amdgcn_mfma_f32_32x32x16_bf16(k0, qf[s], p0, 0, 0, 0);
            p1 = __builtin_amdgcn_mfma_f32_32x32x16_bf16(k1, qf[s], p1, 0, 0, 0);
        }
#pragma unroll
        for (int i = 0; i < 16; ++i) { p0[i] = __builtin_amdgcn_exp2f(p0[i]); p1[i] = __builtin_amdgcn_exp2f(p1[i]); }
        if (maskq >= 0 && it >= T.nA) {
            const int kt = klo + (it - T.nA);
            if (kt == qb - 2 || kt == qb + 2) {
                const int q = maskq + r, k0i = 64 * kt + 4 * hh;
#pragma unroll
                for (int i = 0; i < 16; ++i) { const int d0 = k0i + (i & 3) + 8 * (i >> 2) - q, d1 = d0 + 32;
                    if (d0 > 128 || d0 < -128) p0[i] = 0.f; if (d1 > 128 || d1 < -128) p1[i] = 0.f; }
            }
        }
        { float s0 = 0.f, s1 = 0.f;
#pragma unroll
          for (int i = 0; i < 16; ++i) { s0 += p0[i]; s1 += p1[i]; }
          lsum += s0 + s1; }
        u32x4 pw[4];
#pragma unroll
        for (int j = 0; j < 4; ++j) { pw[0][j] = pk2(p0[2 * j], p0[2 * j + 1]); pw[1][j] = pk2(p0[8 + 2 * j], p0[8 + 2 * j + 1]); pw[2][j] = pk2(p1[2 * j], p1[2 * j + 1]); pw[3][j] = pk2(p1[8 + 2 * j], p1[8 + 2 * j + 1]); }
        const LAS unsigned char* vb = lds + AT_V0 + cur * AT_VSZ + ((lane >> 4) & 1) * 32 + (lane & 3) * 8 + (4 * hh + ((lane & 15) >> 2)) * 64;
#pragma unroll
        for (int d0 = 0; d0 < 2; ++d0)
#pragma unroll
            for (int ks = 0; ks < 4; ++ks) {
                const v4i16_t lo = vtr(vb + d0 * 4096 + ks * 1024), hi = vtr(vb + d0 * 4096 + ks * 1024 + 512);
                const bf16x8 vf = {lo[0], lo[1], lo[2], lo[3], hi[0], hi[1], hi[2], hi[3]};
                o[d0] = __builtin_amdgcn_mfma_f32_32x32x16_bf16(__builtin_bit_cast(bf16x8, pw[ks]), vf, o[d0], 0, 0, 0);
            }
        if (more) AT_STORE(cur ^ 1);
        ATT_BAR();
    }
#undef AT_LOAD
#undef AT_TILE
#undef AT_STORE
}
__device__ __forceinline__ void attn_finish(LAS unsigned char* lds, f32x16 (&o)[2], float lsum, float ladd, bf16_t* G, int row0, int col0, int wave, int lane) {
    const int r = lane & 31, hh = lane >> 5;
    LAS float* wsf = (LAS float*)(lds + AT_WS) + wave * 64;
    const float l = sum_halves(lsum) + ladd;
    if (hh == 0) wsf[r] = l;
    asm volatile("s_waitcnt lgkmcnt(0)" ::: "memory");
    LAS bf16_t* stg = (LAS bf16_t*)(lds + AT_OST) + wave * 2048;
#pragma unroll
    for (int i = 0; i < 16; ++i) { const int orow = crow(i, hh); const float rl = __builtin_amdgcn_rcpf(wsf[orow]);
#pragma unroll
        for (int d0 = 0; d0 < 2; ++d0) stg[orow * 64 + d0 * 32 + r] = f2bf(o[d0][i] * rl); }
    asm volatile("s_waitcnt lgkmcnt(0)" ::: "memory");
#pragma unroll
    for (int i = 0; i < 4; ++i) { const int row = i * 8 + (lane >> 3), ch = lane & 7;
        const u32x4 v = *(const LAS u32x4*)(stg + row * 64 + ch * 8); bf16_t* gp = G + (size_t)(row0 + row) * 1024 + col0 + ch * 8; const u32x4 g = *(const u32x4*)gp;
        u32x4 w;
#pragma unroll
        for (int j = 0; j < 4; ++j) { const float a0 = __uint_as_float(v[j] << 16) * __uint_as_float(g[j] << 16), a1 = __uint_as_float(v[j] & 0xffff0000u) * __uint_as_float(g[j] & 0xffff0000u); w[j] = pk2(a0, a1); }
        *(u32x4*)gp = w; }
    asm volatile("s_waitcnt lgkmcnt(0)" ::: "memory");
}
__device__ __forceinline__ f32x4 unpk_lo(const u32x4& v) { return (f32x4){__uint_as_float(v.x << 16), __uint_as_float(v.x & 0xffff0000u), __uint_as_float(v.y << 16), __uint_as_float(v.y & 0xffff0000u)}; }
__device__ __forceinline__ f32x4 unpk_hi(const u32x4& v) { return (f32x4){__uint_as_float(v.z << 16), __uint_as_float(v.z & 0xffff0000u), __uint_as_float(v.w << 16), __uint_as_float(v.w & 0xffff0000u)}; }

__device__ __forceinline__ void mla_unit(CParams& P, int layer, LAS unsigned char* lds, bool sample, int b, int h, int qblk, int wave, int lane, int tid) {
    const int li = layer >> 1, r = lane & 31, hh = lane >> 5;
    const int row0 = (sample ? NP_ROWS + b * 4096 + qblk * 256 : b * 256) + wave * 32, row = row0 + r;
    bf16x8 qf[6];
    { const bf16_t* QR = ws_bf(P, WS_QR) + ((size_t)row * 8 + h) * 96; const float* gq = P.in[I_QHG] + li * 96; const float* r8 = ws_f32(P, WS_ROPE8);
      const float ss = ws_f32(P, WS_SSQN)[row * 8 + h] + ws_f32(P, WS_SSQR)[row * 8 + h]; const float rs = 1.0f / sqrtf(ss * (1.f / 96.f)); const float qs = 0.10206207261596575f * LOG2E;
      const int t = (row - NP_ROWS) & 4095;
#pragma unroll
      for (int s = 0; s < 6; ++s) { const u32x4 raw = *(const u32x4*)(QR + 16 * s + 8 * hh); f32x4 x0 = unpk_lo(raw), x1 = unpk_hi(raw);
          if (s < 4) { const float* g = gq + 16 * s + 8 * hh; x0 = x0 * rs * *(const f32x4*)(g); x1 = x1 * rs * *(const f32x4*)(g + 4); }
          else { const int base = 16 * (s - 4) + 4 * hh; x0 = x0 * rs * *(const f32x4*)(gq + 64 + base); x1 = x1 * rs * *(const f32x4*)(gq + 64 + base + 8);
              if (sample) { const int pos = (s == 4) ? (t >> 6) : (t & 63); rope4(x0, x1, r8 + (pos * 8 + 4 * hh) * 2); } }
          qf[s] = __builtin_bit_cast(bf16x8, pk8(x0 * qs, x1 * qs)); } }
    AttnTiles T; T.kbase = P.ws + WS_KIMG; T.vbase = P.ws + WS_VIMG; T.a0 = kv_seq_tile0(sample, b, h, 8); T.nA = sample ? 72 : 4; T.b0 = 0; T.nB = 0;
    f32x16 o[2]; float lsum = 0.f;
#pragma unroll
    for (int i = 0; i < 16; ++i) { o[0][i] = 0.f; o[1][i] = 0.f; }
    attn_unit<96>(lds, T, qf, ws_f32(P, WS_BND)[li], -1, 0, 0, o, lsum, wave, lane, tid);
    attn_finish(lds, o, lsum, 0.f, ws_bf(P, WS_G), row0, h * 64, wave, lane);
}
__device__ __forceinline__ void mla_phase(CParams& P, int layer, LAS unsigned char* lds, int wave, int lane, int tid) {
    const int G = gridDim.x, bx = blockIdx.x; const int vcu = (G % 8 == 0) ? (bx % 8) * (G / 8) + bx / 8 : bx;
    for (int u = vcu * 2; u < 512; u += 2 * G)
        for (int j = 0; j < 2; ++j) { const int uu = u + j; mla_unit(P, layer, lds, true, (uu >> 4) >> 3, (uu >> 4) & 7, uu & 15, wave, lane, tid); }
    for (int u = vcu; u < 256; u += G) mla_unit(P, layer, lds, false, u >> 3, u & 7, 0, wave, lane, tid);
}
__device__ __forceinline__ void win_unit(CParams& P, int layer, LAS unsigned char* lds, bool sample, int b, int kvh, int qb, int wave, int lane, int tid) {
    const int li = layer >> 1, r = lane & 31, hh = lane >> 5; const int head = 4 * kvh + (wave >> 1);
    const int qlat = qb * 64 + (wave & 1) * 32;
    const int row0 = (sample ? NP_ROWS + b * 4096 : b * 256) + qlat, row = row0 + r;
    bf16x8 qf[4];
    { const bf16_t* q = ws_bf(P, WS_QW) + (size_t)row * 1024 + head * 64 + 8 * hh;
#pragma unroll
      for (int s = 0; s < 4; ++s) qf[s] = *(const bf16x8*)(q + 16 * s); }
    const float* bf = ws_f32(P, WS_BND); const float knorm = fmaxf(8.f * bf[10 + li], sqrtf(bf[4 + li])); const float bnd = 0.125f * LOG2E * 8.f * bf[8 + li] * knorm;
    AttnTiles T; T.kbase = P.ws + WS_KWIMG; T.vbase = P.ws + WS_VWIMG; const int t0 = kv_seq_tile0(sample, b, kvh, 4);
    int klo = 0;
    if (sample) { klo = max(qb - 2, 0); const int khi = min(qb + 2, 63); T.a0 = t0; T.nA = 8; T.b0 = t0 + 8 + klo; T.nB = khi - klo + 1; }
    else { T.a0 = t0; T.nA = 4; T.b0 = 0; T.nB = 0; }
    f32x16 o[2]; float lsum = 0.f;
#pragma unroll
    for (int i = 0; i < 16; ++i) { o[0][i] = 0.f; o[1][i] = 0.f; }
    attn_unit<64>(lds, T, qf, bnd, sample ? qlat : -1, klo, qb, o, lsum, wave, lane, tid);
    attn_finish(lds, o, lsum, __builtin_amdgcn_exp2f(P.in[I_SINK][li * 16 + head] * LOG2E - bnd), ws_bf(P, WS_G), row0, head * 64, wave, lane);
}
__device__ __forceinline__ void win_phase(CParams& P, int layer, LAS unsigned char* lds, int wave, int lane, int tid) {
    const int G = gridDim.x, bx = blockIdx.x; const int vcu = (G % 8 == 0) ? (bx % 8) * (G / 8) + bx / 8 : bx;
    for (int u = vcu * 4; u < 1024; u += 4 * G)
        for (int j = 0; j < 4; ++j) { const int uu = u + j; win_unit(P, layer, lds, true, (uu >> 6) >> 2, (uu >> 6) & 3, uu & 63, wave, lane, tid); }
    for (int u = vcu * 2; u < 512; u += 2 * G)
        for (int j = 0; j < 2; ++j) { const int uu = u + j; win_unit(P, layer, lds, false, (uu >> 2) >> 2, (uu >> 2) & 3, uu & 3, wave, lane, tid); }
}
typedef __attribute__((address_space(1))) unsigned gu32;
#define XB_TMO      128
#define XB_XCNT(j)  (256  + 64 * (j))
#define XB_XSUB(j)  (1280 + 64 * (j))
#define XB_XGEN(j)  (2304 + 64 * (j))
#define XB_TOP      3328
#define XB_TOPGEN   3392
#define XCD_BAR_WORDS 3456
#define XB_SPIN_CAP (1u << 26)
__device__ __forceinline__ unsigned xb_ld(unsigned* p)              { return __hip_atomic_load(p, __ATOMIC_RELAXED, __HIP_MEMORY_SCOPE_AGENT); }
__device__ __forceinline__ unsigned xb_add(unsigned* p, unsigned v) { return __hip_atomic_fetch_add(p, v, __ATOMIC_RELAXED, __HIP_MEMORY_SCOPE_AGENT); }
__device__ __forceinline__ unsigned xb_xcc_id() { return (unsigned)__builtin_amdgcn_s_getreg((3 << 11) | 20) & 0xFu; }
#define XB_SPIN(cond, bar) do { unsigned _sp = 0; while (cond) { __builtin_amdgcn_s_sleep(1); \
    if ((++_sp & 255u) == 0u) { if (xb_ld(&(bar)[XB_TMO])) break; if (_sp > XB_SPIN_CAP) { atomicAdd(&(bar)[XB_TMO], 1u); break; } } } } while (0)
struct XcdBarrier { unsigned* bar; unsigned x; volatile LAS unsigned* st; };
__device__ __forceinline__ XcdBarrier xcd_barrier_post(unsigned* bar, volatile LAS unsigned* st, bool t0) {
    XcdBarrier b; b.bar = bar; b.x = xb_xcc_id(); b.st = st;
    if (t0) (void)xb_add(&bar[XB_XCNT(b.x)], 1u);
    return b;
}
__device__ __forceinline__ void xcd_barrier_complete(unsigned* bar, unsigned x, unsigned& nloc, unsigned& nx) {
    const unsigned G = gridDim.x * gridDim.y * gridDim.z;
    unsigned sum, cnt, mine, sp = 0u;
    for (;;) {
        sum = 0u; cnt = 0u; mine = 0u;
#pragma unroll
        for (unsigned j = 0; j < 16; ++j) { const unsigned c = xb_ld(&bar[XB_XCNT(j)]); sum += c; cnt += (c > 0u) ? 1u : 0u; mine = (j == x) ? c : mine; }
        if (sum == G) break;
        __builtin_amdgcn_s_sleep(1);
        if ((++sp & 255u) == 0u) { if (xb_ld(&bar[XB_TMO])) break; if (sp > XB_SPIN_CAP) { atomicAdd(&bar[XB_TMO], 1u); break; } }
    }
    nloc = mine > 0u ? mine : 1u; nx = cnt > 0u ? cnt : 1u;
}
__device__ __forceinline__ void xcd_barrier(const XcdBarrier& b, bool t0) {
    asm volatile("s_waitcnt vmcnt(0)" ::: "memory");
    __syncthreads();
    if (t0) {
        unsigned* bar = b.bar;
        __builtin_amdgcn_s_waitcnt(0);
        unsigned nloc = b.st[0], nx = b.st[1];
        if (nloc == 0u) { xcd_barrier_complete(bar, b.x, nloc, nx); b.st[0] = nloc; b.st[1] = nx; }
        const unsigned old = xb_add(&bar[XB_XSUB(b.x)], 1u);
        const unsigned gen = old / nloc;
        if (old + 1u == (gen + 1u) * nloc) {
            __builtin_amdgcn_fence(__ATOMIC_RELEASE, "agent");
            asm volatile("s_waitcnt vmcnt(0)" ::: "memory");
            const unsigned og = xb_add(&bar[XB_TOP], 1u);
            const unsigned tg = og / nx;
            if (og + 1u == (tg + 1u) * nx) xb_add(&bar[XB_TOPGEN], 1u);
            else XB_SPIN(xb_ld(&bar[XB_TOPGEN]) == tg, bar);
            __builtin_amdgcn_fence(__ATOMIC_ACQUIRE, "agent");
            xb_add(&bar[XB_XGEN(b.x)], 1u);
            asm volatile("s_waitcnt vmcnt(0)" ::: "memory");
        } else {
            XB_SPIN(xb_ld(&bar[XB_XGEN(b.x)]) == gen, bar);
            __builtin_amdgcn_fence(__ATOMIC_ACQUIRE, "agent");
            asm volatile("s_waitcnt vmcnt(0)" ::: "memory");
        }
    }
    __syncthreads();
}

#ifndef FAST_OUT
#define FAST_OUT 1
#endif
#ifndef FAST_IN_ODD
#define FAST_IN_ODD 1
#endif
#ifndef FAST_IN_EVEN
#define FAST_IN_EVEN 1
#endif
#ifndef FAST_UQ
#define FAST_UQ 1
#endif
#ifndef FAST_UKV
#define FAST_UKV 1
#endif
#ifndef FAST_MLA
#define FAST_MLA 1
#endif
#ifndef FAST_WIN
#define FAST_WIN 1
#endif

enum { K_P0 = 0, K_P1, K_E_IN, K_E_POST, K_E_UQ, K_E_UQSS, K_E_UKV, K_E_KPOST, K_E_SCAN, K_E_ATTN, K_E_OUT, K_E_PREPA, K_O_IN, K_O_POST, K_O_ATTN, K_O_OUT, K_O_PREPA };
template <int KIND, int LAYER> __device__ __forceinline__ void run_phase(LAS unsigned char* L, int wave_s) {
    constexpr int kind = KIND, layer = LAYER;
    CParams* Pq = params_ptr();
#define P (*Pq)
    int ws_ = wave_s; asm volatile("" : "+s"(ws_)); int ln_ = lane_id(); asm volatile("" : "+v"(ln_));
    const int wave = ws_, lane = ln_, tid = wave * 64 + lane;
    const int G = gridDim.x; const long gn = (long)G * NTHREADS, gt = (long)blockIdx.x * NTHREADS + tid; const int gw = blockIdx.x * NWAVES + wave, ngw = G * NWAVES;
    LAS float* wscr = (LAS float*)(L + wave * 16384);
    LAS float* xch = (LAS float*)(L + EPI_OFF);
    (void)lane; (void)gw; (void)ngw; (void)gt; (void)gn; (void)wscr; (void)xch;
    if constexpr (kind == K_P0) {
        nv_zero_bnd(P, 0, gt, gn); nv_mod(P, 0, gt, gn); prep_layer_weights(P, 0, wscr, gw, ngw, lane); nv_ctx_even(P, 0, gt, gn);
    } else if constexpr (kind == K_P1) {
        nv_gs(P, 0, gt, gn); nv_bias(P, 0, gt, gn); fast_biasL(P, gt, gn); nv_prepA(P, 0, gt, gn);
    } else if constexpr (kind == K_E_IN) {
#if FAST_IN_EVEN
        pg8::Gemm g{ws_bf(P, WS_AEVEN), ws_bf(P, WS_WIN), MROWS, 2816, 1024, 1024}; pg8::StaticOrder S; S.init(MROWS, 2816, G, (int)blockIdx.x);
        EpiIn<false> E{Pq, layer, xch}; pg8::gemm_phase<EpiIn<false>, pg8::StaticOrder, true, true>(L, g, S, E, wave_s);
#else
        nv_in_even(P, layer, gt, gn);
#endif
    } else if constexpr (kind == K_E_POST) { nv_post_even(P, layer, gt, gn);
    } else if constexpr (kind == K_E_UQ) {
#if FAST_UQ
        pg8::Gemm g{ws_bf(P, WS_CQ), ws_bf(P, WS_WUQ), MROWS, 768, 384, 384}; pg8::StaticOrder S; S.init(MROWS, 768, G, (int)blockIdx.x);
        EpiUq E{Pq, layer}; pg8::gemm_phase<EpiUq, pg8::StaticOrder, true, true>(L, g, S, E, wave_s);
#else
        nv_uq(P, layer, gt, gn);
#endif
    } else if constexpr (kind == K_E_UQSS) { nv_uq_ss(P, layer, gt, gn);
    } else if constexpr (kind == K_E_UKV) {
#if FAST_UKV
        { pg8::Gemm g{ws_bf(P, WS_CKVN), ws_bf(P, WS_WUKV), MROWS_X, 1024, 256, 256}; pg8::StaticOrder S; S.init(MROWS_X, 1024, G, (int)blockIdx.x);
          EpiUkv E{Pq, layer}; pg8::gemm_phase<EpiUkv, pg8::StaticOrder, true, true>(L, g, S, E, wave_s); }
#else
        nv_ukv(P, layer, gt, gn);
#endif
        nv_u(P, layer, gt, gn);
    } else if constexpr (kind == K_E_KPOST) { nv_k_post(P, layer, gt, gn);
    } else if constexpr (kind == K_E_SCAN) { nv_scan(P, layer, gt, gn);
    } else if constexpr (kind == K_E_ATTN) {
#if FAST_MLA
        mla_phase(P, layer, L, wave, lane, tid);
#else
        nv_mla_attn(P, layer, gt, gn);
#endif
        nv_ret_out(P, layer, gt, gn);
    } else if constexpr (kind == K_O_IN) {
#if FAST_IN_ODD
        pg8::Gemm g{ws_bf(P, WS_AODD), ws_bf(P, WS_WIN), MROWS, 2560, 1024, 1024}; pg8::StaticOrder S; S.init(MROWS, 2560, G, (int)blockIdx.x);
        EpiIn<true> E{Pq, layer, xch}; pg8::gemm_phase<EpiIn<true>, pg8::StaticOrder, true, true>(L, g, S, E, wave_s);
#else
        nv_in_odd(P, layer, gt, gn);
#endif
    } else if constexpr (kind == K_O_POST) { nv_post_odd(P, layer, gt, gn);
    } else if constexpr (kind == K_O_ATTN) {
#if FAST_WIN
        win_phase(P, layer, L, wave, lane, tid);
#else
        nv_win_attn(P, layer, gt, gn);
#endif
    } else if constexpr (kind == K_E_OUT || kind == K_O_OUT) {
        if constexpr (layer < 3) { prep_layer_weights(P, layer + 1, wscr, gw, ngw, lane); if constexpr ((layer + 1) & 1) nv_ctx_odd(P, layer + 1, gt, gn); else nv_ctx_even(P, layer + 1, gt, gn); }
        __syncthreads();
#if FAST_OUT
        pg8::Gemm g{ws_bf(P, WS_G), ws_bf(P, (layer & 1) ? WS_WOUT1 : WS_WOUT0), MROWS, 1024, 1024, 1024}; pg8::StaticOrder S; S.init(MROWS, 1024, G, (int)blockIdx.x);
        EpiOut E{Pq, layer}; pg8::gemm_phase<EpiOut, pg8::StaticOrder, true, true>(L, g, S, E, wave_s);
#else
        nv_out(P, layer, gt, gn);
#endif
    } else {   nv_prepA(P, layer + 1, gt, gn); }
#undef P
}
__device__ __forceinline__ void grid_bar(volatile LAS unsigned* MISC, int wave_s) {
    CParams* Pb = params_ptr(); XcdBarrier bar; bar.bar = (unsigned*)(Pb->ws + WS_CTL) + 4096; bar.x = xb_xcc_id(); bar.st = MISC + 8; xcd_barrier(bar, wave_s == 0 && lane_id() == 0);
}
#define PH(kind, layer) do { run_phase<kind, layer>(L, wave_s); grid_bar(MISC, wave_s); } while (0)
template <int LAYER> __device__ __forceinline__ void even_layer(LAS unsigned char* L, volatile LAS unsigned* MISC, int wave_s) {
    PH(K_E_IN, LAYER);
    if constexpr (!FAST_IN_EVEN) PH(K_E_POST, LAYER);
    PH(K_E_UQ, LAYER);
    if constexpr (!FAST_UQ) PH(K_E_UQSS, LAYER);
    PH(K_E_UKV, LAYER);
    if constexpr (!FAST_UKV) PH(K_E_KPOST, LAYER);
    PH(K_E_SCAN, LAYER);
    PH(K_E_ATTN, LAYER);
    PH(K_E_OUT, LAYER);
    if constexpr (!FAST_OUT) PH(K_E_PREPA, LAYER);
}
template <int LAYER> __device__ __forceinline__ void odd_layer(LAS unsigned char* L, volatile LAS unsigned* MISC, int wave_s) {
    PH(K_O_IN, LAYER);
    if constexpr (!FAST_IN_ODD) PH(K_O_POST, LAYER);
    PH(K_O_ATTN, LAYER);
    if constexpr (LAYER == 3) { run_phase<K_O_OUT, LAYER>(L, wave_s); }
    else { PH(K_O_OUT, LAYER); if constexpr (!FAST_OUT) PH(K_O_PREPA, LAYER); }
}
__global__ void __launch_bounds__(NTHREADS, 2) mk_fwd(Params P_) {
    extern __shared__ __attribute__((aligned(16))) unsigned char lds[];
    LAS unsigned char* L = (LAS unsigned char*)lds;
    volatile LAS unsigned* MISC = (volatile LAS unsigned*)(L + MISC_OFF);
    const int wave_s = __builtin_amdgcn_readfirstlane(threadIdx.x >> 6);
    if (wave_s == 0 && lane_id() < 32) MISC[lane_id()] = 0u;
    __syncthreads();
    { CParams* P0 = params_ptr(); (void)xcd_barrier_post((unsigned*)(P0->ws + WS_CTL) + 4096, MISC + 8, wave_s == 0 && lane_id() == 0); }
    PH(K_P0, 0); PH(K_P1, 0);
    even_layer<0>(L, MISC, wave_s); odd_layer<1>(L, MISC, wave_s); even_layer<2>(L, MISC, wave_s); odd_layer<3>(L, MISC, wave_s);
}
extern "C" void kernel_launch(void* const* d_in, const int* in_sizes, int n_in, void* d_out, int out_size, void* d_ws, size_t ws_size, hipStream_t stream) {
    if (n_in != N_INPUTS || ws_size < WS_END || (size_t)out_size != O_END) { fprintf(stderr, "kernel_launch: unexpected shapes (n_in %d, out %d, ws %zu)\n", n_in, out_size, ws_size); return; }
    static int grid = 0;
    if (grid == 0) {
        int dev = 0, cus = 0;
        if (hipGetDevice(&dev) != hipSuccess || hipDeviceGetAttribute(&cus, hipDeviceAttributeMultiprocessorCount, dev) != hipSuccess) { grid = -1; return; }
        if (hipFuncSetAttribute((const void*)mk_fwd, hipFuncAttributeMaxDynamicSharedMemorySize, LDS_BYTES) != hipSuccess) { grid = -1; return; }
        grid = cus;
    }
    if (grid < 0) return;
    (void)hipMemsetAsync((char*)d_ws + WS_CTL, 0, 1 * MiB, stream);
    Params P{};
    for (int i = 0; i < N_INPUTS; ++i) P.in[i] = (const float*)d_in[i];
    P.out = (float*)d_out; P.ws = (unsigned char*)d_ws; P.ph_lo = 0; P.ph_hi = 0;
    hipLaunchKernelGGL(mk_fwd, dim3(grid), dim3(NTHREADS), LDS_BYTES, stream, P);
}
```

```cpp
#include <hip/hip_runtime.h>
#include <cstdio>
#include <cstdint>

constexpr int DM = 1024;
constexpr int NP_ROWS = 32 * 256;
constexpr int NS_ROWS = 4 * 4096;
constexpr int MROWS = NP_ROWS + NS_ROWS;
constexpr int CTX_ROWS = 4 * 512;
constexpr int MROWS_X = MROWS + CTX_ROWS;
constexpr float EPS = 1e-6f;
constexpr float LOG2E = 1.4426950408889634f;
constexpr int AB_IN = 2720, WIN_IN = 2560;

enum { I_XP = 0, I_XS, I_C0CKV, I_C0KR, I_S0F, I_S0B, I_C1K, I_C1V, I_C2CKV, I_C2KR, I_S2F, I_S2B, I_C3K, I_C3V, I_C, I_CCTX, I_ADAW, I_ADAB, I_NORMG,
       I_ABWIN, I_QNG, I_WUQ, I_KVNG, I_WUKV, I_QHG, I_KHG, I_DECAY, I_RNG, I_ABWOUT, I_WWIN, I_WQHG, I_WKHG, I_SINK, I_WWOUT, N_INPUTS };

constexpr size_t O_Y = 0;
constexpr size_t O_L0CKV = (size_t)MROWS * DM;
constexpr size_t O_L0KR = O_L0CKV + (size_t)NP_ROWS * 256;
constexpr size_t O_L0RF = O_L0KR + (size_t)NP_ROWS * 32;
constexpr size_t O_L0RB = O_L0RF + (size_t)32 * 4 * 64 * 128;
constexpr size_t O_L1K = O_L0RB + (size_t)32 * 4 * 64 * 128;
constexpr size_t O_L1V = O_L1K + (size_t)NP_ROWS * 256;
constexpr size_t O_L2CKV = O_L1V + (size_t)NP_ROWS * 256;
constexpr size_t O_L2KR = O_L2CKV + (size_t)NP_ROWS * 256;
constexpr size_t O_L2RF = O_L2KR + (size_t)NP_ROWS * 32;
constexpr size_t O_L2RB = O_L2RF + (size_t)32 * 4 * 64 * 128;
constexpr size_t O_L3K = O_L2RB + (size_t)32 * 4 * 64 * 128;
constexpr size_t O_L3V = O_L3K + (size_t)NP_ROWS * 256;
constexpr size_t O_END = O_L3V + (size_t)NP_ROWS * 256;

constexpr size_t MiB = 1u << 20;
constexpr size_t WS_CTL = 0;
constexpr size_t WS_MOD = 1 * MiB;
constexpr size_t WS_GS = WS_MOD + 4 * 5 * 3072 * 4;
constexpr size_t WS_BIAS = WS_GS + 4 * 5 * 1024 * 4;
constexpr size_t WS_BIASL = WS_BIAS + 4 * 5 * 2816 * 4;
constexpr size_t WS_SS = WS_BIASL + 4 * 5 * 2816 * 4;
constexpr size_t WS_SSCQ = WS_SS + (size_t)MROWS * 16 * 4;
constexpr size_t WS_SSKR = WS_SSCQ + (size_t)MROWS * 8 * 4;
constexpr size_t WS_SSQN = WS_SSKR + (size_t)MROWS_X * 4;
constexpr size_t WS_SSQR = WS_SSQN + (size_t)MROWS * 8 * 4;
constexpr size_t WS_ROPE8 = WS_SSQR + (size_t)MROWS * 8 * 4;
constexpr size_t WS_ROPE16 = WS_ROPE8 + 64 * 8 * 2 * 4;
constexpr size_t WS_BND = WS_ROPE16 + 64 * 16 * 2 * 4;
constexpr size_t WS_MISC_END = WS_BND + 256;
static_assert(WS_MISC_END <= 6 * MiB, "misc region");
constexpr size_t WS_WIN = 6 * MiB;
constexpr size_t WS_WUQ = WS_WIN + (size_t)2816 * 1024 * 2;
constexpr size_t WS_WUKV = WS_WUQ + (size_t)768 * 384 * 2;
constexpr size_t WS_WOUT0 = WS_WUKV + (size_t)1024 * 256 * 2;
constexpr size_t WS_WOUT1 = WS_WOUT0 + (size_t)1024 * 1024 * 2;
constexpr size_t WS_W_END = WS_WOUT1 + (size_t)1024 * 1024 * 2;
static_assert(WS_W_END <= 17 * MiB, "weight region");
constexpr size_t WS_G = 17 * MiB;
constexpr size_t WS_X = WS_G + 48 * MiB;
constexpr size_t WS_RQ = WS_X, WS_RK = WS_X + 12 * MiB, WS_RV = WS_X + 24 * MiB, WS_QW = WS_X;
constexpr size_t WS_Q = WS_X + 48 * MiB;
constexpr size_t WS_QR = WS_Q, WS_CQ = WS_Q + 36 * MiB, WS_AODD = WS_Q;
constexpr size_t WS_URS = WS_CQ;
constexpr size_t WS_CKVN = WS_Q + 54 * MiB;
constexpr size_t WS_KR = WS_CKVN + 13 * MiB;
constexpr size_t WS_KV = WS_KR + (size_t)MROWS_X * 32 * 2;
constexpr size_t WS_KIMG = WS_KV, WS_VIMG = WS_KV + 39 * MiB, WS_AEVEN = WS_KV;
constexpr size_t WS_KWIMG = WS_KV + 39 * MiB, WS_VWIMG = WS_KV + 52 * MiB;
constexpr size_t WS_URP = WS_KV + 65 * MiB;
constexpr size_t WS_END = WS_URP + 8 * MiB;
static_assert(WS_END <= 256 * MiB, "workspace map exceeds 256 MiB");

typedef unsigned short bf16_t;

struct Params {
    const float* in[N_INPUTS];
    float* out;
    unsigned char* ws;
    int ph_lo, ph_hi;
};

typedef const __attribute__((address_space(4))) Params CParams;
__device__ __forceinline__ CParams* params_ptr() { CParams* p = (CParams*)__builtin_amdgcn_kernarg_segment_ptr(); asm volatile("" : "+s"(p)); return p; }

__device__ __forceinline__ float bf2f(bf16_t b) { return __uint_as_float((unsigned)b << 16); }
__device__ __forceinline__ bf16_t f2bf(float f) { unsigned u = __float_as_uint(f); return (bf16_t)((u + 0x7fffu + ((u >> 16) & 1u)) >> 16); }
__device__ __forceinline__ float bfr(float f) { return bf2f(f2bf(f)); }
__device__ __forceinline__ float silu_f(float x) { return x / (1.f + __expf(-x)); }

__device__ __forceinline__ int p2d64(int p) { return 32 * ((p >> 3) & 1) + 16 * ((p >> 2) & 1) + 4 * (p >> 4) + (p & 3); }
__device__ __forceinline__ int d2p64(int d) { return 16 * ((d >> 2) & 3) + 8 * (d >> 5) + 4 * ((d >> 4) & 1) + (d & 3); }
__device__ __forceinline__ int o2j32(int o) { const int grp = o >> 3, w = o & 7; return 16 * (grp >> 1) + 4 * (grp & 1) + (w & 3) + 8 * (w >> 2); }
__device__ __forceinline__ int j2o32(int j) { return 8 * (2 * (j >> 4) + ((j >> 2) & 1)) + 4 * ((j >> 3) & 1) + (j & 3); }

struct RowInfo { int cond; int b; int t; bool sample; };
__device__ __forceinline__ RowInfo row_info(int row) {
    RowInfo r;
    if (row < NP_ROWS) { r.cond = 4; r.b = row >> 8; r.t = row & 255; r.sample = false; }
    else { const int rs = row - NP_ROWS; r.b = rs >> 12; r.t = rs & 4095; r.cond = r.b; r.sample = true; }
    return r;
}
__device__ __forceinline__ int kv_tile(int R, int head, int H, int& kin) {
    if (R < NP_ROWS) { const int b = R >> 8, key = R & 255; kin = key & 63; return (b * H + head) * 4 + (key >> 6); }
    int b, key;
    if (R < MROWS) { const int rs = R - NP_ROWS; b = rs >> 12; key = 512 + (rs & 4095); }
    else { const int rc = R - MROWS; b = rc >> 9; key = rc & 511; }
    kin = key & 63; return 32 * H * 4 + (b * H + head) * 72 + (key >> 6);
}
__device__ __forceinline__ int kv_seq_tile0(bool sample, int b, int head, int H) { return sample ? 32 * H * 4 + (b * H + head) * 72 : (b * H + head) * 4; }

template <int K> __device__ __forceinline__ float xor_shfl(float v) { static_assert(K < 32, "xor_shfl"); return __int_as_float(__builtin_amdgcn_ds_swizzle(__float_as_int(v), (K << 10) | 0x1f)); }
__device__ __forceinline__ float sum_halves(float v) { auto r = __builtin_amdgcn_permlane32_swap(__float_as_uint(v), __float_as_uint(v), false, false); return __uint_as_float(r[0]) + __uint_as_float(r[1]); }
__device__ __forceinline__ float wave_sum(float v) { v += xor_shfl<1>(v); v += xor_shfl<2>(v); v += xor_shfl<4>(v); v += xor_shfl<8>(v); v += xor_shfl<16>(v); return sum_halves(v); }

__device__ __forceinline__ int lane_id() { int l; asm volatile("v_mbcnt_lo_u32_b32 %0, -1, 0\n\tv_mbcnt_hi_u32_b32 %0, -1, %0" : "=v"(l)); return l; }

#define NVF(name) __device__ void name(CParams& P, int layer, long gt, long gn)

__device__ __forceinline__ const float* cond_vec(CParams& P, int c) { return c < 4 ? P.in[I_C] + c * 1024 : P.in[I_CCTX]; }
__device__ __forceinline__ float* ws_f32(CParams& P, size_t off) { return (float*)(P.ws + off); }
__device__ __forceinline__ bf16_t* ws_bf(CParams& P, size_t off) { return (bf16_t*)(P.ws + off); }
__device__ __forceinline__ const float* y_row(CParams& P, int layer, int row) {
    if (layer == 0) return row < NP_ROWS ? P.in[I_XP] + (size_t)row * DM : P.in[I_XS] + (size_t)(row - NP_ROWS) * DM;
    return P.out + (size_t)row * DM;
}
__device__ __forceinline__ float log_gamma(CParams& P, int layer, int dir, int head) { return -__expf(P.in[I_DECAY][(layer >> 1) * 8 + dir * 4 + head]); }

NVF(nv_mod) {
    float* mod = ws_f32(P, WS_MOD);
    for (long i = gt; i < 4L * 5 * 3072; i += gn) {
        const int j = (int)(i % 3072), c = (int)((i / 3072) % 5), l = (int)(i / (3072 * 5));
        const float* cv = cond_vec(P, c); const float* w = P.in[I_ADAW] + (size_t)l * 1024 * 3072 + j;
        float s = 0.f;
        for (int k = 0; k < 1024; ++k) s += silu_f(cv[k]) * w[(size_t)k * 3072];
        mod[i] = s + P.in[I_ADAB][l * 3072 + j];
    }
    float* r8 = ws_f32(P, WS_ROPE8); float* r16 = ws_f32(P, WS_ROPE16);
    for (long i = gt; i < 64 * 8; i += gn) { const int pos = (int)(i >> 3), f = (int)(i & 7); const float inv = powf(10000.f, -(float)f / 8.f), a = (float)pos * inv; r8[2 * i] = cosf(a); r8[2 * i + 1] = sinf(a); }
    for (long i = gt; i < 64 * 16; i += gn) { const int pos = (int)(i >> 4), f = (int)(i & 15); const float inv = powf(10000.f, -(float)f / 16.f), a = (float)pos * inv; r16[2 * i] = cosf(a); r16[2 * i + 1] = sinf(a); }
}
NVF(nv_gs) {
    float* gs = ws_f32(P, WS_GS); const float* mod = ws_f32(P, WS_MOD);
    for (long i = gt; i < 4L * 5 * 1024; i += gn) { const int k = (int)(i & 1023), c = (int)((i >> 10) % 5), l = (int)(i / 5120); gs[i] = P.in[I_NORMG][l * 1024 + k] * (1.f + mod[(l * 5 + c) * 3072 + 1024 + k]); }
    if (gt == 0) {
        float* bnd = ws_f32(P, WS_BND);
        for (int i = 0; i < 2; ++i) {
            float mq = 0.f, mk = 0.f; for (int d = 0; d < 96; ++d) { mq = fmaxf(mq, fabsf(P.in[I_QHG][i * 96 + d])); mk = fmaxf(mk, fabsf(P.in[I_KHG][i * 96 + d])); }
            bnd[i] = sqrtf(96.f) * LOG2E * mq * mk;
        }
        for (int i = 0; i < 2; ++i) {
            float mq = 0.f, mk = 0.f; for (int d = 0; d < 64; ++d) { mq = fmaxf(mq, fabsf(P.in[I_WQHG][i * 64 + d])); mk = fmaxf(mk, fabsf(P.in[I_WKHG][i * 64 + d])); }
            bnd[8 + i] = mq; bnd[10 + i] = mk;
        }
    }
}
NVF(nv_bias) {
    float* bias = ws_f32(P, WS_BIAS); const float* mod = ws_f32(P, WS_MOD);
    for (long i = gt; i < 4L * 5 * 2816; i += gn) {
        const int col = (int)(i % 2816), c = (int)((i / 2816) % 5), l = (int)(i / (2816 * 5));
        const int N = (l & 1) ? WIN_IN : AB_IN; float s = 0.f;
        if (col < N) { const float* w = ((l & 1) ? P.in[I_WWIN] : P.in[I_ABWIN]) + (size_t)(l >> 1) * 1024 * N + col; const float* sh = mod + (l * 5 + c) * 3072;
            for (int k = 0; k < 1024; ++k) s += sh[k] * w[(size_t)k * N]; }
        bias[i] = s;
    }
}
NVF(nv_prepA) {
    bf16_t* A = ws_bf(P, (layer & 1) ? WS_AODD : WS_AEVEN); float* SS = ws_f32(P, WS_SS);
    const float* mod = ws_f32(P, WS_MOD);
    for (long row = gt; row < MROWS; row += gn) {
        const RowInfo ri = row_info((int)row); const float* y = y_row(P, layer, (int)row);
        const float* sc = mod + (layer * 5 + ri.cond) * 3072 + 1024; const float* g = P.in[I_NORMG] + layer * 1024;
        float s = 0.f;
        for (int k = 0; k < 1024; ++k) { const float v = y[k]; s += v * v; A[(size_t)row * 1024 + k] = f2bf(v * g[k] * (1.f + sc[k])); }
        SS[row * 16] = s; for (int j = 1; j < 16; ++j) SS[row * 16 + j] = 0.f;
    }
}
__device__ __forceinline__ float row_rstd(const float* SS, int row) { float s = 0.f; for (int j = 0; j < 16; ++j) s += SS[row * 16 + j]; return 1.0f / sqrtf(s * (1.f / 1024.f) + EPS); }

NVF(nv_in_even) {
    const bf16_t* A = ws_bf(P, WS_AEVEN); const float* SS = ws_f32(P, WS_SS); const float* W = P.in[I_ABWIN] + (size_t)(layer >> 1) * 1024 * AB_IN;
    const float* bias = ws_f32(P, WS_BIAS);
    bf16_t *CQ = ws_bf(P, WS_CQ), *CKVN = ws_bf(P, WS_CKVN), *KR = ws_bf(P, WS_KR), *G = ws_bf(P, WS_G), *RQ = ws_bf(P, WS_RQ), *RK = ws_bf(P, WS_RK), *RV = ws_bf(P, WS_RV);
    float* okr = P.out + (layer == 0 ? O_L0KR : O_L2KR);
    for (long i = gt; i < (long)(MROWS / 4) * AB_IN; i += gn) {
        const int col = (int)(i % AB_IN), r0 = (int)(i / AB_IN) * 4;
        float acc[4] = {0.f, 0.f, 0.f, 0.f};
        for (int k = 0; k < 1024; ++k) { const float w = bfr(W[(size_t)k * AB_IN + col]);
#pragma unroll
            for (int r = 0; r < 4; ++r) acc[r] += bf2f(A[(size_t)(r0 + r) * 1024 + k]) * w; }
#pragma unroll
        for (int r = 0; r < 4; ++r) {
            const int row = r0 + r; const RowInfo ri = row_info(row);
            const float v = acc[r] * row_rstd(SS, row) + bias[(layer * 5 + ri.cond) * 2816 + col];
            if (col < 384) CQ[(size_t)row * 384 + col] = f2bf(v);
            else if (col < 640) CKVN[(size_t)row * 256 + col - 384] = f2bf(v);
            else if (col < 672) { const int j = col - 640; KR[(size_t)row * 32 + j2o32(j)] = f2bf(v); if (!ri.sample) okr[(size_t)row * 32 + j] = v; }
            else if (col < 1184) G[(size_t)row * 1024 + col - 672] = f2bf(silu_f(v));
            else if (col < 1440) { const int x = col - 1184; RQ[(size_t)row * 256 + (x >> 6) * 64 + d2p64(x & 63)] = f2bf(v); }
            else if (col < 1696) { const int x = col - 1440; RK[(size_t)row * 256 + (x >> 6) * 64 + d2p64(x & 63)] = f2bf(v); }
            else if (col < 2208) RV[(size_t)row * 512 + col - 1696] = f2bf(v);
            else G[(size_t)row * 1024 + 512 + col - 2208] = f2bf(silu_f(v));
        }
    }
}
NVF(nv_post_even) {
    bf16_t *CQ = ws_bf(P, WS_CQ), *CKVN = ws_bf(P, WS_CKVN), *KR = ws_bf(P, WS_KR), *RQ = ws_bf(P, WS_RQ), *RK = ws_bf(P, WS_RK);
    float *sscq = ws_f32(P, WS_SSCQ), *sskr = ws_f32(P, WS_SSKR); const float* r16 = ws_f32(P, WS_ROPE16);
    const float* gkv = P.in[I_KVNG] + (layer >> 1) * 256; float* ockv = P.out + (layer == 0 ? O_L0CKV : O_L2CKV);
    for (long row = gt; row < MROWS; row += gn) {
        const RowInfo ri = row_info((int)row);
        float s = 0.f; for (int k = 0; k < 384; ++k) { const float v = bf2f(CQ[row * 384 + k]); s += v * v; }
        sscq[row * 8] = s; for (int j = 1; j < 8; ++j) sscq[row * 8 + j] = 0.f;
        s = 0.f; for (int k = 0; k < 32; ++k) { const float v = bf2f(KR[row * 32 + k]); s += v * v; }
        sskr[row] = s;
        s = 0.f; for (int k = 0; k < 256; ++k) { const float v = bf2f(CKVN[row * 256 + k]); s += v * v; }
        const float rs = 1.0f / sqrtf(s * (1.f / 256.f) + EPS);
        for (int k = 0; k < 256; ++k) { const float v = bf2f(CKVN[row * 256 + k]) * rs * gkv[k]; CKVN[row * 256 + k] = f2bf(v); if (!ri.sample) ockv[row * 256 + k] = v; }
        const int pr = ri.t >> 6, pc = ri.t & 63;
        for (int a = 0; a < 2; ++a) { bf16_t* X = a ? RK : RQ; const float scl = a ? 1.f : 0.125f;
            for (int h = 0; h < 4; ++h) for (int half = 0; half < 2; ++half) for (int f = 0; f < 16; ++f) {
                const int d1 = 32 * half + f, d2 = d1 + 16; bf16_t* p1 = X + row * 256 + h * 64 + d2p64(d1); bf16_t* p2 = X + row * 256 + h * 64 + d2p64(d2);
                float x1 = bf2f(*p1) * scl, x2 = bf2f(*p2) * scl;
                if (ri.sample) { const int pos = half ? pc : pr; const float c = r16[(pos * 16 + f) * 2], sn = r16[(pos * 16 + f) * 2 + 1]; const float y1 = x1 * c - x2 * sn, y2 = x1 * sn + x2 * c; x1 = y1; x2 = y2; }
                *p1 = f2bf(x1); *p2 = f2bf(x2); } }
    }
}
NVF(nv_ctx_even) {
    const float* cckv = P.in[layer == 0 ? I_C0CKV : I_C2CKV]; const float* ckr = P.in[layer == 0 ? I_C0KR : I_C2KR];
    bf16_t *CKVN = ws_bf(P, WS_CKVN), *KR = ws_bf(P, WS_KR); float* sskr = ws_f32(P, WS_SSKR);
    for (long i = gt; i < (long)CTX_ROWS * 256; i += gn) CKVN[(size_t)MROWS * 256 + i] = f2bf(cckv[i]);
    for (long rc = gt; rc < CTX_ROWS; rc += gn) { float s = 0.f;
        for (int j = 0; j < 32; ++j) { const bf16_t v = f2bf(ckr[rc * 32 + j]); KR[(size_t)(MROWS + rc) * 32 + j2o32(j)] = v; s += bf2f(v) * bf2f(v); }
        sskr[MROWS + rc] = s; }
}
NVF(nv_uq) {
    const bf16_t* CQ = ws_bf(P, WS_CQ); bf16_t* QR = ws_bf(P, WS_QR); const float* W = P.in[I_WUQ] + (size_t)(layer >> 1) * 384 * 768; const float* gq = P.in[I_QNG] + (layer >> 1) * 384;
    for (long i = gt; i < (long)MROWS * 768; i += gn) {
        const int sp = (int)(i % 96), head = (int)((i / 96) & 7); const long row = i / 768;
        const int dd = sp < 64 ? sp : 64 + o2j32(sp - 64), col = head * 96 + dd; float z = 0.f;
        for (int k = 0; k < 384; ++k) z += bf2f(CQ[row * 384 + k]) * bfr(gq[k] * W[(size_t)k * 768 + col]);
        QR[i] = f2bf(z);
    }
}
NVF(nv_uq_ss) {
    const bf16_t* QR = ws_bf(P, WS_QR); const float* sscq = ws_f32(P, WS_SSCQ); float *ssqn = ws_f32(P, WS_SSQN), *ssqr = ws_f32(P, WS_SSQR);
    for (long i = gt; i < (long)MROWS * 8; i += gn) { const long row = i >> 3; float a = 0.f, b = 0.f;
        for (int s = 0; s < 64; ++s) { const float v = bf2f(QR[i * 96 + s]); a += v * v; }
        for (int s = 64; s < 96; ++s) { const float v = bf2f(QR[i * 96 + s]); b += v * v; }
        float c = 0.f; for (int j = 0; j < 8; ++j) c += sscq[row * 8 + j];
        ssqn[i] = a + 96.f * EPS * (c * (1.f / 384.f) + EPS); ssqr[i] = b; }
}
NVF(nv_ukv) {
    const bf16_t* CKVN = ws_bf(P, WS_CKVN); const float* W = P.in[I_WUKV] + (size_t)(layer >> 1) * 256 * 1024;
    unsigned char* KI = P.ws + WS_KIMG; unsigned char* VI = P.ws + WS_VIMG;
    for (long i = gt; i < (long)MROWS_X * 1024; i += gn) {
        const int feat = (int)(i & 1023), head = feat >> 7, r = feat & 127; const int R = (int)(i >> 10); float v = 0.f;
        for (int k = 0; k < 256; ++k) v += bf2f(CKVN[(size_t)R * 256 + k]) * bfr(W[(size_t)k * 1024 + feat]);
        int kin; const int tile = kv_tile(R, head, 8, kin);
        if (r < 64) *(bf16_t*)(KI + (size_t)tile * 12288 + (r >> 3) * 1024 + kin * 16 + (r & 7) * 2) = f2bf(v);
        else { const int dv = r - 64; *(bf16_t*)(VI + (size_t)tile * 8192 + (dv >> 5) * 4096 + kin * 64 + (dv & 31) * 2) = f2bf(v); }
    }
}
NVF(nv_k_post) {
    const bf16_t* KR = ws_bf(P, WS_KR); const float* sskr = ws_f32(P, WS_SSKR); const float* gk = P.in[I_KHG] + (layer >> 1) * 96; const float* r8 = ws_f32(P, WS_ROPE8);
    unsigned char* KI = P.ws + WS_KIMG;
    for (long i = gt; i < (long)MROWS_X * 8; i += gn) {
        const int R = (int)(i >> 3), head = (int)(i & 7); int kin; const int tile = kv_tile(R, head, 8, kin);
        unsigned char* base = KI + (size_t)tile * 12288 + kin * 16;
        float s = sskr[R];
        for (int d = 0; d < 64; ++d) { const float v = bf2f(*(bf16_t*)(base + (d >> 3) * 1024 + (d & 7) * 2)); s += v * v; }
        const float rs = 1.0f / sqrtf(s * (1.f / 96.f) + EPS);
        for (int d = 0; d < 64; ++d) { bf16_t* p = (bf16_t*)(base + (d >> 3) * 1024 + (d & 7) * 2); *p = f2bf(bf2f(*p) * rs * gk[d]); }
        const bool lat = (R >= NP_ROWS && R < MROWS); const int t = (R - NP_ROWS) & 4095, pr = t >> 6, pc = t & 63;
        for (int half = 0; half < 2; ++half) for (int f = 0; f < 8; ++f) {
            const int j1 = 16 * half + f, j2 = j1 + 8; const int o1 = j2o32(j1), o2 = j2o32(j2);
            float x1 = bf2f(KR[(size_t)R * 32 + o1]) * rs * gk[64 + j1], x2 = bf2f(KR[(size_t)R * 32 + o2]) * rs * gk[64 + j2];
            if (lat) { const int pos = half ? pc : pr; const float c = r8[(pos * 8 + f) * 2], sn = r8[(pos * 8 + f) * 2 + 1]; const float y1 = x1 * c - x2 * sn, y2 = x1 * sn + x2 * c; x1 = y1; x2 = y2; }
            *(bf16_t*)(base + ((64 + o1) >> 3) * 1024 + (o1 & 7) * 2) = f2bf(x1); *(bf16_t*)(base + ((64 + o2) >> 3) * 1024 + (o2 & 7) * 2) = f2bf(x2); }
    }
}
__device__ __forceinline__ int chunk_row0(int c) { return c < 64 ? (c >> 1) * 256 + (c & 1) * 128 : NP_ROWS + ((c - 64) >> 5) * 4096 + ((c - 64) & 31) * 128; }
__device__ __forceinline__ unsigned char* ur_ptr(CParams& P, int c, int head, int dir) { return c < 64 ? P.ws + WS_URP + (size_t)((c * 4 + head) * 2 + dir) * 16384 : P.ws + WS_URS + (size_t)(((c - 64) * 4 + head) * 2 + dir) * 16384; }
__device__ __forceinline__ size_t ur_el(int p, int dv) { return (size_t)(dv >> 5) * 4096 + p * 64 + (dv & 31) * 2; }
NVF(nv_u) {
    const bf16_t *RK = ws_bf(P, WS_RK), *RV = ws_bf(P, WS_RV);
    for (long i = gt; i < 192L * 4 * 2 * 8192; i += gn) {
        const int dv = (int)(i & 127), p = (int)((i >> 7) & 63), dir = (int)((i >> 13) & 1), head = (int)((i >> 14) & 3), c = (int)(i >> 16);
        const float lg = log_gamma(P, layer, dir, head); const int r0 = chunk_row0(c); float s = 0.f;
        for (int t = 0; t < 128; ++t) { const float w = __expf(lg * (float)(dir ? t : 127 - t)); s += bfr(bf2f(RK[(size_t)(r0 + t) * 256 + head * 64 + p]) * w) * bf2f(RV[(size_t)(r0 + t) * 512 + head * 128 + dv]); }
        *(bf16_t*)(ur_ptr(P, c, head, dir) + ur_el(p, dv)) = f2bf(s);
    }
}
NVF(nv_scan) {
    float* orf = P.out + (layer == 0 ? O_L0RF : O_L2RF); float* orb = P.out + (layer == 0 ? O_L0RB : O_L2RB);
    const float* s0f = P.in[layer == 0 ? I_S0F : I_S2F]; const float* s0b = P.in[layer == 0 ? I_S0B : I_S2B];
    for (long i = gt; i < 36L * 4 * 2 * 8192; i += gn) {
        const int dv = (int)(i & 127), p = (int)((i >> 7) & 63), dir = (int)((i >> 13) & 1), head = (int)((i >> 14) & 3), seq = (int)(i >> 16);
        const float gC = __expf(128.f * log_gamma(P, layer, dir, head)); const size_t el = ur_el(p, dv); const int d = p2d64(p);
        if (seq < 32) {
            bf16_t* u0 = (bf16_t*)(ur_ptr(P, 2 * seq, head, dir) + el); bf16_t* u1 = (bf16_t*)(ur_ptr(P, 2 * seq + 1, head, dir) + el);
            const float a = bf2f(*u0), b = bf2f(*u1);
            if (dir == 0) { orf[((size_t)(seq * 4 + head) * 64 + d) * 128 + dv] = gC * a + b; *u0 = 0; *u1 = f2bf(a); }
            else { orb[((size_t)(seq * 4 + head) * 64 + d) * 128 + dv] = gC * b + a; *u1 = 0; *u0 = f2bf(b); }
        } else {
            const int b = seq - 32; float R = (dir ? s0b : s0f)[((size_t)(b * 4 + head) * 64 + d) * 128 + dv];
            for (int n = 0; n < 32; ++n) { const int c = 64 + b * 32 + (dir ? 31 - n : n); bf16_t* u = (bf16_t*)(ur_ptr(P, c, head, dir) + el); const float uv = bf2f(*u); *u = f2bf(R); R = gC * R + uv; }
        }
    }
}
__device__ __forceinline__ float mla_q_at(CParams& P, int layer, int row, int head, int s) {
    const bf16_t* QR = ws_bf(P, WS_QR) + ((size_t)row * 8 + head) * 96; const float* gq = P.in[I_QHG] + (layer >> 1) * 96; const float* r8 = ws_f32(P, WS_ROPE8);
    const float ss = ws_f32(P, WS_SSQN)[row * 8 + head] + ws_f32(P, WS_SSQR)[row * 8 + head]; const float rs = 1.0f / sqrtf(ss * (1.f / 96.f));
    const float qs = 0.10206207261596575f * LOG2E;
    if (s < 64) return bfr(bf2f(QR[s]) * rs * gq[s] * qs);
    const RowInfo ri = row_info(row);
    const int j = o2j32(s - 64), j1 = j & ~8, j2 = j1 + 8, half = j >> 4, f = j & 7;
    const float x1 = bf2f(QR[64 + j2o32(j1)]) * rs * gq[64 + j1], x2 = bf2f(QR[64 + j2o32(j2)]) * rs * gq[64 + j2];
    float c = 1.f, sn = 0.f;
    if (ri.sample) { const int pos = half ? (ri.t & 63) : (ri.t >> 6); c = r8[(pos * 8 + f) * 2]; sn = r8[(pos * 8 + f) * 2 + 1]; }
    const float y = (j & 8) ? (x1 * sn + x2 * c) : (x1 * c - x2 * sn);
    return bfr(y * qs);
}
NVF(nv_mla_attn) {
    const unsigned char* KI = P.ws + WS_KIMG; const unsigned char* VI = P.ws + WS_VIMG; bf16_t* G = ws_bf(P, WS_G); const float bnd = ws_f32(P, WS_BND)[layer >> 1];
    const int lane = (int)(gt & 63);
    for (long it = gt >> 6; it < (long)MROWS * 8; it += gn >> 6) {
        const int row = (int)(it % MROWS), head = (int)(it / MROWS); const RowInfo ri = row_info(row);
        const float q0 = mla_q_at(P, layer, row, head, lane), q1 = lane < 32 ? mla_q_at(P, layer, row, head, 64 + lane) : 0.f;
        float o = 0.f, l = 0.f;
        const int t0 = kv_seq_tile0(ri.sample, ri.b, head, 8), nk = ri.sample ? 4608 : 256;
        for (int key = 0; key < nk; ++key) {
            const unsigned char* kb = KI + (size_t)(t0 + (key >> 6)) * 12288 + (key & 63) * 16; const unsigned char* vb = VI + (size_t)(t0 + (key >> 6)) * 8192 + (key & 63) * 64;
            float s = q0 * bf2f(*(const bf16_t*)(kb + (lane >> 3) * 1024 + (lane & 7) * 2));
            if (lane < 32) s += q1 * bf2f(*(const bf16_t*)(kb + ((64 + lane) >> 3) * 1024 + (lane & 7) * 2));
            s = wave_sum(s);
            const float p = exp2f(s - bnd); l += p;
            o += bfr(p) * bf2f(*(const bf16_t*)(vb + (lane >> 5) * 4096 + (lane & 31) * 2));
        }
        bf16_t* g = G + (size_t)row * 1024 + head * 64 + lane; *g = f2bf(o / l * bf2f(*g));
    }
}
NVF(nv_ret_out) {
    const bf16_t *RQ = ws_bf(P, WS_RQ), *RK = ws_bf(P, WS_RK), *RV = ws_bf(P, WS_RV); bf16_t* G = ws_bf(P, WS_G); const float* gn_ = P.in[I_RNG] + (layer >> 1) * 512;
    const int lane = (int)(gt & 63);
    for (long it = gt >> 6; it < (long)MROWS * 4; it += gn >> 6) {
        const int row = (int)(it % MROWS), head = (int)(it / MROWS);
        const int c = row < NP_ROWS ? row >> 7 : 64 + ((row - NP_ROWS) >> 7); const int ii = row & 127, r0 = chunk_row0(c);
        const float lgf = log_gamma(P, layer, 0, head), lgb = log_gamma(P, layer, 1, head);
        const float ql = bf2f(RQ[(size_t)row * 256 + head * 64 + lane]);
        float o0 = 0.f, o1 = 0.f;
        for (int j = 0; j < 128; ++j) {
            const float s = wave_sum(ql * bf2f(RK[(size_t)(r0 + j) * 256 + head * 64 + lane]));
            const float D = j < ii ? __expf(lgf * (float)(ii - j)) : (j > ii ? __expf(lgb * (float)(j - ii)) : 2.f);
            const float pb = bfr(s * D);
            o0 += pb * bf2f(RV[(size_t)(r0 + j) * 512 + head * 128 + lane]); o1 += pb * bf2f(RV[(size_t)(r0 + j) * 512 + head * 128 + 64 + lane]);
        }
        const float wf = __expf(lgf * (float)(ii + 1)), wb = __expf(lgb * (float)(128 - ii));
        const unsigned char* Rf = ur_ptr(P, c, head, 0); const unsigned char* Rb = ur_ptr(P, c, head, 1);
        for (int p = 0; p < 64; ++p) { const float qp = bf2f(RQ[(size_t)row * 256 + head * 64 + p]); const float qf = bfr(qp * wf), qb = bfr(qp * wb);
            o0 += qf * bf2f(*(const bf16_t*)(Rf + ur_el(p, lane))) + qb * bf2f(*(const bf16_t*)(Rb + ur_el(p, lane)));
            o1 += qf * bf2f(*(const bf16_t*)(Rf + ur_el(p, 64 + lane))) + qb * bf2f(*(const bf16_t*)(Rb + ur_el(p, 64 + lane))); }
        const float mu = wave_sum(o0 + o1) * (1.f / 128.f);
        const float d0 = o0 - mu, d1 = o1 - mu; const float var = wave_sum(d0 * d0 + d1 * d1) * (1.f / 128.f);
        const float rs = 1.0f / sqrtf(var + EPS);
        bf16_t* g = G + (size_t)row * 1024 + 512 + head * 128 + lane;
        g[0] = f2bf(d0 * rs * gn_[head * 128 + lane] * bf2f(g[0])); g[64] = f2bf(d1 * rs * gn_[head * 128 + 64 + lane] * bf2f(g[64]));
    }
}
NVF(nv_out) {
    const bf16_t* G = ws_bf(P, WS_G); const float* W = ((layer & 1) ? P.in[I_WWOUT] : P.in[I_ABWOUT]) + (size_t)(layer >> 1) * 1024 * 1024; const float* mod = ws_f32(P, WS_MOD);
    for (long i = gt; i < (long)(MROWS / 4) * 1024; i += gn) {
        const int col = (int)(i & 1023), r0 = (int)(i >> 10) * 4; float acc[4] = {0.f, 0.f, 0.f, 0.f};
        for (int k = 0; k < 1024; ++k) { const float w = bfr(W[(size_t)k * 1024 + col]);
#pragma unroll
            for (int r = 0; r < 4; ++r) acc[r] += bf2f(G[(size_t)(r0 + r) * 1024 + k]) * w; }
#pragma unroll
        for (int r = 0; r < 4; ++r) { const int row = r0 + r; const RowInfo ri = row_info(row);
            P.out[(size_t)row * 1024 + col] = y_row(P, layer, row)[col] + mod[(layer * 5 + ri.cond) * 3072 + 2048 + col] * acc[r]; }
    }
}
NVF(nv_in_odd) {
    const bf16_t* A = ws_bf(P, WS_AODD); const float* SS = ws_f32(P, WS_SS); const float* W = P.in[I_WWIN] + (size_t)(layer >> 1) * 1024 * WIN_IN; const float* bias = ws_f32(P, WS_BIAS);
    bf16_t *QW = ws_bf(P, WS_QW), *G = ws_bf(P, WS_G); unsigned char* KI = P.ws + WS_KWIMG; unsigned char* VI = P.ws + WS_VWIMG; float* ov = P.out + (layer == 1 ? O_L1V : O_L3V);
    for (long i = gt; i < (long)(MROWS / 4) * WIN_IN; i += gn) {
        const int col = (int)(i % WIN_IN), r0 = (int)(i / WIN_IN) * 4; float acc[4] = {0.f, 0.f, 0.f, 0.f};
        for (int k = 0; k < 1024; ++k) { const float w = bfr(W[(size_t)k * WIN_IN + col]);
#pragma unroll
            for (int r = 0; r < 4; ++r) acc[r] += bf2f(A[(size_t)(r0 + r) * 1024 + k]) * w; }
#pragma unroll
        for (int r = 0; r < 4; ++r) { const int row = r0 + r; const RowInfo ri = row_info(row);
            const float v = acc[r] * row_rstd(SS, row) + bias[(layer * 5 + ri.cond) * 2816 + col];
            if (col < 1024) QW[(size_t)row * 1024 + (col >> 6) * 64 + d2p64(col & 63)] = f2bf(v);
            else if (col < 1280) { const int x = col - 1024, kvh = x >> 6, p = d2p64(x & 63); int kin; const int tile = kv_tile(row, kvh, 4, kin); *(bf16_t*)(KI + (size_t)tile * 8192 + (p >> 3) * 1024 + kin * 16 + (p & 7) * 2) = f2bf(v); }
            else if (col < 1536) { const int x = col - 1280, kvh = x >> 6, dv = x & 63; int kin; const int tile = kv_tile(row, kvh, 4, kin); *(bf16_t*)(VI + (size_t)tile * 8192 + (dv >> 5) * 4096 + kin * 64 + (dv & 31) * 2) = f2bf(v); if (!ri.sample) ov[(size_t)row * 256 + x] = v; }
            else G[(size_t)row * 1024 + col - 1536] = f2bf(silu_f(v)); }
    }
}
NVF(nv_post_odd) {
    bf16_t* QW = ws_bf(P, WS_QW); unsigned char* KI = P.ws + WS_KWIMG; const float* r16 = ws_f32(P, WS_ROPE16); float* ok = P.out + (layer == 1 ? O_L1K : O_L3K);
    const float* gq = P.in[I_WQHG] + (layer >> 1) * 64; const float* gk = P.in[I_WKHG] + (layer >> 1) * 64;
    const int d = (int)(gt & 63), p = d2p64(d);
    for (long it = gt >> 6; it < (long)MROWS * 20; it += gn >> 6) {
        const int row = (int)(it / 20), hh = (int)(it % 20); const RowInfo ri = row_info(row); const bool isq = hh < 16; const int kvh = hh - 16;
        int kin = 0, tile = 0; if (!isq) tile = kv_tile(row, kvh, 4, kin);
        bf16_t* ptr = isq ? QW + (size_t)row * 1024 + hh * 64 + p : (bf16_t*)(KI + (size_t)tile * 8192 + (p >> 3) * 1024 + kin * 16 + (p & 7) * 2);
        float x = bf2f(*ptr);
        const float rs = 1.0f / sqrtf(wave_sum(x * x) * (1.f / 64.f) + EPS);
        x *= rs * (isq ? gq[d] : gk[d]);
        if (!isq && !ri.sample) ok[(size_t)row * 256 + kvh * 64 + d] = x;
        const float xp = xor_shfl<16>(x);
        if (ri.sample) { const int half = d >> 5, f = d & 15; const int pos = half ? (ri.t & 63) : (ri.t >> 6);
            const float c = r16[(pos * 16 + f) * 2], sn = r16[(pos * 16 + f) * 2 + 1];
            x = (d & 16) ? (xp * sn + x * c) : (x * c - xp * sn); }
        *ptr = f2bf(isq ? x * 0.125f * LOG2E : x);
    }
}
NVF(nv_ctx_odd) {
    const float* ck = P.in[layer == 1 ? I_C1K : I_C3K]; const float* cv = P.in[layer == 1 ? I_C1V : I_C3V]; unsigned char* KI = P.ws + WS_KWIMG; unsigned char* VI = P.ws + WS_VWIMG;
    unsigned* bmax = (unsigned*)ws_f32(P, WS_BND) + 4 + (layer >> 1);
    for (long i = gt; i < (long)CTX_ROWS * 4; i += gn) { const int rc = (int)(i >> 2), kvh = (int)(i & 3); int kin; const int tile = kv_tile(MROWS + rc, kvh, 4, kin); float s = 0.f;
        for (int d = 0; d < 64; ++d) { const int p = d2p64(d); const bf16_t kb = f2bf(ck[(size_t)rc * 256 + kvh * 64 + d]); s += bf2f(kb) * bf2f(kb);
            *(bf16_t*)(KI + (size_t)tile * 8192 + (p >> 3) * 1024 + kin * 16 + (p & 7) * 2) = kb;
            *(bf16_t*)(VI + (size_t)tile * 8192 + (d >> 5) * 4096 + kin * 64 + (d & 31) * 2) = f2bf(cv[(size_t)rc * 256 + kvh * 64 + d]); }
        atomicMax(bmax, __float_as_uint(s)); }
}
NVF(nv_win_attn) {
    const bf16_t* QW = ws_bf(P, WS_QW); const unsigned char* KI = P.ws + WS_KWIMG; const unsigned char* VI = P.ws + WS_VWIMG; bf16_t* G = ws_bf(P, WS_G);
    const float* bf = ws_f32(P, WS_BND); const int li = layer >> 1;
    const float knorm = fmaxf(8.f * bf[10 + li], sqrtf(bf[4 + li])); const float bnd = 0.125f * LOG2E * 8.f * bf[8 + li] * knorm;
    const int lane = (int)(gt & 63);
    for (long it = gt >> 6; it < (long)MROWS * 16; it += gn >> 6) {
        const int row = (int)(it % MROWS), head = (int)(it / MROWS), kvh = head >> 2; const RowInfo ri = row_info(row);
        const float ql = bf2f(QW[(size_t)row * 1024 + head * 64 + lane]);
        float o = 0.f, l = exp2f(P.in[I_SINK][li * 16 + head] * LOG2E - bnd);
        const int t0 = kv_seq_tile0(ri.sample, ri.b, kvh, 4);
        int klo = 0, khi = 256, k2lo = 0, k2hi = 0;
        if (ri.sample) { klo = 0; khi = 512; k2lo = 512 + max(0, ri.t - 128); k2hi = 512 + min(4095, ri.t + 128) + 1; }
        for (int seg = 0; seg < 2; ++seg) { const int a = seg ? k2lo : klo, b = seg ? k2hi : khi;
            for (int key = a; key < b; ++key) {
                const unsigned char* kb = KI + (size_t)(t0 + (key >> 6)) * 8192 + (key & 63) * 16; const unsigned char* vb = VI + (size_t)(t0 + (key >> 6)) * 8192 + (key & 63) * 64;
                const float s = wave_sum(ql * bf2f(*(const bf16_t*)(kb + (lane >> 3) * 1024 + (lane & 7) * 2)));
                const float pp = exp2f(s - bnd); l += pp;
                o += bfr(pp) * bf2f(*(const bf16_t*)(vb + (lane >> 5) * 4096 + (lane & 31) * 2)); } }
        bf16_t* g = G + (size_t)row * 1024 + head * 64 + lane; *g = f2bf(o / l * bf2f(*g));
    }
}
NVF(nv_zero_bnd) { if (gt < 64) ws_f32(P, WS_BND)[gt] = 0.f; }

namespace pg8 {
#define PG8_LAS __attribute__((address_space(3)))
typedef short bf16x8 __attribute__((ext_vector_type(8)));
typedef float f32x4 __attribute__((ext_vector_type(4)));
typedef unsigned u32x4 __attribute__((ext_vector_type(4)));
constexpr int BM = 256, BK = 64, HALF = 128, HTB = HALF * BK * 2  , STAGE_BYTES = 8 * HTB, NXCD = 8, WGM = 8;

__host__ __device__ __forceinline__ int lds_byte(int r, int c) { const int st = (r >> 4) * 2 + (c >> 5), rr = r & 15, cc = c & 31, ob = rr * 64 + cc * 2; return st * 1024 + (ob ^ (((ob >> 9) & 1) << 5)); }
__host__ __device__ __forceinline__ void stage_rc(int b, int& R, int& C) { const int st = b / 1024, sb = b % 1024, swz = sb ^ (((sb >> 9) & 1) << 5); R = (st >> 1) * 16 + swz / 64; C = (st & 1) * 32 + (swz % 64) / 2; }
__host__ __device__ __forceinline__ int perm32(int rho) { const int n = rho >> 4, i = rho & 15; return 8 * (i >> 2) + 4 * n + (i & 3); }

struct Unit { int pm, pn; };
struct Gemm { const bf16_t* A; const bf16_t* Bt; int M, N, K, lda; };

struct StaticOrder {
    int nM, nN, nwg, G, c;
    __host__ __device__ void init(int M, int N, int G_, int c_) { nM = M / BM; nN = N / BM; nwg = nM * nN; G = G_; c = c_; }
    __host__ __device__ bool next(int i, Unit& u) const {
        const long L = (long)i * G + c; if (L >= nwg) return false;
        int wgid = (int)L; { const int q = nwg / NXCD, r = nwg % NXCD, xcd = wgid % NXCD, off = wgid / NXCD; wgid = (xcd < r ? xcd * (q + 1) : r * (q + 1) + (xcd - r) * q) + off; }
        const int nig = WGM * nN, gid = wgid / nig, fm = gid * WGM, gsz = (nM - fm) < WGM ? (nM - fm) : WGM;
        u.pm = fm + ((wgid % nig) % gsz); u.pn = (wgid % nig) / gsz; return true;
    }
    __device__ __forceinline__ void a_ready(const Unit&) const {}
    __device__ __forceinline__ void done(const Unit&) const {}
};

template <class Epi, class Sched, bool ALIGN_EPI = false, bool SP2 = false>
__device__ __forceinline__ void gemm_phase(PG8_LAS unsigned char* lds, const Gemm g, const Sched& S, const Epi& E, int wave_s) {
    int ws_ = wave_s; asm volatile("" : "+s"(ws_)); int ln_ = lane_id(); asm volatile("" : "+v"(ln_)); const int wid = ws_, lane = ln_, tid = wid * 64 + lane, wr = wid >> 2, wc = wid & 3, fr = lane & 15, fq = lane >> 4;
    const int K = g.K, nt = K / BK;
    unsigned voffA[2], voffB[2];
#pragma unroll
    for (int i = 0; i < 2; ++i) { int R, C; stage_rc(tid * 16 + i * 8192, R, C); const int Rb = Epi::PERM ? ((R & ~31) + perm32(R & 31)) : R;
        voffA[i] = (unsigned)(R * g.lda + C) * 2u; voffB[i] = (unsigned)(Rb * K + C) * 2u; }
    const size_t kstep = (size_t)(BK * 2);
    const size_t hstepA = (size_t)HALF * g.lda * 2, hstepB = (size_t)HALF * K * 2;
    const size_t tstepA = 2 * hstepA, tstepB = 2 * hstepB;
    const unsigned ldsw = (unsigned)wid * 1024u;
    const int aoff = lds_byte(wr * 64 + fr, fq * 8), boff = lds_byte(wc * 32 + fr, fq * 8);
#define PG8_SA(b, h) (((b) * 2 + (h)) * HTB)
#define PG8_SB(b, h) ((4 + (b) * 2 + (h)) * HTB)
#define PG8_STAGE(bufoff, gbase, voff) do { _Pragma("unroll") for (int _i = 0; _i < 2; ++_i) \
        __builtin_amdgcn_global_load_lds((const unsigned*)((const char*)(gbase) + (voff)[_i]), (PG8_LAS unsigned*)(lds + (bufoff) + ldsw + _i * 8192), 16, 0, 0); } while (0)
#define PG8_LDA(dst, b, h) do { _Pragma("unroll") for (int m = 0; m < 4; ++m) _Pragma("unroll") for (int k = 0; k < 2; ++k) dst[m][k] = *(const PG8_LAS bf16x8*)(lds + PG8_SA(b, h) + aoff + m * 2048 + k * 1024); } while (0)
#define PG8_LDB(dst, b, h) do { _Pragma("unroll") for (int n = 0; n < 2; ++n) _Pragma("unroll") for (int k = 0; k < 2; ++k) dst[n][k] = *(const PG8_LAS bf16x8*)(lds + PG8_SB(b, h) + boff + n * 2048 + k * 1024); } while (0)
#define PG8_MMA(ai, bj, At, Bt) do { __builtin_amdgcn_s_setprio(1); _Pragma("unroll") for (int m = 0; m < 4; ++m) _Pragma("unroll") for (int n = 0; n < 2; ++n) _Pragma("unroll") for (int k = 0; k < 2; ++k) \
        acc[ai][bj][m][n] = __builtin_amdgcn_mfma_f32_16x16x32_bf16(Bt[n][k], At[m][k], acc[ai][bj][m][n], 0, 0, 0); __builtin_amdgcn_s_setprio(0); } while (0)
#define PG8_WAIT_V(n) asm volatile("s_waitcnt vmcnt(" #n ")" ::: "memory")
#define PG8_WAIT_L(n) asm volatile("s_waitcnt lgkmcnt(" #n ")" ::: "memory")
#define PG8_BAR __builtin_amdgcn_s_barrier()
#define PG8_SCHED __builtin_amdgcn_sched_barrier(0)
    Unit cur, nxt; int ui = 0;
    if (!S.next(0, cur)) return;
    f32x4 acc[2][2][4][2];
#pragma unroll
    for (int a = 0; a < 2; ++a)
#pragma unroll
        for (int b = 0; b < 2; ++b)
#pragma unroll
            for (int m = 0; m < 4; ++m)
#pragma unroll
                for (int n = 0; n < 2; ++n) acc[a][b][m][n] = (f32x4){0.f, 0.f, 0.f, 0.f};
    bf16x8 At[4][2], B0[2][2], B1[2][2];
    const char* cA = (const char*)g.A + (size_t)cur.pm * tstepA; const char* cB = (const char*)g.Bt + (size_t)cur.pn * tstepB;
    S.a_ready(cur);
    if constexpr (SP2) {
        PG8_STAGE(PG8_SB(0, 0), cB, voffB); PG8_STAGE(PG8_SB(0, 1), cB + hstepB, voffB); PG8_STAGE(PG8_SA(0, 0), cA, voffA); PG8_STAGE(PG8_SA(0, 1), cA + hstepA, voffA);
        if (wr == 1) PG8_BAR;
        PG8_WAIT_V(2); PG8_BAR;
        PG8_STAGE(PG8_SB(1, 0), cB + kstep, voffB); PG8_STAGE(PG8_SA(1, 0), cA + kstep, voffA); PG8_STAGE(PG8_SB(1, 1), cB + hstepB + kstep, voffB);
        PG8_WAIT_V(6); PG8_BAR;
    } else {
        PG8_STAGE(PG8_SB(0, 0), cB, voffB); PG8_STAGE(PG8_SA(0, 0), cA, voffA); PG8_STAGE(PG8_SB(0, 1), cB + hstepB, voffB); PG8_STAGE(PG8_SA(0, 1), cA + hstepA, voffA);
        if (wr == 1) PG8_BAR;
        PG8_WAIT_V(4); PG8_BAR;
        PG8_STAGE(PG8_SB(1, 0), cB + kstep, voffB); PG8_STAGE(PG8_SA(1, 0), cA + kstep, voffA); PG8_STAGE(PG8_SB(1, 1), cB + hstepB + kstep, voffB);
        PG8_WAIT_V(6); PG8_BAR;
    }
    for (;;) {
        const bool has_next = S.next(ui + 1, nxt);
        const char* nA = has_next ? (const char*)g.A + (size_t)nxt.pm * tstepA : cA; const char* nB = has_next ? (const char*)g.Bt + (size_t)nxt.pn * tstepB : cB;
        for (int t = 0; t < nt; t += 2) {
            const bool last = (t == nt - 2);
            const char* a1 = cA + (size_t)(t + 1) * kstep;
            const char* a2 = last ? nA : cA + (size_t)(t + 2) * kstep; const char* b2 = last ? nB : cB + (size_t)(t + 2) * kstep;
            const char* a3 = a2 + kstep; const char* b3 = b2 + kstep;
            if (last && has_next) S.a_ready(nxt);
            if constexpr (SP2) {
            PG8_LDB(B0, 0, 0); PG8_LDB(B1, 0, 1); PG8_SCHED; PG8_LDA(At, 0, 0); PG8_STAGE(PG8_SA(1, 1), a1 + hstepA, voffA);
            PG8_WAIT_V(8); PG8_WAIT_L(0); PG8_BAR; PG8_MMA(0, 0, At, B0); PG8_MMA(0, 1, At, B1); PG8_BAR; PG8_SCHED;
            PG8_LDA(At, 0, 1); PG8_STAGE(PG8_SB(0, 0), b2, voffB); PG8_STAGE(PG8_SB(0, 1), b2 + hstepB, voffB); PG8_STAGE(PG8_SA(0, 0), a2, voffA);
            PG8_WAIT_V(8); PG8_WAIT_L(0); PG8_BAR; PG8_MMA(1, 0, At, B0); PG8_MMA(1, 1, At, B1); PG8_BAR; PG8_SCHED;
            PG8_LDB(B0, 1, 0); PG8_LDB(B1, 1, 1); PG8_SCHED; PG8_LDA(At, 1, 0); PG8_STAGE(PG8_SA(0, 1), a2 + hstepA, voffA);
            PG8_WAIT_V(8); PG8_WAIT_L(0); PG8_BAR; PG8_MMA(0, 0, At, B0); PG8_MMA(0, 1, At, B1); PG8_BAR; PG8_SCHED;
            PG8_LDA(At, 1, 1); PG8_STAGE(PG8_SB(1, 0), b3, voffB); PG8_STAGE(PG8_SB(1, 1), b3 + hstepB, voffB); PG8_STAGE(PG8_SA(1, 0), a3, voffA);
            PG8_WAIT_V(8); PG8_WAIT_L(0); PG8_BAR; PG8_MMA(1, 0, At, B0); PG8_MMA(1, 1, At, B1); PG8_BAR; PG8_SCHED;
            } else {
            PG8_LDB(B0, 0, 0); PG8_SCHED; PG8_LDA(At, 0, 0); PG8_STAGE(PG8_SA(1, 1), a1 + hstepA, voffA);
            PG8_WAIT_L(8); PG8_BAR; PG8_WAIT_L(0); PG8_MMA(0, 0, At, B0); PG8_BAR; PG8_SCHED;
            PG8_LDB(B1, 0, 1); PG8_STAGE(PG8_SB(0, 0), b2, voffB);
            PG8_BAR; PG8_WAIT_L(0); PG8_MMA(0, 1, At, B1); PG8_BAR;
            PG8_LDA(At, 0, 1); PG8_STAGE(PG8_SA(0, 0), a2, voffA);
            PG8_BAR; PG8_WAIT_L(0); PG8_MMA(1, 0, At, B0); PG8_BAR; PG8_SCHED;
            PG8_STAGE(PG8_SB(0, 1), b2 + hstepB, voffB);
            PG8_WAIT_V(6); PG8_BAR; PG8_MMA(1, 1, At, B1); PG8_BAR;
            PG8_LDB(B0, 1, 0); PG8_SCHED; PG8_LDA(At, 1, 0); PG8_STAGE(PG8_SA(0, 1), a2 + hstepA, voffA);
            PG8_WAIT_L(8); PG8_BAR; PG8_WAIT_L(0); PG8_MMA(0, 0, At, B0); PG8_BAR; PG8_SCHED;
            PG8_LDB(B1, 1, 1); PG8_STAGE(PG8_SB(1, 0), b3, voffB);
            PG8_BAR; PG8_WAIT_L(0); PG8_MMA(0, 1, At, B1); PG8_BAR;
            PG8_LDA(At, 1, 1); PG8_STAGE(PG8_SA(1, 0), a3, voffA);
            PG8_BAR; PG8_WAIT_L(0); PG8_MMA(1, 0, At, B0); PG8_BAR; PG8_SCHED;
            PG8_STAGE(PG8_SB(1, 1), b3 + hstepB, voffB);
            PG8_WAIT_V(6); PG8_BAR; PG8_MMA(1, 1, At, B1); PG8_BAR;
            }
        }
        if constexpr (ALIGN_EPI) { if (wr == 0) PG8_BAR; }
        if constexpr (!Epi::AFTER_DRAIN) { E(acc, cur, wr, wc, fr, fq); S.done(cur); }
        if (!has_next) break;
#pragma unroll
        for (int a = 0; a < 2; ++a)
#pragma unroll
            for (int b = 0; b < 2; ++b)
#pragma unroll
                for (int m = 0; m < 4; ++m)
#pragma unroll
                    for (int n = 0; n < 2; ++n) acc[a][b][m][n] = (f32x4){0.f, 0.f, 0.f, 0.f};
        cur = nxt; cA = nA; cB = nB; ++ui;
        if constexpr (ALIGN_EPI) { if (wr == 1) PG8_BAR; }
    }
    PG8_WAIT_V(0);
    if constexpr (!ALIGN_EPI) { if (wr == 0) PG8_BAR; }
    PG8_BAR;
    if constexpr (Epi::AFTER_DRAIN) { E.fused(acc, cur, wr, wc, fr, fq, lds, wid, lane); S.done(cur); }
#undef PG8_SA
#undef PG8_SB
#undef PG8_STAGE
#undef PG8_LDA
#undef PG8_LDB
#undef PG8_MMA
#undef PG8_WAIT_V
#undef PG8_WAIT_L
#undef PG8_BAR
#undef PG8_SCHED
}
}
#define LAS __attribute__((address_space(3)))
typedef float f32x4 __attribute__((ext_vector_type(4)));
typedef unsigned u32x4 __attribute__((ext_vector_type(4)));
typedef unsigned u32x2 __attribute__((ext_vector_type(2)));
constexpr int NWAVES = 8, NTHREADS = 512;
constexpr int RING_BYTES = 131072, EPI_OFF = RING_BYTES, EPI_BYTES = 8192, MISC_OFF = EPI_OFF + EPI_BYTES, LDS_BYTES = 147456;

typedef float f32x2_t __attribute__((ext_vector_type(2))); typedef __bf16 bf16x2_t __attribute__((ext_vector_type(2)));
__device__ __forceinline__ unsigned pk2(float lo, float hi) { f32x2_t v = {lo, hi}; bf16x2_t b = __builtin_convertvector(v, bf16x2_t); return __builtin_bit_cast(unsigned, b); }
__device__ __forceinline__ u32x4 pk8(const f32x4& a, const f32x4& b) { u32x4 r; r.x = pk2(a[0], a[1]); r.y = pk2(a[2], a[3]); r.z = pk2(b[0], b[1]); r.w = pk2(b[2], b[3]); return r; }
__device__ __forceinline__ float sum4sq(const f32x4& a) { return (a[0] * a[0] + a[1] * a[1]) + (a[2] * a[2] + a[3] * a[3]); }
__device__ __forceinline__ float fq_sum(float s) { s += xor_shfl<16>(s); return sum_halves(s); }

struct LDec { int pn, bj, wc, nn, fq, e, f, w, d; };
__device__ __forceinline__ LDec ldec(int n) { LDec r; r.pn = n >> 8; const int L = n & 255; r.bj = L >> 7; r.wc = (L >> 5) & 3; r.nn = (L >> 4) & 1; r.fq = (L >> 2) & 3; r.e = L & 3;
    r.f = 128 * r.bj + 32 * r.wc + 8 * r.fq + 4 * r.nn + r.e;
    r.w = 16 * r.fq + 8 * r.bj + 4 * r.nn + r.e;
    r.d = 32 * r.bj + 16 * r.nn + 4 * r.fq + r.e;
    return r; }
enum { MAP_OUT = 0, MAP_IN_ODD, MAP_IN_EVEN, MAP_UQ, MAP_UKV };
__device__ __forceinline__ int srccol(int map, int n) {
    const LDec r = ldec(n);
    switch (map) {
        case MAP_OUT: return r.pn * 256 + r.f;
        case MAP_IN_ODD:
            if (r.pn < 4) return (4 * r.pn + r.wc) * 64 + r.d;
            if (r.pn == 4) return 1024 + r.wc * 64 + r.d;
            if (r.pn == 5) return 1280 + r.wc * 64 + r.w;
            return 1536 + (r.pn - 6) * 256 + r.f;
        case MAP_IN_EVEN:
            switch (r.pn) {
                case 0: return r.f;
                case 1: if (r.bj == 0) return 256 + r.f; return r.wc == 0 ? 640 + o2j32(8 * r.fq + 4 * r.nn + r.e) : -1;
                case 2: return 384 + r.f;
                case 3: case 4: return 672 + (r.pn - 3) * 256 + r.f;
                case 5: case 6: return 2208 + (r.pn - 5) * 256 + r.f;
                case 7: return 1184 + r.wc * 64 + r.d;
                case 8: return 1440 + r.wc * 64 + r.d;
                default: return 1696 + (2 * (r.pn - 9) + (r.wc >> 1)) * 128 + 64 * (r.wc & 1) + r.w;
            }
        case MAP_UQ:
            if (r.pn < 2) return (4 * r.pn + r.wc) * 96 + r.w;
            return (2 * r.wc + (r.w >> 5)) * 96 + 64 + o2j32(r.w & 31);
        default:
            if (r.pn < 2) return (4 * r.pn + r.wc) * 128 + r.w;
            return (4 * (r.pn - 2) + r.wc) * 128 + 64 + r.w;
    }
}
__device__ __forceinline__ void prep_item(const float* W, int K, int Nsrc, bf16_t* WT, int map, const float* kscale, LAS float* scr, int item, int lane) {
    const int nblk_k = K / 64, nb = item / nblk_k, kb = item % nblk_k, k0 = 64 * kb, n0 = 32 * nb;
    const int sc = srccol(map, n0 + (lane & 31));
#pragma unroll 8
    for (int i = 0; i < 32; ++i) { const int kk = 2 * i + (lane >> 5); float v = 0.f; if (sc >= 0) { v = W[(size_t)(k0 + kk) * Nsrc + sc]; if (kscale) v *= kscale[k0 + kk]; } scr[kk * 33 + (lane & 31)] = v; }
    asm volatile("s_waitcnt lgkmcnt(0)" ::: "memory");
    const int c = lane & 7;
#pragma unroll
    for (int j = 0; j < 4; ++j) { const int n = (lane >> 3) + 8 * j; const LAS float* s = scr + (8 * c) * 33 + n;
        u32x4 o; o.x = pk2(s[0 * 33], s[1 * 33]); o.y = pk2(s[2 * 33], s[3 * 33]); o.z = pk2(s[4 * 33], s[5 * 33]); o.w = pk2(s[6 * 33], s[7 * 33]);
        *(u32x4*)(WT + (size_t)(n0 + n) * K + k0 + 8 * c) = o; }
    asm volatile("s_waitcnt lgkmcnt(0)" ::: "memory");
}
__device__ __forceinline__ void prep_layer_weights(CParams& P, int layer, LAS float* scr, int gw, int ngw, int lane) {
    const int li = layer >> 1;
    if (layer & 1) {
        const int nIn = (2560 / 32) * 16, nOut = (1024 / 32) * 16;
        for (int it = gw; it < nIn + nOut; it += ngw) {
            if (it < nIn) prep_item(P.in[I_WWIN] + (size_t)li * 1024 * WIN_IN, 1024, WIN_IN, ws_bf(P, WS_WIN), MAP_IN_ODD, nullptr, scr, it, lane);
            else prep_item(P.in[I_WWOUT] + (size_t)li * 1024 * 1024, 1024, 1024, ws_bf(P, layer & 1 ? WS_WOUT1 : WS_WOUT0), MAP_OUT, nullptr, scr, it - nIn, lane);
        }
    } else {
        const int nIn = (2816 / 32) * 16, nOut = (1024 / 32) * 16, nUq = (768 / 32) * 6, nUkv = (1024 / 32) * 4;
        for (int it = gw; it < nIn + nOut + nUq + nUkv; it += ngw) {
            int r = it;
            if (r < nIn) { prep_item(P.in[I_ABWIN] + (size_t)li * 1024 * AB_IN, 1024, AB_IN, ws_bf(P, WS_WIN), MAP_IN_EVEN, nullptr, scr, r, lane); continue; } r -= nIn;
            if (r < nOut) { prep_item(P.in[I_ABWOUT] + (size_t)li * 1024 * 1024, 1024, 1024, ws_bf(P, WS_WOUT0), MAP_OUT, nullptr, scr, r, lane); continue; } r -= nOut;
            if (r < nUq) { prep_item(P.in[I_WUQ] + (size_t)li * 384 * 768, 384, 768, ws_bf(P, WS_WUQ), MAP_UQ, P.in[I_QNG] + li * 384, scr, r, lane); continue; } r -= nUq;
            prep_item(P.in[I_WUKV] + (size_t)li * 256 * 1024, 256, 1024, ws_bf(P, WS_WUKV), MAP_UKV, nullptr, scr, r, lane);
        }
    }
}
__device__ void fast_biasL(CParams& P, long gt, long gn) {
    float* biasl = ws_f32(P, WS_BIASL); const float* mod = ws_f32(P, WS_MOD);
    for (long i = gt; i < 4L * 5 * 2816; i += gn) {
        const int n = (int)(i % 2816), c = (int)((i / 2816) % 5), l = (int)(i / (2816 * 5));
        const int N = (l & 1) ? WIN_IN : AB_IN; float s = 0.f;
        const int sc = (n < ((l & 1) ? 2560 : 2816)) ? srccol((l & 1) ? MAP_IN_ODD : MAP_IN_EVEN, n) : -1;
        if (sc >= 0) { const float* w = ((l & 1) ? P.in[I_WWIN] : P.in[I_ABWIN]) + (size_t)(l >> 1) * 1024 * N + sc; const float* sh = mod + (l * 5 + c) * 3072;
            for (int k = 0; k < 1024; ++k) s += sh[k] * w[(size_t)k * N]; }
        biasl[i] = s;
    }
}

#define EPI_ROW(ai, m) (u.pm * 256 + (ai) * 128 + wr * 64 + (m) * 16 + fr)
typedef f32x4 AccT[2][2][4][2];

struct EpiOut {
    static constexpr bool PERM = false, AFTER_DRAIN = false;
    CParams* Pp; int layer;
    __device__ __forceinline__ void operator()(const AccT& acc, const pg8::Unit& u, int wr, int wc, int fr_, int fq_) const {
        const int ln_ = lane_id(); const int fr = ln_ & 15, fq = ln_ >> 4; (void)fr_; (void)fq_;
        CParams* Pl = Pp; asm volatile("" : "+s"(Pl)); CParams& P = *Pl;
        const int cond = u.pm < 32 ? 4 : (u.pm - 32) >> 4;
        const float* gate = ws_f32(P, WS_MOD) + (layer * 5 + cond) * 3072 + 2048; const float* gsn = ws_f32(P, WS_GS) + ((layer + 1) * 5 + cond) * 1024;
        bf16_t* An = ws_bf(P, (layer & 1) ? WS_AEVEN : WS_AODD); float* SS = ws_f32(P, WS_SS);
        float ssq[2][4];
#pragma unroll
        for (int ai = 0; ai < 2; ++ai)
#pragma unroll
            for (int m = 0; m < 4; ++m) ssq[ai][m] = 0.f;
#pragma unroll
        for (int bj = 0; bj < 2; ++bj) {
            const int col = u.pn * 256 + 128 * bj + 32 * wc + 8 * fq;
            const f32x4 g0 = *(const f32x4*)(gate + col), g1 = *(const f32x4*)(gate + col + 4);
            f32x4 s0 = {0.f, 0.f, 0.f, 0.f}, s1 = s0; if (layer < 3) { s0 = *(const f32x4*)(gsn + col); s1 = *(const f32x4*)(gsn + col + 4); }
#pragma unroll
            for (int ai = 0; ai < 2; ++ai)
#pragma unroll
                for (int m = 0; m < 4; ++m) {
                    const int row = EPI_ROW(ai, m); const float* yo = y_row(P, layer, row) + col; float* yn = P.out + (size_t)row * 1024 + col;
                    const f32x4 y0 = *(const f32x4*)(yo) + g0 * acc[ai][bj][m][0], y1 = *(const f32x4*)(yo + 4) + g1 * acc[ai][bj][m][1];
                    *(f32x4*)(yn) = y0; *(f32x4*)(yn + 4) = y1; ssq[ai][m] += sum4sq(y0) + sum4sq(y1);
                    if (layer < 3) *(u32x4*)(An + (size_t)row * 1024 + col) = pk8(y0 * s0, y1 * s1);
                    if (m & 1) asm volatile("" ::: "memory");
                }
        }
        if (layer < 3) {
#pragma unroll
            for (int ai = 0; ai < 2; ++ai)
#pragma unroll
                for (int m = 0; m < 4; ++m) { const float s = fq_sum(ssq[ai][m]); if (fq == 0) SS[EPI_ROW(ai, m) * 16 + u.pn * 4 + wc] = s; }
        }
    }
};

__device__ __forceinline__ void rope4(f32x4& x0, f32x4& x1, const float* cs) {
    const f32x4 a = *(const f32x4*)cs, b = *(const f32x4*)(cs + 4);
    const f32x4 c = {a[0], a[2], b[0], b[2]}, s = {a[1], a[3], b[1], b[3]};
    const f32x4 y0 = x0 * c - x1 * s, y1 = x0 * s + x1 * c; x0 = y0; x1 = y1;
}

template <bool ODD> struct EpiIn {
    static constexpr bool PERM = false, AFTER_DRAIN = false;
    CParams* Pp; int layer; LAS float* xch;
    __device__ __forceinline__ void operator()(const AccT& acc, const pg8::Unit& u, int wr, int wc, int fr_, int fq_) const {
        const int ln_ = lane_id(); const int fr = ln_ & 15, fq = ln_ >> 4; (void)fr_; (void)fq_;
        CParams* Pl = Pp; asm volatile("" : "+s"(Pl)); CParams& P = *Pl;
        const int pn = u.pn; const bool sample = u.pm >= 32; const int cond = sample ? (u.pm - 32) >> 4 : 4; const int li = layer >> 1;
        const float* SS = ws_f32(P, WS_SS); const float* biasl = ws_f32(P, WS_BIASL) + (layer * 5 + cond) * 2816 + pn * 256;
        const float* r16 = ws_f32(P, WS_ROPE16);
        f32x4 bv[2][2];
#pragma unroll
        for (int bj = 0; bj < 2; ++bj)
#pragma unroll
            for (int n = 0; n < 2; ++n) bv[bj][n] = *(const f32x4*)(biasl + 128 * bj + 32 * wc + 16 * n + 4 * fq);
        enum { K_NAT_G, K_ROPEHEAD, K_V, K_CQ0, K_CQ1, K_CKV, K_RV };
        int kind; bf16_t* gdst = nullptr;
        if (ODD) { kind = pn < 5 ? K_ROPEHEAD : (pn == 5 ? K_V : K_NAT_G); if (pn >= 6) gdst = ws_bf(P, WS_G) + (pn - 6) * 256; }
        else { kind = pn == 0 ? K_CQ0 : pn == 1 ? K_CQ1 : pn == 2 ? K_CKV : pn < 7 ? K_NAT_G : pn < 9 ? K_ROPEHEAD : K_RV; if (pn >= 3 && pn < 7) gdst = ws_bf(P, WS_G) + (pn - 3) * 256; }
        const float* hg = nullptr; f32x4 hgv[2][2];
        if (ODD && pn < 5) { hg = (pn < 4 ? P.in[I_WQHG] : P.in[I_WKHG]) + li * 64;
#pragma unroll
            for (int bj = 0; bj < 2; ++bj)
#pragma unroll
                for (int n = 0; n < 2; ++n) hgv[bj][n] = *(const f32x4*)(hg + 32 * bj + 16 * n + 4 * fq); }
        if (!ODD && kind == K_CKV) {
#pragma unroll
            for (int ai = 0; ai < 2; ++ai)
#pragma unroll
                for (int m = 0; m < 4; ++m) { const int row = EPI_ROW(ai, m); const float rs = row_rstd(SS, row); float s = 0.f;
#pragma unroll
                    for (int bj = 0; bj < 2; ++bj)
#pragma unroll
                        for (int n = 0; n < 2; ++n) s += sum4sq(acc[ai][bj][m][n] * rs + bv[bj][n]);
                    s = fq_sum(s); if (fq == 0) xch[(ai * 128 + wr * 64 + m * 16 + fr) * 4 + wc] = s; }
            asm volatile("s_waitcnt lgkmcnt(0)" ::: "memory"); __builtin_amdgcn_s_barrier(); asm volatile("" ::: "memory");
        }
#pragma unroll
        for (int ai = 0; ai < 2; ++ai)
#pragma unroll
            for (int m = 0; m < 4; ++m) {
                const int row = EPI_ROW(ai, m); const float rs = row_rstd(SS, row);
                f32x4 v[2][2];
#pragma unroll
                for (int bj = 0; bj < 2; ++bj)
#pragma unroll
                    for (int n = 0; n < 2; ++n) v[bj][n] = acc[ai][bj][m][n] * rs + bv[bj][n];
                const int t = (row - NP_ROWS) & 4095, pr = t >> 6, pc = t & 63;
                if (kind == K_NAT_G) {
#pragma unroll
                    for (int bj = 0; bj < 2; ++bj) { f32x4 a = v[bj][0], b = v[bj][1];
#pragma unroll
                        for (int e = 0; e < 4; ++e) { a[e] = silu_f(a[e]); b[e] = silu_f(b[e]); }
                        *(u32x4*)(gdst + (size_t)row * 1024 + 128 * bj + 32 * wc + 8 * fq) = pk8(a, b); }
                } else if (kind == K_ROPEHEAD) {
                    if (ODD) {
                        float s = 0.f;
#pragma unroll
                        for (int bj = 0; bj < 2; ++bj) s += sum4sq(v[bj][0]) + sum4sq(v[bj][1]);
                        s = fq_sum(s); const float hr = 1.0f / sqrtf(s * (1.f / 64.f) + EPS);
#pragma unroll
                        for (int bj = 0; bj < 2; ++bj)
#pragma unroll
                            for (int n = 0; n < 2; ++n) v[bj][n] = v[bj][n] * hr * hgv[bj][n];
                        if (pn == 4 && !sample) { float* ok = P.out + (layer == 1 ? O_L1K : O_L3K) + (size_t)row * 256 + wc * 64;
#pragma unroll
                            for (int bj = 0; bj < 2; ++bj)
#pragma unroll
                                for (int n = 0; n < 2; ++n) *(f32x4*)(ok + 32 * bj + 16 * n + 4 * fq) = v[bj][n]; }
                        if (sample) { rope4(v[0][0], v[0][1], r16 + (pr * 16 + 4 * fq) * 2); rope4(v[1][0], v[1][1], r16 + (pc * 16 + 4 * fq) * 2); }
                        if (pn < 4) { const float qs = 0.125f * LOG2E; bf16_t* q = ws_bf(P, WS_QW) + (size_t)row * 1024 + (4 * pn + wc) * 64 + 16 * fq;
                            *(u32x4*)(q) = pk8(v[0][0] * qs, v[0][1] * qs); *(u32x4*)(q + 8) = pk8(v[1][0] * qs, v[1][1] * qs);
                        } else { int kin; const int tile = kv_tile(row, wc, 4, kin); unsigned char* kb = P.ws + WS_KWIMG + (size_t)tile * 8192 + kin * 16;
                            *(u32x4*)(kb + (2 * fq) * 1024) = pk8(v[0][0], v[0][1]); *(u32x4*)(kb + (2 * fq + 1) * 1024) = pk8(v[1][0], v[1][1]); }
                    } else {
                        if (pn == 7) {
#pragma unroll
                            for (int bj = 0; bj < 2; ++bj) { v[bj][0] = v[bj][0] * 0.125f; v[bj][1] = v[bj][1] * 0.125f; } }
                        if (sample) { rope4(v[0][0], v[0][1], r16 + (pr * 16 + 4 * fq) * 2); rope4(v[1][0], v[1][1], r16 + (pc * 16 + 4 * fq) * 2); }
                        bf16_t* q = ws_bf(P, pn == 7 ? WS_RQ : WS_RK) + (size_t)row * 256 + wc * 64 + 16 * fq;
                        *(u32x4*)(q) = pk8(v[0][0], v[0][1]); *(u32x4*)(q + 8) = pk8(v[1][0], v[1][1]);
                    }
                } else if (kind == K_V) {
                    if (!sample) { float* ov = P.out + (layer == 1 ? O_L1V : O_L3V) + (size_t)row * 256 + wc * 64 + 16 * fq;
#pragma unroll
                        for (int bj = 0; bj < 2; ++bj) { *(f32x4*)(ov + 8 * bj) = v[bj][0]; *(f32x4*)(ov + 8 * bj + 4) = v[bj][1]; } }
                    int kin; const int tile = kv_tile(row, wc, 4, kin); unsigned char* vb = P.ws + WS_VWIMG + (size_t)tile * 8192 + (fq >> 1) * 4096 + kin * 64 + (fq & 1) * 32;
                    *(u32x4*)(vb) = pk8(v[0][0], v[0][1]); *(u32x4*)(vb + 16) = pk8(v[1][0], v[1][1]);
                } else if (kind == K_CQ0 || kind == K_CQ1) {
                    bf16_t* cq = ws_bf(P, WS_CQ) + (size_t)row * 384; float* sscq = ws_f32(P, WS_SSCQ);
                    if (kind == K_CQ0) {
#pragma unroll
                        for (int bj = 0; bj < 2; ++bj) *(u32x4*)(cq + 128 * bj + 32 * wc + 8 * fq) = pk8(v[bj][0], v[bj][1]);
                        float s = sum4sq(v[0][0]) + sum4sq(v[0][1]) + sum4sq(v[1][0]) + sum4sq(v[1][1]); s = fq_sum(s); if (fq == 0) sscq[row * 8 + wc] = s;
                    } else {
                        *(u32x4*)(cq + 256 + 32 * wc + 8 * fq) = pk8(v[0][0], v[0][1]);
                        float s = sum4sq(v[0][0]) + sum4sq(v[0][1]); s = fq_sum(s); if (fq == 0) sscq[row * 8 + 4 + wc] = s;
                        if (wc == 0) {
                            *(u32x4*)(ws_bf(P, WS_KR) + (size_t)row * 32 + 8 * fq) = pk8(v[1][0], v[1][1]);
                            float s2 = sum4sq(v[1][0]) + sum4sq(v[1][1]); s2 = fq_sum(s2); if (fq == 0) ws_f32(P, WS_SSKR)[row] = s2;
                            if (!sample) { float* okr = P.out + (layer == 0 ? O_L0KR : O_L2KR) + (size_t)row * 32 + 16 * (fq >> 1) + 4 * (fq & 1); *(f32x4*)(okr) = v[1][0]; *(f32x4*)(okr + 8) = v[1][1]; }
                        }
                    }
                } else if (kind == K_CKV) {
                    const LAS float* xr = xch + (ai * 128 + wr * 64 + m * 16 + fr) * 4; const float s = (xr[0] + xr[1]) + (xr[2] + xr[3]);
                    const float cr = 1.0f / sqrtf(s * (1.f / 256.f) + EPS); const float* gkv = P.in[I_KVNG] + li * 256;
#pragma unroll
                    for (int bj = 0; bj < 2; ++bj) { const int col = 128 * bj + 32 * wc + 8 * fq;
                        const f32x4 a = v[bj][0] * cr * *(const f32x4*)(gkv + col), b = v[bj][1] * cr * *(const f32x4*)(gkv + col + 4);
                        *(u32x4*)(ws_bf(P, WS_CKVN) + (size_t)row * 256 + col) = pk8(a, b);
                        if (!sample) { float* oc = P.out + (layer == 0 ? O_L0CKV : O_L2CKV) + (size_t)row * 256 + col; *(f32x4*)(oc) = a; *(f32x4*)(oc + 4) = b; } }
                } else {
                    bf16_t* rv = ws_bf(P, WS_RV) + (size_t)row * 512 + (2 * (pn - 9) + (wc >> 1)) * 128 + 64 * (wc & 1) + 16 * fq;
                    *(u32x4*)(rv) = pk8(v[0][0], v[0][1]); *(u32x4*)(rv + 8) = pk8(v[1][0], v[1][1]);
                }
            }
        if (!ODD && kind == K_CKV) { asm volatile("s_waitcnt lgkmcnt(0)" ::: "memory"); __builtin_amdgcn_s_barrier(); asm volatile("" ::: "memory"); }
    }
};

struct EpiUq {
    static constexpr bool PERM = false, AFTER_DRAIN = false;
    CParams* Pp; int layer;
    __device__ __forceinline__ void operator()(const AccT& acc, const pg8::Unit& u, int wr, int wc, int fr_, int fq_) const {
        const int ln_ = lane_id(); const int fr = ln_ & 15, fq = ln_ >> 4; (void)fr_; (void)fq_;
        CParams* Pl = Pp; asm volatile("" : "+s"(Pl)); CParams& P = *Pl;
        bf16_t* QR = ws_bf(P, WS_QR); const float* sscq = ws_f32(P, WS_SSCQ);
#pragma unroll
        for (int ai = 0; ai < 2; ++ai)
#pragma unroll
            for (int m = 0; m < 4; ++m) { const int row = EPI_ROW(ai, m);
                float s = sum4sq(acc[ai][0][m][0]) + sum4sq(acc[ai][0][m][1]) + sum4sq(acc[ai][1][m][0]) + sum4sq(acc[ai][1][m][1]);
                if (u.pn < 2) { const int head = 4 * u.pn + wc; bf16_t* q = QR + ((size_t)row * 8 + head) * 96 + 16 * fq;
                    *(u32x4*)(q) = pk8(acc[ai][0][m][0], acc[ai][0][m][1]); *(u32x4*)(q + 8) = pk8(acc[ai][1][m][0], acc[ai][1][m][1]);
                    s = fq_sum(s);
                    if (fq == 0) { float c = 0.f;
#pragma unroll
                        for (int j = 0; j < 8; ++j) c += sscq[row * 8 + j];
                        ws_f32(P, WS_SSQN)[row * 8 + head] = s + 96.f * EPS * (c * (1.f / 384.f) + EPS); }
                } else { const int head = 2 * wc + (fq >> 1); bf16_t* q = QR + ((size_t)row * 8 + head) * 96 + 64 + 16 * (fq & 1);
                    *(u32x4*)(q) = pk8(acc[ai][0][m][0], acc[ai][0][m][1]); *(u32x4*)(q + 8) = pk8(acc[ai][1][m][0], acc[ai][1][m][1]);
                    s += xor_shfl<16>(s);
                    if ((fq & 1) == 0) ws_f32(P, WS_SSQR)[row * 8 + head] = s; }
            }
    }
};

struct EpiUkv {
    static constexpr bool PERM = false, AFTER_DRAIN = false;
    CParams* Pp; int layer;
    __device__ __forceinline__ void operator()(const AccT& acc, const pg8::Unit& u, int wr, int wc, int fr_, int fq_) const {
        const int ln_ = lane_id(); const int fr = ln_ & 15, fq = ln_ >> 4; (void)fr_; (void)fq_;
        CParams* Pl = Pp; asm volatile("" : "+s"(Pl)); CParams& P = *Pl;
        const int li = layer >> 1; const float* gk = P.in[I_KHG] + li * 96; const float* r8 = ws_f32(P, WS_ROPE8); const float* sskr = ws_f32(P, WS_SSKR); const bf16_t* KR = ws_bf(P, WS_KR);
        const bool lat = (u.pm >= 32 && u.pm < 96);
#pragma unroll
        for (int ai = 0; ai < 2; ++ai)
#pragma unroll
            for (int m = 0; m < 4; ++m) { const int R = EPI_ROW(ai, m);
                if (u.pn < 2) { const int head = 4 * u.pn + wc; int kin; const int tile = kv_tile(R, head, 8, kin); unsigned char* kb = P.ws + WS_KIMG + (size_t)tile * 12288 + kin * 16;
                    float s = sum4sq(acc[ai][0][m][0]) + sum4sq(acc[ai][0][m][1]) + sum4sq(acc[ai][1][m][0]) + sum4sq(acc[ai][1][m][1]);
                    s = fq_sum(s) + sskr[R]; const float rs = 1.0f / sqrtf(s * (1.f / 96.f) + EPS);
#pragma unroll
                    for (int bj = 0; bj < 2; ++bj) { const float* g = gk + 16 * fq + 8 * bj;
                        *(u32x4*)(kb + (2 * fq + bj) * 1024) = pk8(acc[ai][bj][m][0] * rs * *(const f32x4*)(g), acc[ai][bj][m][1] * rs * *(const f32x4*)(g + 4)); }
                    const u32x4 kr = *(const u32x4*)(KR + (size_t)R * 32 + 8 * fq); const int jb = 16 * (fq >> 1) + 4 * (fq & 1);
                    f32x4 x1 = {__uint_as_float(kr.x << 16), __uint_as_float(kr.x & 0xffff0000u), __uint_as_float(kr.y << 16), __uint_as_float(kr.y & 0xffff0000u)};
                    f32x4 x2 = {__uint_as_float(kr.z << 16), __uint_as_float(kr.z & 0xffff0000u), __uint_as_float(kr.w << 16), __uint_as_float(kr.w & 0xffff0000u)};
                    x1 = x1 * rs * *(const f32x4*)(gk + 64 + jb); x2 = x2 * rs * *(const f32x4*)(gk + 64 + jb + 8);
                    if (lat) { const int t = (R - NP_ROWS) & 4095; const int pos = (fq >> 1) ? (t & 63) : (t >> 6); rope4(x1, x2, r8 + (pos * 8 + 4 * (fq & 1)) * 2); }
                    *(u32x4*)(kb + (8 + fq) * 1024) = pk8(x1, x2);
                } else { const int head = 4 * (u.pn - 2) + wc; int kin; const int tile = kv_tile(R, head, 8, kin);
                    unsigned char* vb = P.ws + WS_VIMG + (size_t)tile * 8192 + (fq >> 1) * 4096 + kin * 64 + (fq & 1) * 32;
                    *(u32x4*)(vb) = pk8(acc[ai][0][m][0], acc[ai][0][m][1]); *(u32x4*)(vb + 16) = pk8(acc[ai][1][m][0], acc[ai][1][m][1]); }
            }
    }
};
typedef short bf16x8 __attribute__((ext_vector_type(8)));
typedef float f32x16 __attribute__((ext_vector_type(16)));
typedef short v4i16_t __attribute__((ext_vector_type(4)));
__device__ __forceinline__ int crow(int r, int hi) { return (r & 3) + 8 * (r >> 2) + 4 * hi; }
__device__ __forceinline__ v4i16_t vtr(const LAS unsigned char* p) { return __builtin_amdgcn_ds_read_tr16_b64_v4i16((LAS v4i16_t*)p); }
#define ATT_BAR() asm volatile("s_waitcnt vmcnt(0) lgkmcnt(0)\n\ts_barrier" ::: "memory")

constexpr int AT_K0 = 0, AT_KSZ = 12288, AT_V0 = 2 * AT_KSZ, AT_VSZ = 8192, AT_WS = AT_V0 + 2 * AT_VSZ, AT_OST = AT_WS + 8 * 256, AT_END = AT_OST + 8 * 4096;
static_assert(AT_END <= RING_BYTES, "attention LDS map");

struct AttnTiles { const unsigned char* kbase; const unsigned char* vbase; int a0, nA, b0, nB; };

template <int DQK>
__device__ __forceinline__ void attn_unit(LAS unsigned char* lds, const AttnTiles& T, const bf16x8 (&qf)[DQK / 16], float bnd, int maskq, int klo, int qb,
                                          f32x16 (&o)[2], float& lsum, int wave, int lane, int tid) {
    constexpr int KT = DQK * 128;
    constexpr int NS = DQK / 16;
    const int r = lane & 31, hh = lane >> 5;
    const int nT = T.nA + T.nB;
    u32x4 kr0, kr1 = {0u, 0u, 0u, 0u}, vr;
    const bool k2 = (DQK == 96) && (tid < 256);
#define AT_TILE(i) ((i) < T.nA ? T.a0 + (i) : T.b0 + ((i) - T.nA))
#define AT_LOAD(i) do { const int ti_ = AT_TILE(i); const unsigned char* kp_ = T.kbase + (size_t)ti_ * KT; kr0 = *(const u32x4*)(kp_ + tid * 16); \
        if (k2) kr1 = *(const u32x4*)(kp_ + 8192 + tid * 16); vr = *(const u32x4*)(T.vbase + (size_t)ti_ * 8192 + tid * 16); } while (0)
#define AT_STORE(b) do { *(LAS u32x4*)(lds + AT_K0 + (b) * AT_KSZ + tid * 16) = kr0; if (k2) *(LAS u32x4*)(lds + AT_K0 + (b) * AT_KSZ + 8192 + tid * 16) = kr1; \
        *(LAS u32x4*)(lds + AT_V0 + (b) * AT_VSZ + tid * 16) = vr; } while (0)
    f32x16 negb;
#pragma unroll
    for (int i = 0; i < 16; ++i) negb[i] = -bnd;
    AT_LOAD(0); AT_STORE(0); ATT_BAR();
    for (int it = 0; it < nT; ++it) {
        const int cur = it & 1;
        const bool more = it + 1 < nT;
        if (more) AT_LOAD(it + 1);
        const LAS unsigned char* kb = lds + AT_K0 + cur * AT_KSZ + hh * 1024 + r * 16;
        f32x16 p0 = negb, p1 = negb;
#pragma unroll
        for (int s = 0; s < NS; ++s) {
            const bf16x8 k0 = *(const LAS bf16x8*)(kb + s * 2048), k1 = *(const LAS bf16x8*)(kb + s * 2048 + 512);
            p0 = __builtin_amdgcn_mfma_f32_32x32x16_bf16(k0, qf[s], p0, 0, 0, 0);
            p1 = __builtin_amdgcn_mfma_f32_32x32x16_bf16(k1, qf[s], p1, 0, 0, 0);
        }
#pragma unroll
        for (int i = 0; i < 16; ++i) { p0[i] = __builtin_amdgcn_exp2f(p0[i]); p1[i] = __builtin_amdgcn_exp2f(p1[i]); }
        if (maskq >= 0 && it >= T.nA) {
            const int kt = klo + (it - T.nA);
            if (kt == qb - 2 || kt == qb + 2) {
                const int q = maskq + r, k0i = 64 * kt + 4 * hh;
#pragma unroll
                for (int i = 0; i < 16; ++i) { const int d0 = k0i + (i & 3) + 8 * (i >> 2) - q, d1 = d0 + 32;
                    if (d0 > 128 || d0 < -128) p0[i] = 0.f; if (d1 > 128 || d1 < -128) p1[i] = 0.f; }
            }
        }
        { float s0 = 0.f, s1 = 0.f;
#pragma unroll
          for (int i = 0; i < 16; ++i) { s0 += p0[i]; s1 += p1[i]; }
          lsum += s0 + s1; }
        u32x4 pw[4];
#pragma unroll
        for (int j = 0; j < 4; ++j) { pw[0][j] = pk2(p0[2 * j], p0[2 * j + 1]); pw[1][j] = pk2(p0[8 + 2 * j], p0[8 + 2 * j + 1]); pw[2][j] = pk2(p1[2 * j], p1[2 * j + 1]); pw[3][j] = pk2(p1[8 + 2 * j], p1[8 + 2 * j + 1]); }
        const LAS unsigned char* vb = lds + AT_V0 + cur * AT_VSZ + ((lane >> 4) & 1) * 32 + (lane & 3) * 8 + (4 * hh + ((lane & 15) >> 2)) * 64;
#pragma unroll
        for (int d0 = 0; d0 < 2; ++d0)
#pragma unroll
            for (int ks = 0; ks < 4; ++ks) {
                const v4i16_t lo = vtr(vb + d0 * 4096 + ks * 1024), hi = vtr(vb + d0 * 4096 + ks * 1024 + 512);
                const bf16x8 vf = {lo[0], lo[1], lo[2], lo[3], hi[0], hi[1], hi[2], hi[3]};
                o[d0] = __builtin_amdgcn_mfma_f32_32x32x16_bf16(__builtin_bit_cast(bf16x8, pw[ks]), vf, o[d0], 0, 0, 0);
            }
        if (more) AT_STORE(cur ^ 1);
        ATT_BAR();
    }
#undef AT_LOAD
#undef AT_TILE
#undef AT_STORE
}
__device__ __forceinline__ void attn_finish(LAS unsigned char* lds, f32x16 (&o)[2], float lsum, float ladd, bf16_t* G, int row0, int col0, int wave, int lane) {
    const int r = lane & 31, hh = lane >> 5;
    LAS float* wsf = (LAS float*)(lds + AT_WS) + wave * 64;
    const float l = sum_halves(lsum) + ladd;
    if (hh == 0) wsf[r] = l;
    asm volatile("s_waitcnt lgkmcnt(0)" ::: "memory");
    LAS bf16_t* stg = (LAS bf16_t*)(lds + AT_OST) + wave * 2048;
#pragma unroll
    for (int i = 0; i < 16; ++i) { const int orow = crow(i, hh); const float rl = __builtin_amdgcn_rcpf(wsf[orow]);
#pragma unroll
        for (int d0 = 0; d0 < 2; ++d0) stg[orow * 64 + d0 * 32 + r] = f2bf(o[d0][i] * rl); }
    asm volatile("s_waitcnt lgkmcnt(0)" ::: "memory");
#pragma unroll
    for (int i = 0; i < 4; ++i) { const int row = i * 8 + (lane >> 3), ch = lane & 7;
        const u32x4 v = *(const LAS u32x4*)(stg + row * 64 + ch * 8); bf16_t* gp = G + (size_t)(row0 + row) * 1024 + col0 + ch * 8; const u32x4 g = *(const u32x4*)gp;
        u32x4 w;
#pragma unroll
        for (int j = 0; j < 4; ++j) { const float a0 = __uint_as_float(v[j] << 16) * __uint_as_float(g[j] << 16), a1 = __uint_as_float(v[j] & 0xffff0000u) * __uint_as_float(g[j] & 0xffff0000u); w[j] = pk2(a0, a1); }
        *(u32x4*)gp = w; }
    asm volatile("s_waitcnt lgkmcnt(0)" ::: "memory");
}
__device__ __forceinline__ f32x4 unpk_lo(const u32x4& v) { return (f32x4){__uint_as_float(v.x << 16), __uint_as_float(v.x & 0xffff0000u), __uint_as_float(v.y << 16), __uint_as_float(v.y & 0xffff0000u)}; }
__device__ __forceinline__ f32x4 unpk_hi(const u32x4& v) { return (f32x4){__uint_as_float(v.z << 16), __uint_as_float(v.z & 0xffff0000u), __uint_as_float(v.w << 16), __uint_as_float(v.w & 0xffff0000u)}; }

__device__ __forceinline__ void mla_unit(CParams& P, int layer, LAS unsigned char* lds, bool sample, int b, int h, int qblk, int wave, int lane, int tid) {
    const int li = layer >> 1, r = lane & 31, hh = lane >> 5;
    const int row0 = (sample ? NP_ROWS + b * 4096 + qblk * 256 : b * 256) + wave * 32, row = row0 + r;
    bf16x8 qf[6];
    { const bf16_t* QR = ws_bf(P, WS_QR) + ((size_t)row * 8 + h) * 96; const float* gq = P.in[I_QHG] + li * 96; const float* r8 = ws_f32(P, WS_ROPE8);
      const float ss = ws_f32(P, WS_SSQN)[row * 8 + h] + ws_f32(P, WS_SSQR)[row * 8 + h]; const float rs = 1.0f / sqrtf(ss * (1.f / 96.f)); const float qs = 0.10206207261596575f * LOG2E;
      const int t = (row - NP_ROWS) & 4095;
#pragma unroll
      for (int s = 0; s < 6; ++s) { const u32x4 raw = *(const u32x4*)(QR + 16 * s + 8 * hh); f32x4 x0 = unpk_lo(raw), x1 = unpk_hi(raw);
          if (s < 4) { const float* g = gq + 16 * s + 8 * hh; x0 = x0 * rs * *(const f32x4*)(g); x1 = x1 * rs * *(const f32x4*)(g + 4); }
          else { const int base = 16 * (s - 4) + 4 * hh; x0 = x0 * rs * *(const f32x4*)(gq + 64 + base); x1 = x1 * rs * *(const f32x4*)(gq + 64 + base + 8);
              if (sample) { const int pos = (s == 4) ? (t >> 6) : (t & 63); rope4(x0, x1, r8 + (pos * 8 + 4 * hh) * 2); } }
          qf[s] = __builtin_bit_cast(bf16x8, pk8(x0 * qs, x1 * qs)); } }
    AttnTiles T; T.kbase = P.ws + WS_KIMG; T.vbase = P.ws + WS_VIMG; T.a0 = kv_seq_tile0(sample, b, h, 8); T.nA = sample ? 72 : 4; T.b0 = 0; T.nB = 0;
    f32x16 o[2]; float lsum = 0.f;
#pragma unroll
    for (int i = 0; i < 16; ++i) { o[0][i] = 0.f; o[1][i] = 0.f; }
    attn_unit<96>(lds, T, qf, ws_f32(P, WS_BND)[li], -1, 0, 0, o, lsum, wave, lane, tid);
    attn_finish(lds, o, lsum, 0.f, ws_bf(P, WS_G), row0, h * 64, wave, lane);
}
__device__ __forceinline__ void mla_phase(CParams& P, int layer, LAS unsigned char* lds, int wave) {
    const int lane = lane_id(), tid = wave * 64 + lane;
    const int G = gridDim.x, bx = blockIdx.x; const int vcu = (G % 8 == 0) ? (bx % 8) * (G / 8) + bx / 8 : bx;
    for (int u = vcu * 2; u < 512; u += 2 * G)
        for (int j = 0; j < 2; ++j) { const int uu = u + j; mla_unit(P, layer, lds, true, (uu >> 4) >> 3, (uu >> 4) & 7, uu & 15, wave, lane, tid); }
    for (int u = vcu; u < 256; u += G) mla_unit(P, layer, lds, false, u >> 3, u & 7, 0, wave, lane, tid);
}
__device__ __forceinline__ void win_unit(CParams& P, int layer, LAS unsigned char* lds, bool sample, int b, int kvh, int qb, int wave, int lane, int tid) {
    const int li = layer >> 1, r = lane & 31, hh = lane >> 5; const int head = 4 * kvh + (wave >> 1);
    const int qlat = qb * 64 + (wave & 1) * 32;
    const int row0 = (sample ? NP_ROWS + b * 4096 : b * 256) + qlat, row = row0 + r;
    bf16x8 qf[4];
    { const bf16_t* q = ws_bf(P, WS_QW) + (size_t)row * 1024 + head * 64 + 8 * hh;
#pragma unroll
      for (int s = 0; s < 4; ++s) qf[s] = *(const bf16x8*)(q + 16 * s); }
    const float* bf = ws_f32(P, WS_BND); const float knorm = fmaxf(8.f * bf[10 + li], sqrtf(bf[4 + li])); const float bnd = 0.125f * LOG2E * 8.f * bf[8 + li] * knorm;
    AttnTiles T; T.kbase = P.ws + WS_KWIMG; T.vbase = P.ws + WS_VWIMG; const int t0 = kv_seq_tile0(sample, b, kvh, 4);
    int klo = 0;
    if (sample) { klo = max(qb - 2, 0); const int khi = min(qb + 2, 63); T.a0 = t0; T.nA = 8; T.b0 = t0 + 8 + klo; T.nB = khi - klo + 1; }
    else { T.a0 = t0; T.nA = 4; T.b0 = 0; T.nB = 0; }
    f32x16 o[2]; float lsum = 0.f;
#pragma unroll
    for (int i = 0; i < 16; ++i) { o[0][i] = 0.f; o[1][i] = 0.f; }
    attn_unit<64>(lds, T, qf, bnd, sample ? qlat : -1, klo, qb, o, lsum, wave, lane, tid);
    attn_finish(lds, o, lsum, __builtin_amdgcn_exp2f(P.in[I_SINK][li * 16 + head] * LOG2E - bnd), ws_bf(P, WS_G), row0, head * 64, wave, lane);
}
__device__ __forceinline__ void win_phase(CParams& P, int layer, LAS unsigned char* lds, int wave) {
    const int lane = lane_id(), tid = wave * 64 + lane;
    const int G = gridDim.x, bx = blockIdx.x; const int vcu = (G % 8 == 0) ? (bx % 8) * (G / 8) + bx / 8 : bx;
    for (int u = vcu * 4; u < 1024; u += 4 * G)
        for (int j = 0; j < 4; ++j) { const int uu = u + j; win_unit(P, layer, lds, true, (uu >> 6) >> 2, (uu >> 6) & 3, uu & 63, wave, lane, tid); }
    for (int u = vcu * 2; u < 512; u += 2 * G)
        for (int j = 0; j < 2; ++j) { const int uu = u + j; win_unit(P, layer, lds, false, (uu >> 2) >> 2, (uu >> 2) & 3, uu & 3, wave, lane, tid); }
}
#define RET_BAR() asm volatile("s_waitcnt vmcnt(0) lgkmcnt(0)\n\ts_barrier" ::: "memory")
__device__ __forceinline__ bf16x8 tr_frag(const LAS unsigned char* p, int hi_off) { const v4i16_t lo = vtr(p), hi = vtr(p + hi_off); return (bf16x8){lo[0], lo[1], lo[2], lo[3], hi[0], hi[1], hi[2], hi[3]}; }

constexpr int RU_KF = 0, RU_KB = 16384, RU_V = 32768;
__device__ __forceinline__ void ret_u_unit(CParams& P, int layer, LAS unsigned char* lds, int c, int h, int wave, int lane, int tid) {
    const int r0 = chunk_row0(c); const float lgf = log_gamma(P, layer, 0, h), lgb = log_gamma(P, layer, 1, h);
    const bf16_t* RK = ws_bf(P, WS_RK); const bf16_t* RV = ws_bf(P, WS_RV);
#pragma unroll
    for (int j = 0; j < 2; ++j) { const int q = tid + 512 * j, i = q >> 3, pc = q & 7; const u32x4 raw = *(const u32x4*)(RK + (size_t)(r0 + i) * 256 + h * 64 + 8 * pc);
        const float wf = __expf(lgf * (float)(127 - i)), wb = __expf(lgb * (float)i); const f32x4 a = unpk_lo(raw), b = unpk_hi(raw);
        const int off = (pc >> 2) * 8192 + i * 64 + (pc & 3) * 16;
        *(LAS u32x4*)(lds + RU_KF + off) = pk8(a * wf, b * wf); *(LAS u32x4*)(lds + RU_KB + off) = pk8(a * wb, b * wb); }
#pragma unroll
    for (int j = 0; j < 4; ++j) { const int q = tid + 512 * j, i = q >> 4, vc = q & 15;
        *(LAS u32x4*)(lds + RU_V + (vc >> 2) * 8192 + i * 64 + (vc & 3) * 16) = *(const u32x4*)(RV + (size_t)(r0 + i) * 512 + h * 128 + 8 * vc); }
    RET_BAR();
    const int hh = lane >> 5, r = lane & 31, dir = wave >> 2, pblk = (wave >> 1) & 1, db = 2 * (wave & 1);
    const int lp = ((lane >> 4) & 1) * 32 + (lane & 3) * 8 + (4 * hh + ((lane & 15) >> 2)) * 64;
    const LAS unsigned char* ka = lds + (dir ? RU_KB : RU_KF) + pblk * 8192 + lp; const LAS unsigned char* vb = lds + RU_V + db * 8192 + lp;
    f32x16 acc[2];
#pragma unroll
    for (int i = 0; i < 16; ++i) { acc[0][i] = 0.f; acc[1][i] = 0.f; }
#pragma unroll
    for (int s = 0; s < 8; ++s) { const bf16x8 a = tr_frag(ka + s * 1024, 512);
        acc[0] = __builtin_amdgcn_mfma_f32_32x32x16_bf16(a, tr_frag(vb + s * 1024, 512), acc[0], 0, 0, 0);
        acc[1] = __builtin_amdgcn_mfma_f32_32x32x16_bf16(a, tr_frag(vb + 8192 + s * 1024, 512), acc[1], 0, 0, 0); }
    unsigned char* U = ur_ptr(P, c, h, dir);
#pragma unroll
    for (int d = 0; d < 2; ++d)
#pragma unroll
        for (int i = 0; i < 16; ++i) *(bf16_t*)(U + (size_t)(db + d) * 4096 + (32 * pblk + crow(i, hh)) * 64 + r * 2) = f2bf(acc[d][i]);
    RET_BAR();
}
__device__ __forceinline__ void ret_u_phase(CParams& P, int layer, LAS unsigned char* lds, int wave) {
    const int lane = lane_id(), tid = wave * 64 + lane;
    for (int u = blockIdx.x; u < 768; u += gridDim.x) ret_u_unit(P, layer, lds, u >> 2, u & 3, wave, lane, tid);
}

constexpr int RO_K = 0, RO_V = 16384, RO_RF = 49152, RO_RB = 65536, RO_X = 81920;
__device__ __forceinline__ void ret_out_unit(CParams& P, int layer, LAS unsigned char* lds, int c, int h, int wave, int lane, int tid) {
    const int r0 = chunk_row0(c); const float lgf = log_gamma(P, layer, 0, h), lgb = log_gamma(P, layer, 1, h);
    const bf16_t* RQ = ws_bf(P, WS_RQ); const bf16_t* RK = ws_bf(P, WS_RK); const bf16_t* RV = ws_bf(P, WS_RV);
#pragma unroll
    for (int j = 0; j < 2; ++j) { const int q = tid + 512 * j, i = q >> 3, pc = q & 7;
        *(LAS u32x4*)(lds + RO_K + pc * 2048 + i * 16) = *(const u32x4*)(RK + (size_t)(r0 + i) * 256 + h * 64 + 8 * pc); }
#pragma unroll
    for (int j = 0; j < 4; ++j) { const int q = tid + 512 * j, i = q >> 4, vc = q & 15;
        *(LAS u32x4*)(lds + RO_V + (vc >> 2) * 8192 + i * 64 + (vc & 3) * 16) = *(const u32x4*)(RV + (size_t)(r0 + i) * 512 + h * 128 + 8 * vc); }
    { const unsigned char* Rf = ur_ptr(P, c, h, 0); const unsigned char* Rb = ur_ptr(P, c, h, 1);
#pragma unroll
      for (int j = 0; j < 2; ++j) { const int q = tid + 512 * j; *(LAS u32x4*)(lds + RO_RF + q * 16) = *(const u32x4*)(Rf + q * 16); *(LAS u32x4*)(lds + RO_RB + q * 16) = *(const u32x4*)(Rb + q * 16); } }
    RET_BAR();
    const int hh = lane >> 5, r = lane & 31, ib = wave & 3, dvh = wave >> 2;
    const int ii = 32 * ib + r, row = r0 + ii;
    bf16x8 qf[4], qwf[4], qwb[4];
    { const float wf = __expf(lgf * (float)(ii + 1)), wb = __expf(lgb * (float)(128 - ii)); const bf16_t* q = RQ + (size_t)row * 256 + h * 64 + 8 * hh;
#pragma unroll
      for (int s = 0; s < 4; ++s) { const u32x4 raw = *(const u32x4*)(q + 16 * s); qf[s] = __builtin_bit_cast(bf16x8, raw); const f32x4 a = unpk_lo(raw), b = unpk_hi(raw);
          qwf[s] = __builtin_bit_cast(bf16x8, pk8(a * wf, b * wf)); qwb[s] = __builtin_bit_cast(bf16x8, pk8(a * wb, b * wb)); } }
    f32x16 acc[2];
#pragma unroll
    for (int i = 0; i < 16; ++i) { acc[0][i] = 0.f; acc[1][i] = 0.f; }
    { const int lpn = ((lane >> 4) & 1) * 32 + (lane & 3) * 8 + (8 * hh + ((lane & 15) >> 2)) * 64;
#pragma unroll
      for (int d = 0; d < 2; ++d) { const LAS unsigned char* rf = lds + RO_RF + (2 * dvh + d) * 4096 + lpn; const LAS unsigned char* rb = lds + RO_RB + (2 * dvh + d) * 4096 + lpn;
#pragma unroll
          for (int s = 0; s < 4; ++s) { acc[d] = __builtin_amdgcn_mfma_f32_32x32x16_bf16(tr_frag(rf + s * 1024, 256), qwf[s], acc[d], 0, 0, 0);
              acc[d] = __builtin_amdgcn_mfma_f32_32x32x16_bf16(tr_frag(rb + s * 1024, 256), qwb[s], acc[d], 0, 0, 0); } } }
    { const LAS unsigned char* kb = lds + RO_K + hh * 2048 + r * 16;
      const int lpp = ((lane >> 4) & 1) * 32 + (lane & 3) * 8 + (4 * hh + ((lane & 15) >> 2)) * 64;
#pragma unroll
      for (int jb = 0; jb < 4; ++jb) {
          f32x16 st;
#pragma unroll
          for (int i = 0; i < 16; ++i) st[i] = 0.f;
#pragma unroll
          for (int s = 0; s < 4; ++s) st = __builtin_amdgcn_mfma_f32_32x32x16_bf16(*(const LAS bf16x8*)(kb + s * 4096 + jb * 512), qf[s], st, 0, 0, 0);
#pragma unroll
          for (int i = 0; i < 16; ++i) { const int j = 32 * jb + crow(i, hh); const int dl = ii - j;
              const float D = dl > 0 ? __expf(lgf * (float)dl) : (dl < 0 ? __expf(lgb * (float)(-dl)) : 2.f); st[i] *= D; }
          u32x4 pw0, pw1;
#pragma unroll
          for (int j = 0; j < 4; ++j) { pw0[j] = pk2(st[2 * j], st[2 * j + 1]); pw1[j] = pk2(st[8 + 2 * j], st[8 + 2 * j + 1]); }
#pragma unroll
          for (int d = 0; d < 2; ++d) { const LAS unsigned char* vb = lds + RO_V + (2 * dvh + d) * 8192 + lpp + jb * 2048;
              acc[d] = __builtin_amdgcn_mfma_f32_32x32x16_bf16(tr_frag(vb, 512), __builtin_bit_cast(bf16x8, pw0), acc[d], 0, 0, 0);
              acc[d] = __builtin_amdgcn_mfma_f32_32x32x16_bf16(tr_frag(vb + 1024, 512), __builtin_bit_cast(bf16x8, pw1), acc[d], 0, 0, 0); }
      } }
    LAS float* X = (LAS float*)(lds + RO_X);
    float s = 0.f;
#pragma unroll
    for (int i = 0; i < 16; ++i) s += acc[0][i] + acc[1][i];
    s = sum_halves(s); if (hh == 0) X[dvh * 128 + ii] = s;
    RET_BAR();
    const float mu = (X[ii] + X[128 + ii]) * (1.f / 128.f);
    float v = 0.f;
#pragma unroll
    for (int i = 0; i < 16; ++i) { const float a = acc[0][i] - mu, b = acc[1][i] - mu; v += a * a + b * b; }
    v = sum_halves(v);
    RET_BAR();
    if (hh == 0) X[dvh * 128 + ii] = v;
    RET_BAR();
    const float rs = 1.0f / sqrtf((X[ii] + X[128 + ii]) * (1.f / 128.f) + EPS);
    const float* gn_ = P.in[I_RNG] + (layer >> 1) * 512 + h * 128; bf16_t* G = ws_bf(P, WS_G) + (size_t)row * 1024 + 512 + h * 128;
#pragma unroll
    for (int d = 0; d < 2; ++d)
#pragma unroll
        for (int a = 0; a < 4; ++a) { const int dv = 32 * (2 * dvh + d) + 8 * a + 4 * hh; const f32x4 gv = *(const f32x4*)(gn_ + dv); const u32x2 gg = *(const u32x2*)(G + dv);
            const float g0 = __uint_as_float(gg.x << 16), g1 = __uint_as_float(gg.x & 0xffff0000u), g2 = __uint_as_float(gg.y << 16), g3 = __uint_as_float(gg.y & 0xffff0000u);
            u32x2 w; w.x = pk2((acc[d][4 * a] - mu) * rs * gv[0] * g0, (acc[d][4 * a + 1] - mu) * rs * gv[1] * g1); w.y = pk2((acc[d][4 * a + 2] - mu) * rs * gv[2] * g2, (acc[d][4 * a + 3] - mu) * rs * gv[3] * g3);
            *(u32x2*)(G + dv) = w; }
    RET_BAR();
}
__device__ __forceinline__ void ret_out_phase(CParams& P, int layer, LAS unsigned char* lds, int wave) {
    const int lane = lane_id(), tid = wave * 64 + lane;
    for (int u = blockIdx.x; u < 768; u += gridDim.x) ret_out_unit(P, layer, lds, u >> 2, u & 3, wave, lane, tid);
}
typedef __attribute__((address_space(1))) unsigned gu32;
#define XB_TMO      128
#define XB_XCNT(j)  (256  + 64 * (j))
#define XB_XSUB(j)  (1280 + 64 * (j))
#define XB_XGEN(j)  (2304 + 64 * (j))
#define XB_TOP      3328
#define XB_TOPGEN   3392
#define XCD_BAR_WORDS 3456
#define XB_SPIN_CAP (1u << 26)
__device__ __forceinline__ unsigned xb_ld(unsigned* p)              { return __hip_atomic_load(p, __ATOMIC_RELAXED, __HIP_MEMORY_SCOPE_AGENT); }
__device__ __forceinline__ unsigned xb_add(unsigned* p, unsigned v) { return __hip_atomic_fetch_add(p, v, __ATOMIC_RELAXED, __HIP_MEMORY_SCOPE_AGENT); }
__device__ __forceinline__ unsigned xb_xcc_id() { return (unsigned)__builtin_amdgcn_s_getreg((3 << 11) | 20) & 0xFu; }
#define XB_SPIN(cond, bar) do { unsigned _sp = 0; while (cond) { __builtin_amdgcn_s_sleep(1); \
    if ((++_sp & 255u) == 0u) { if (xb_ld(&(bar)[XB_TMO])) break; if (_sp > XB_SPIN_CAP) { atomicAdd(&(bar)[XB_TMO], 1u); break; } } } } while (0)
struct XcdBarrier { unsigned* bar; unsigned x; volatile LAS unsigned* st; };
__device__ __forceinline__ XcdBarrier xcd_barrier_post(unsigned* bar, volatile LAS unsigned* st, bool t0) {
    XcdBarrier b; b.bar = bar; b.x = xb_xcc_id(); b.st = st;
    if (t0) (void)xb_add(&bar[XB_XCNT(b.x)], 1u);
    return b;
}
__device__ __forceinline__ void xcd_barrier_complete(unsigned* bar, unsigned x, unsigned& nloc, unsigned& nx) {
    const unsigned G = gridDim.x * gridDim.y * gridDim.z;
    unsigned sum, cnt, mine, sp = 0u;
    for (;;) {
        sum = 0u; cnt = 0u; mine = 0u;
#pragma unroll
        for (unsigned j = 0; j < 16; ++j) { const unsigned c = xb_ld(&bar[XB_XCNT(j)]); sum += c; cnt += (c > 0u) ? 1u : 0u; mine = (j == x) ? c : mine; }
        if (sum == G) break;
        __builtin_amdgcn_s_sleep(1);
        if ((++sp & 255u) == 0u) { if (xb_ld(&bar[XB_TMO])) break; if (sp > XB_SPIN_CAP) { atomicAdd(&bar[XB_TMO], 1u); break; } }
    }
    nloc = mine > 0u ? mine : 1u; nx = cnt > 0u ? cnt : 1u;
}
__device__ __forceinline__ void xcd_barrier(const XcdBarrier& b, bool t0) {
    asm volatile("s_waitcnt vmcnt(0)" ::: "memory");
    __syncthreads();
    if (t0) {
        unsigned* bar = b.bar;
        __builtin_amdgcn_s_waitcnt(0);
        unsigned nloc = b.st[0], nx = b.st[1];
        if (nloc == 0u) { xcd_barrier_complete(bar, b.x, nloc, nx); b.st[0] = nloc; b.st[1] = nx; }
        const unsigned old = xb_add(&bar[XB_XSUB(b.x)], 1u);
        const unsigned gen = old / nloc;
        if (old + 1u == (gen + 1u) * nloc) {
            __builtin_amdgcn_fence(__ATOMIC_RELEASE, "agent");
            asm volatile("s_waitcnt vmcnt(0)" ::: "memory");
            const unsigned og = xb_add(&bar[XB_TOP], 1u);
            const unsigned tg = og / nx;
            if (og + 1u == (tg + 1u) * nx) xb_add(&bar[XB_TOPGEN], 1u);
            else XB_SPIN(xb_ld(&bar[XB_TOPGEN]) == tg, bar);
            __builtin_amdgcn_fence(__ATOMIC_ACQUIRE, "agent");
            xb_add(&bar[XB_XGEN(b.x)], 1u);
            asm volatile("s_waitcnt vmcnt(0)" ::: "memory");
        } else {
            XB_SPIN(xb_ld(&bar[XB_XGEN(b.x)]) == gen, bar);
            __builtin_amdgcn_fence(__ATOMIC_ACQUIRE, "agent");
            asm volatile("s_waitcnt vmcnt(0)" ::: "memory");
        }
    }
    __syncthreads();
}

#ifndef FAST_OUT
#define FAST_OUT 1
#endif
#ifndef FAST_IN_ODD
#define FAST_IN_ODD 1
#endif
#ifndef FAST_IN_EVEN
#define FAST_IN_EVEN 1
#endif
#ifndef FAST_UQ
#define FAST_UQ 1
#endif
#ifndef FAST_UKV
#define FAST_UKV 1
#endif
#ifndef FAST_MLA
#define FAST_MLA 1
#endif
#ifndef FAST_WIN
#define FAST_WIN 1
#endif
#ifndef FAST_RETU
#define FAST_RETU 1
#endif
#ifndef FAST_RETO
#define FAST_RETO 1
#endif

enum { K_P0 = 0, K_P1, K_E_IN, K_E_POST, K_E_UQ, K_E_UQSS, K_E_UKV, K_E_KPOST, K_E_SCAN, K_E_ATTN, K_E_OUT, K_E_PREPA, K_O_IN, K_O_POST, K_O_ATTN, K_O_OUT, K_O_PREPA };
template <int KIND, int LAYER> __device__ __forceinline__ void run_phase(LAS unsigned char* L, int wave_s) {
    constexpr int kind = KIND, layer = LAYER;
    CParams* Pq = params_ptr();
#define P (*Pq)
    int ws_ = wave_s; asm volatile("" : "+s"(ws_)); int ln_ = lane_id(); asm volatile("" : "+v"(ln_));
    const int wave = ws_, lane = ln_, tid = wave * 64 + lane;
    const int G = gridDim.x; const long gn = (long)G * NTHREADS, gt = (long)blockIdx.x * NTHREADS + tid; const int gw = blockIdx.x * NWAVES + wave, ngw = G * NWAVES;
    LAS float* wscr = (LAS float*)(L + wave * 16384);
    LAS float* xch = (LAS float*)(L + EPI_OFF);
    (void)lane; (void)gw; (void)ngw; (void)gt; (void)gn; (void)wscr; (void)xch;
    if constexpr (kind == K_P0) {
        nv_zero_bnd(P, 0, gt, gn); nv_mod(P, 0, gt, gn); prep_layer_weights(P, 0, wscr, gw, ngw, lane); nv_ctx_even(P, 0, gt, gn);
    } else if constexpr (kind == K_P1) {
        nv_gs(P, 0, gt, gn); nv_bias(P, 0, gt, gn); fast_biasL(P, gt, gn); nv_prepA(P, 0, gt, gn);
    } else if constexpr (kind == K_E_IN) {
#if FAST_IN_EVEN
        pg8::Gemm g{ws_bf(P, WS_AEVEN), ws_bf(P, WS_WIN), MROWS, 2816, 1024, 1024}; pg8::StaticOrder S; S.init(MROWS, 2816, G, (int)blockIdx.x);
        EpiIn<false> E{Pq, layer, xch}; pg8::gemm_phase<EpiIn<false>, pg8::StaticOrder, true, true>(L, g, S, E, wave_s);
#else
        nv_in_even(P, layer, gt, gn);
#endif
    } else if constexpr (kind == K_E_POST) { nv_post_even(P, layer, gt, gn);
    } else if constexpr (kind == K_E_UQ) {
#if FAST_UQ
        pg8::Gemm g{ws_bf(P, WS_CQ), ws_bf(P, WS_WUQ), MROWS, 768, 384, 384}; pg8::StaticOrder S; S.init(MROWS, 768, G, (int)blockIdx.x);
        EpiUq E{Pq, layer}; pg8::gemm_phase<EpiUq, pg8::StaticOrder, true, true>(L, g, S, E, wave_s);
#else
        nv_uq(P, layer, gt, gn);
#endif
    } else if constexpr (kind == K_E_UQSS) { nv_uq_ss(P, layer, gt, gn);
    } else if constexpr (kind == K_E_UKV) {
#if FAST_UKV
        { pg8::Gemm g{ws_bf(P, WS_CKVN), ws_bf(P, WS_WUKV), MROWS_X, 1024, 256, 256}; pg8::StaticOrder S; S.init(MROWS_X, 1024, G, (int)blockIdx.x);
          EpiUkv E{Pq, layer}; pg8::gemm_phase<EpiUkv, pg8::StaticOrder, true, true>(L, g, S, E, wave_s); }
#else
        nv_ukv(P, layer, gt, gn);
#endif
#if FAST_RETU
        ret_u_phase(P, layer, L, wave);
#else
        nv_u(P, layer, gt, gn);
#endif
    } else if constexpr (kind == K_E_KPOST) { nv_k_post(P, layer, gt, gn);
    } else if constexpr (kind == K_E_SCAN) { nv_scan(P, layer, gt, gn);
    } else if constexpr (kind == K_E_ATTN) {
#if FAST_MLA
        mla_phase(P, layer, L, wave);
#else
        nv_mla_attn(P, layer, gt, gn);
#endif
#if FAST_RETO
        ret_out_phase(P, layer, L, wave);
#else
        nv_ret_out(P, layer, gt, gn);
#endif
    } else if constexpr (kind == K_O_IN) {
#if FAST_IN_ODD
        pg8::Gemm g{ws_bf(P, WS_AODD), ws_bf(P, WS_WIN), MROWS, 2560, 1024, 1024}; pg8::StaticOrder S; S.init(MROWS, 2560, G, (int)blockIdx.x);
        EpiIn<true> E{Pq, layer, xch}; pg8::gemm_phase<EpiIn<true>, pg8::StaticOrder, true, true>(L, g, S, E, wave_s);
#else
        nv_in_odd(P, layer, gt, gn);
#endif
    } else if constexpr (kind == K_O_POST) { nv_post_odd(P, layer, gt, gn);
    } else if constexpr (kind == K_O_ATTN) {
#if FAST_WIN
        win_phase(P, layer, L, wave);
#else
        nv_win_attn(P, layer, gt, gn);
#endif
    } else if constexpr (kind == K_E_OUT || kind == K_O_OUT) {
        if constexpr (layer < 3) { prep_layer_weights(P, layer + 1, wscr, gw, ngw, lane); if constexpr ((layer + 1) & 1) nv_ctx_odd(P, layer + 1, gt, gn); else nv_ctx_even(P, layer + 1, gt, gn); }
        __syncthreads();
#if FAST_OUT
        pg8::Gemm g{ws_bf(P, WS_G), ws_bf(P, (layer & 1) ? WS_WOUT1 : WS_WOUT0), MROWS, 1024, 1024, 1024}; pg8::StaticOrder S; S.init(MROWS, 1024, G, (int)blockIdx.x);
        EpiOut E{Pq, layer}; pg8::gemm_phase<EpiOut, pg8::StaticOrder, true, true>(L, g, S, E, wave_s);
#else
        nv_out(P, layer, gt, gn);
#endif
    } else {   nv_prepA(P, layer + 1, gt, gn); }
#undef P
}
__device__ __forceinline__ void grid_bar(volatile LAS unsigned* MISC, int wave_s) {
    CParams* Pb = params_ptr(); XcdBarrier bar; bar.bar = (unsigned*)(Pb->ws + WS_CTL) + 4096; bar.x = xb_xcc_id(); bar.st = MISC + 8; xcd_barrier(bar, wave_s == 0 && lane_id() == 0);
}
#define PH(kind, layer) do { run_phase<kind, layer>(L, wave_s); grid_bar(MISC, wave_s); } while (0)
template <int LAYER> __device__ __forceinline__ void even_layer(LAS unsigned char* L, volatile LAS unsigned* MISC, int wave_s) {
    PH(K_E_IN, LAYER);
    if constexpr (!FAST_IN_EVEN) PH(K_E_POST, LAYER);
    PH(K_E_UQ, LAYER);
    if constexpr (!FAST_UQ) PH(K_E_UQSS, LAYER);
    PH(K_E_UKV, LAYER);
    if constexpr (!FAST_UKV) PH(K_E_KPOST, LAYER);
    PH(K_E_SCAN, LAYER);
    PH(K_E_ATTN, LAYER);
    PH(K_E_OUT, LAYER);
    if constexpr (!FAST_OUT) PH(K_E_PREPA, LAYER);
}
template <int LAYER> __device__ __forceinline__ void odd_layer(LAS unsigned char* L, volatile LAS unsigned* MISC, int wave_s) {
    PH(K_O_IN, LAYER);
    if constexpr (!FAST_IN_ODD) PH(K_O_POST, LAYER);
    PH(K_O_ATTN, LAYER);
    if constexpr (LAYER == 3) { run_phase<K_O_OUT, LAYER>(L, wave_s); }
    else { PH(K_O_OUT, LAYER); if constexpr (!FAST_OUT) PH(K_O_PREPA, LAYER); }
}
__global__ void __launch_bounds__(NTHREADS, 2) mk_fwd(Params P_) {
    extern __shared__ __attribute__((aligned(16))) unsigned char lds[];
    LAS unsigned char* L = (LAS unsigned char*)lds;
    volatile LAS unsigned* MISC = (volatile LAS unsigned*)(L + MISC_OFF);
    const int wave_s = __builtin_amdgcn_readfirstlane(threadIdx.x >> 6);
    if (wave_s == 0 && lane_id() < 32) MISC[lane_id()] = 0u;
    __syncthreads();
    { CParams* P0 = params_ptr(); (void)xcd_barrier_post((unsigned*)(P0->ws + WS_CTL) + 4096, MISC + 8, wave_s == 0 && lane_id() == 0); }
    PH(K_P0, 0); PH(K_P1, 0);
    even_layer<0>(L, MISC, wave_s); odd_layer<1>(L, MISC, wave_s); even_layer<2>(L, MISC, wave_s); odd_layer<3>(L, MISC, wave_s);
}
extern "C" void kernel_launch(void* const* d_in, const int* in_sizes, int n_in, void* d_out, int out_size, void* d_ws, size_t ws_size, hipStream_t stream) {
    if (n_in != N_INPUTS || ws_size < WS_END || (size_t)out_size != O_END) { fprintf(stderr, "kernel_launch: unexpected shapes (n_in %d, out %d, ws %zu)\n", n_in, out_size, ws_size); return; }
    static int grid = 0;
    if (grid == 0) {
        int dev = 0, cus = 0;
        if (hipGetDevice(&dev) != hipSuccess || hipDeviceGetAttribute(&cus, hipDeviceAttributeMultiprocessorCount, dev) != hipSuccess) { grid = -1; return; }
        if (hipFuncSetAttribute((const void*)mk_fwd, hipFuncAttributeMaxDynamicSharedMemorySize, LDS_BYTES) != hipSuccess) { grid = -1; return; }
        grid = cus;
    }
    if (grid < 0) return;
    (void)hipMemsetAsync((char*)d_ws + WS_CTL, 0, 1 * MiB, stream);
    Params P{};
    for (int i = 0; i < N_INPUTS; ++i) P.in[i] = (const float*)d_in[i];
    P.out = (float*)d_out; P.ws = (unsigned char*)d_ws; P.ph_lo = 0; P.ph_hi = 0;
    hipLaunchKernelGGL(mk_fwd, dim3(grid), dim3(NTHREADS), LDS_BYTES, stream, P);
}
```

```cpp
#include <hip/hip_runtime.h>
#include <cstdio>
#include <cstdint>

constexpr int DM = 1024;
constexpr int NP_ROWS = 32 * 256;
constexpr int NS_ROWS = 4 * 4096;
constexpr int MROWS = NP_ROWS + NS_ROWS;
constexpr int CTX_ROWS = 4 * 512;
constexpr int MROWS_X = MROWS + CTX_ROWS;
constexpr float EPS = 1e-6f;
constexpr float LOG2E = 1.4426950408889634f;
constexpr int AB_IN = 2720, WIN_IN = 2560;

enum { I_XP = 0, I_XS, I_C0CKV, I_C0KR, I_S0F, I_S0B, I_C1K, I_C1V, I_C2CKV, I_C2KR, I_S2F, I_S2B, I_C3K, I_C3V, I_C, I_CCTX, I_ADAW, I_ADAB, I_NORMG,
       I_ABWIN, I_QNG, I_WUQ, I_KVNG, I_WUKV, I_QHG, I_KHG, I_DECAY, I_RNG, I_ABWOUT, I_WWIN, I_WQHG, I_WKHG, I_SINK, I_WWOUT, N_INPUTS };

constexpr size_t O_Y = 0;
constexpr size_t O_L0CKV = (size_t)MROWS * DM;
constexpr size_t O_L0KR = O_L0CKV + (size_t)NP_ROWS * 256;
constexpr size_t O_L0RF = O_L0KR + (size_t)NP_ROWS * 32;
constexpr size_t O_L0RB = O_L0RF + (size_t)32 * 4 * 64 * 128;
constexpr size_t O_L1K = O_L0RB + (size_t)32 * 4 * 64 * 128;
constexpr size_t O_L1V = O_L1K + (size_t)NP_ROWS * 256;
constexpr size_t O_L2CKV = O_L1V + (size_t)NP_ROWS * 256;
constexpr size_t O_L2KR = O_L2CKV + (size_t)NP_ROWS * 256;
constexpr size_t O_L2RF = O_L2KR + (size_t)NP_ROWS * 32;
constexpr size_t O_L2RB = O_L2RF + (size_t)32 * 4 * 64 * 128;
constexpr size_t O_L3K = O_L2RB + (size_t)32 * 4 * 64 * 128;
constexpr size_t O_L3V = O_L3K + (size_t)NP_ROWS * 256;
constexpr size_t O_END = O_L3V + (size_t)NP_ROWS * 256;

constexpr size_t MiB = 1u << 20;
constexpr size_t WS_CTL = 0;
constexpr size_t WS_MOD = 1 * MiB;
constexpr size_t WS_GS = WS_MOD + 4 * 5 * 3072 * 4;
constexpr size_t WS_BIAS = WS_GS + 4 * 5 * 1024 * 4;
constexpr size_t WS_BIASL = WS_BIAS + 4 * 5 * 2816 * 4;
constexpr size_t WS_SS = WS_BIASL + 4 * 5 * 2816 * 4;
constexpr size_t WS_SSCQ = WS_SS + (size_t)MROWS * 16 * 4;
constexpr size_t WS_SSKR = WS_SSCQ + (size_t)MROWS * 8 * 4;
constexpr size_t WS_SSQN = WS_SSKR + (size_t)MROWS_X * 4;
constexpr size_t WS_SSQR = WS_SSQN + (size_t)MROWS * 8 * 4;
constexpr size_t WS_ROPE8 = WS_SSQR + (size_t)MROWS * 8 * 4;
constexpr size_t WS_ROPE16 = WS_ROPE8 + 64 * 8 * 2 * 4;
constexpr size_t WS_BND = WS_ROPE16 + 64 * 16 * 2 * 4;
constexpr size_t WS_MISC_END = WS_BND + 256;
static_assert(WS_MISC_END <= 6 * MiB, "misc region");
constexpr size_t WS_WIN = 6 * MiB;
constexpr size_t WS_WUQ = WS_WIN + (size_t)2816 * 1024 * 2;
constexpr size_t WS_WUKV = WS_WUQ + (size_t)768 * 384 * 2;
constexpr size_t WS_WOUT0 = WS_WUKV + (size_t)1024 * 256 * 2;
constexpr size_t WS_WOUT1 = WS_WOUT0 + (size_t)1024 * 1024 * 2;
constexpr size_t WS_W_END = WS_WOUT1 + (size_t)1024 * 1024 * 2;
static_assert(WS_W_END <= 17 * MiB, "weight region");
constexpr size_t WS_G = 17 * MiB;
constexpr size_t WS_X = WS_G + 48 * MiB;
constexpr size_t WS_RQ = WS_X, WS_RK = WS_X + 12 * MiB, WS_RV = WS_X + 24 * MiB, WS_QW = WS_X;
constexpr size_t WS_Q = WS_X + 48 * MiB;
constexpr size_t WS_QR = WS_Q, WS_CQ = WS_Q + 36 * MiB, WS_AODD = WS_Q;
constexpr size_t WS_URS = WS_CQ;
constexpr size_t WS_CKVN = WS_Q + 54 * MiB;
constexpr size_t WS_KR = WS_CKVN + 13 * MiB;
constexpr size_t WS_KV = WS_KR + (size_t)MROWS_X * 32 * 2;
constexpr size_t WS_KIMG = WS_KV, WS_VIMG = WS_KV + 39 * MiB, WS_AEVEN = WS_KV;
constexpr size_t WS_KWIMG = WS_KV + 39 * MiB, WS_VWIMG = WS_KV + 52 * MiB;
constexpr size_t WS_URP = WS_KV + 65 * MiB;
constexpr size_t WS_END = WS_URP + 8 * MiB;
static_assert(WS_END <= 256 * MiB, "workspace map exceeds 256 MiB");

typedef unsigned short bf16_t;

struct Params {
    const float* in[N_INPUTS];
    float* out;
    unsigned char* ws;
    int ph_lo, ph_hi;
};

typedef const __attribute__((address_space(4))) Params CParams;
__device__ __forceinline__ CParams* params_ptr() { CParams* p = (CParams*)__builtin_amdgcn_kernarg_segment_ptr(); asm volatile("" : "+s"(p)); return p; }

__device__ __forceinline__ float bf2f(bf16_t b) { return __uint_as_float((unsigned)b << 16); }
__device__ __forceinline__ bf16_t f2bf(float f) { unsigned u = __float_as_uint(f); return (bf16_t)((u + 0x7fffu + ((u >> 16) & 1u)) >> 16); }
__device__ __forceinline__ float bfr(float f) { return bf2f(f2bf(f)); }
__device__ __forceinline__ float silu_f(float x) { return x / (1.f + __expf(-x)); }

__device__ __forceinline__ int p2d64(int p) { return 32 * ((p >> 3) & 1) + 16 * ((p >> 2) & 1) + 4 * (p >> 4) + (p & 3); }
__device__ __forceinline__ int d2p64(int d) { return 16 * ((d >> 2) & 3) + 8 * (d >> 5) + 4 * ((d >> 4) & 1) + (d & 3); }
__device__ __forceinline__ int o2j32(int o) { const int grp = o >> 3, w = o & 7; return 16 * (grp >> 1) + 4 * (grp & 1) + (w & 3) + 8 * (w >> 2); }
__device__ __forceinline__ int j2o32(int j) { return 8 * (2 * (j >> 4) + ((j >> 2) & 1)) + 4 * ((j >> 3) & 1) + (j & 3); }

struct RowInfo { int cond; int b; int t; bool sample; };
__device__ __forceinline__ RowInfo row_info(int row) {
    RowInfo r;
    if (row < NP_ROWS) { r.cond = 4; r.b = row >> 8; r.t = row & 255; r.sample = false; }
    else { const int rs = row - NP_ROWS; r.b = rs >> 12; r.t = rs & 4095; r.cond = r.b; r.sample = true; }
    return r;
}
__device__ __forceinline__ int kv_tile(int R, int head, int H, int& kin) {
    if (R < NP_ROWS) { const int b = R >> 8, key = R & 255; kin = key & 63; return (b * H + head) * 4 + (key >> 6); }
    int b, key;
    if (R < MROWS) { const int rs = R - NP_ROWS; b = rs >> 12; key = 512 + (rs & 4095); }
    else { const int rc = R - MROWS; b = rc >> 9; key = rc & 511; }
    kin = key & 63; return 32 * H * 4 + (b * H + head) * 72 + (key >> 6);
}
__device__ __forceinline__ int kv_seq_tile0(bool sample, int b, int head, int H) { return sample ? 32 * H * 4 + (b * H + head) * 72 : (b * H + head) * 4; }

template <int K> __device__ __forceinline__ float xor_shfl(float v) { static_assert(K < 32, "xor_shfl"); return __int_as_float(__builtin_amdgcn_ds_swizzle(__float_as_int(v), (K << 10) | 0x1f)); }
__device__ __forceinline__ float sum_halves(float v) { auto r = __builtin_amdgcn_permlane32_swap(__float_as_uint(v), __float_as_uint(v), false, false); return __uint_as_float(r[0]) + __uint_as_float(r[1]); }
__device__ __forceinline__ float wave_sum(float v) { v += xor_shfl<1>(v); v += xor_shfl<2>(v); v += xor_shfl<4>(v); v += xor_shfl<8>(v); v += xor_shfl<16>(v); return sum_halves(v); }

__device__ __forceinline__ int lane_id() { int l; asm volatile("v_mbcnt_lo_u32_b32 %0, -1, 0\n\tv_mbcnt_hi_u32_b32 %0, -1, %0" : "=v"(l)); return l; }

#define NVF(name) __device__ void name(CParams& P, int layer, long gt, long gn)

__device__ __forceinline__ const float* cond_vec(CParams& P, int c) { return c < 4 ? P.in[I_C] + c * 1024 : P.in[I_CCTX]; }
__device__ __forceinline__ float* ws_f32(CParams& P, size_t off) { return (float*)(P.ws + off); }
__device__ __forceinline__ bf16_t* ws_bf(CParams& P, size_t off) { return (bf16_t*)(P.ws + off); }
__device__ __forceinline__ const float* y_row(CParams& P, int layer, int row) {
    if (layer == 0) return row < NP_ROWS ? P.in[I_XP] + (size_t)row * DM : P.in[I_XS] + (size_t)(row - NP_ROWS) * DM;
    return P.out + (size_t)row * DM;
}
__device__ __forceinline__ float log_gamma(CParams& P, int layer, int dir, int head) { return -__expf(P.in[I_DECAY][(layer >> 1) * 8 + dir * 4 + head]); }

NVF(nv_mod) {
    float* mod = ws_f32(P, WS_MOD);
    for (long i = gt; i < 4L * 5 * 3072; i += gn) {
        const int j = (int)(i % 3072), c = (int)((i / 3072) % 5), l = (int)(i / (3072 * 5));
        const float* cv = cond_vec(P, c); const float* w = P.in[I_ADAW] + (size_t)l * 1024 * 3072 + j;
        float s = 0.f;
        for (int k = 0; k < 1024; ++k) s += silu_f(cv[k]) * w[(size_t)k * 3072];
        mod[i] = s + P.in[I_ADAB][l * 3072 + j];
    }
    float* r8 = ws_f32(P, WS_ROPE8); float* r16 = ws_f32(P, WS_ROPE16);
    for (long i = gt; i < 64 * 8; i += gn) { const int pos = (int)(i >> 3), f = (int)(i & 7); const float inv = powf(10000.f, -(float)f / 8.f), a = (float)pos * inv; r8[2 * i] = cosf(a); r8[2 * i + 1] = sinf(a); }
    for (long i = gt; i < 64 * 16; i += gn) { const int pos = (int)(i >> 4), f = (int)(i & 15); const float inv = powf(10000.f, -(float)f / 16.f), a = (float)pos * inv; r16[2 * i] = cosf(a); r16[2 * i + 1] = sinf(a); }
}
NVF(nv_gs) {
    float* gs = ws_f32(P, WS_GS); const float* mod = ws_f32(P, WS_MOD);
    for (long i = gt; i < 4L * 5 * 1024; i += gn) { const int k = (int)(i & 1023), c = (int)((i >> 10) % 5), l = (int)(i / 5120); gs[i] = P.in[I_NORMG][l * 1024 + k] * (1.f + mod[(l * 5 + c) * 3072 + 1024 + k]); }
    if (gt == 0) {
        float* bnd = ws_f32(P, WS_BND);
        for (int i = 0; i < 2; ++i) {
            float mq = 0.f, mk = 0.f; for (int d = 0; d < 96; ++d) { mq = fmaxf(mq, fabsf(P.in[I_QHG][i * 96 + d])); mk = fmaxf(mk, fabsf(P.in[I_KHG][i * 96 + d])); }
            bnd[i] = sqrtf(96.f) * LOG2E * mq * mk;
        }
        for (int i = 0; i < 2; ++i) {
            float mq = 0.f, mk = 0.f; for (int d = 0; d < 64; ++d) { mq = fmaxf(mq, fabsf(P.in[I_WQHG][i * 64 + d])); mk = fmaxf(mk, fabsf(P.in[I_WKHG][i * 64 + d])); }
            bnd[8 + i] = mq; bnd[10 + i] = mk;
        }
    }
}
NVF(nv_bias) {
    float* bias = ws_f32(P, WS_BIAS); const float* mod = ws_f32(P, WS_MOD);
    for (long i = gt; i < 4L * 5 * 2816; i += gn) {
        const int col = (int)(i % 2816), c = (int)((i / 2816) % 5), l = (int)(i / (2816 * 5));
        const int N = (l & 1) ? WIN_IN : AB_IN; float s = 0.f;
        if (col < N) { const float* w = ((l & 1) ? P.in[I_WWIN] : P.in[I_ABWIN]) + (size_t)(l >> 1) * 1024 * N + col; const float* sh = mod + (l * 5 + c) * 3072;
            for (int k = 0; k < 1024; ++k) s += sh[k] * w[(size_t)k * N]; }
        bias[i] = s;
    }
}
NVF(nv_prepA) {
    bf16_t* A = ws_bf(P, (layer & 1) ? WS_AODD : WS_AEVEN); float* SS = ws_f32(P, WS_SS);
    const float* mod = ws_f32(P, WS_MOD);
    for (long row = gt; row < MROWS; row += gn) {
        const RowInfo ri = row_info((int)row); const float* y = y_row(P, layer, (int)row);
        const float* sc = mod + (layer * 5 + ri.cond) * 3072 + 1024; const float* g = P.in[I_NORMG] + layer * 1024;
        float s = 0.f;
        for (int k = 0; k < 1024; ++k) { const float v = y[k]; s += v * v; A[(size_t)row * 1024 + k] = f2bf(v * g[k] * (1.f + sc[k])); }
        SS[row * 16] = s; for (int j = 1; j < 16; ++j) SS[row * 16 + j] = 0.f;
    }
}
__device__ __forceinline__ float row_rstd(const float* SS, int row) { float s = 0.f; for (int j = 0; j < 16; ++j) s += SS[row * 16 + j]; return 1.0f / sqrtf(s * (1.f / 1024.f) + EPS); }

NVF(nv_in_even) {
    const bf16_t* A = ws_bf(P, WS_AEVEN); const float* SS = ws_f32(P, WS_SS); const float* W = P.in[I_ABWIN] + (size_t)(layer >> 1) * 1024 * AB_IN;
    const float* bias = ws_f32(P, WS_BIAS);
    bf16_t *CQ = ws_bf(P, WS_CQ), *CKVN = ws_bf(P, WS_CKVN), *KR = ws_bf(P, WS_KR), *G = ws_bf(P, WS_G), *RQ = ws_bf(P, WS_RQ), *RK = ws_bf(P, WS_RK), *RV = ws_bf(P, WS_RV);
    float* okr = P.out + (layer == 0 ? O_L0KR : O_L2KR);
    for (long i = gt; i < (long)(MROWS / 4) * AB_IN; i += gn) {
        const int col = (int)(i % AB_IN), r0 = (int)(i / AB_IN) * 4;
        float acc[4] = {0.f, 0.f, 0.f, 0.f};
        for (int k = 0; k < 1024; ++k) { const float w = bfr(W[(size_t)k * AB_IN + col]);
#pragma unroll
            for (int r = 0; r < 4; ++r) acc[r] += bf2f(A[(size_t)(r0 + r) * 1024 + k]) * w; }
#pragma unroll
        for (int r = 0; r < 4; ++r) {
            const int row = r0 + r; const RowInfo ri = row_info(row);
            const float v = acc[r] * row_rstd(SS, row) + bias[(layer * 5 + ri.cond) * 2816 + col];
            if (col < 384) CQ[(size_t)row * 384 + col] = f2bf(v);
            else if (col < 640) CKVN[(size_t)row * 256 + col - 384] = f2bf(v);
            else if (col < 672) { const int j = col - 640; KR[(size_t)row * 32 + j2o32(j)] = f2bf(v); if (!ri.sample) okr[(size_t)row * 32 + j] = v; }
            else if (col < 1184) G[(size_t)row * 1024 + col - 672] = f2bf(silu_f(v));
            else if (col < 1440) { const int x = col - 1184; RQ[(size_t)row * 256 + (x >> 6) * 64 + d2p64(x & 63)] = f2bf(v); }
            else if (col < 1696) { const int x = col - 1440; RK[(size_t)row * 256 + (x >> 6) * 64 + d2p64(x & 63)] = f2bf(v); }
            else if (col < 2208) RV[(size_t)row * 512 + col - 1696] = f2bf(v);
            else G[(size_t)row * 1024 + 512 + col - 2208] = f2bf(silu_f(v));
        }
    }
}
NVF(nv_post_even) {
    bf16_t *CQ = ws_bf(P, WS_CQ), *CKVN = ws_bf(P, WS_CKVN), *KR = ws_bf(P, WS_KR), *RQ = ws_bf(P, WS_RQ), *RK = ws_bf(P, WS_RK);
    float *sscq = ws_f32(P, WS_SSCQ), *sskr = ws_f32(P, WS_SSKR); const float* r16 = ws_f32(P, WS_ROPE16);
    const float* gkv = P.in[I_KVNG] + (layer >> 1) * 256; float* ockv = P.out + (layer == 0 ? O_L0CKV : O_L2CKV);
    for (long row = gt; row < MROWS; row += gn) {
        const RowInfo ri = row_info((int)row);
        float s = 0.f; for (int k = 0; k < 384; ++k) { const float v = bf2f(CQ[row * 384 + k]); s += v * v; }
        sscq[row * 8] = s; for (int j = 1; j < 8; ++j) sscq[row * 8 + j] = 0.f;
        s = 0.f; for (int k = 0; k < 32; ++k) { const float v = bf2f(KR[row * 32 + k]); s += v * v; }
        sskr[row] = s;
        s = 0.f; for (int k = 0; k < 256; ++k) { const float v = bf2f(CKVN[row * 256 + k]); s += v * v; }
        const float rs = 1.0f / sqrtf(s * (1.f / 256.f) + EPS);
        for (int k = 0; k < 256; ++k) { const float v = bf2f(CKVN[row * 256 + k]) * rs * gkv[k]; CKVN[row * 256 + k] = f2bf(v); if (!ri.sample) ockv[row * 256 + k] = v; }
        const int pr = ri.t >> 6, pc = ri.t & 63;
        for (int a = 0; a < 2; ++a) { bf16_t* X = a ? RK : RQ; const float scl = a ? 1.f : 0.125f;
            for (int h = 0; h < 4; ++h) for (int half = 0; half < 2; ++half) for (int f = 0; f < 16; ++f) {
                const int d1 = 32 * half + f, d2 = d1 + 16; bf16_t* p1 = X + row * 256 + h * 64 + d2p64(d1); bf16_t* p2 = X + row * 256 + h * 64 + d2p64(d2);
                float x1 = bf2f(*p1) * scl, x2 = bf2f(*p2) * scl;
                if (ri.sample) { const int pos = half ? pc : pr; const float c = r16[(pos * 16 + f) * 2], sn = r16[(pos * 16 + f) * 2 + 1]; const float y1 = x1 * c - x2 * sn, y2 = x1 * sn + x2 * c; x1 = y1; x2 = y2; }
                *p1 = f2bf(x1); *p2 = f2bf(x2); } }
    }
}
NVF(nv_ctx_even) {
    const float* cckv = P.in[layer == 0 ? I_C0CKV : I_C2CKV]; const float* ckr = P.in[layer == 0 ? I_C0KR : I_C2KR];
    bf16_t *CKVN = ws_bf(P, WS_CKVN), *KR = ws_bf(P, WS_KR); float* sskr = ws_f32(P, WS_SSKR);
    for (long i = gt; i < (long)CTX_ROWS * 256; i += gn) CKVN[(size_t)MROWS * 256 + i] = f2bf(cckv[i]);
    for (long rc = gt; rc < CTX_ROWS; rc += gn) { float s = 0.f;
        for (int j = 0; j < 32; ++j) { const bf16_t v = f2bf(ckr[rc * 32 + j]); KR[(size_t)(MROWS + rc) * 32 + j2o32(j)] = v; s += bf2f(v) * bf2f(v); }
        sskr[MROWS + rc] = s; }
}
NVF(nv_uq) {
    const bf16_t* CQ = ws_bf(P, WS_CQ); bf16_t* QR = ws_bf(P, WS_QR); const float* W = P.in[I_WUQ] + (size_t)(layer >> 1) * 384 * 768; const float* gq = P.in[I_QNG] + (layer >> 1) * 384;
    for (long i = gt; i < (long)MROWS * 768; i += gn) {
        const int sp = (int)(i % 96), head = (int)((i / 96) & 7); const long row = i / 768;
        const int dd = sp < 64 ? sp : 64 + o2j32(sp - 64), col = head * 96 + dd; float z = 0.f;
        for (int k = 0; k < 384; ++k) z += bf2f(CQ[row * 384 + k]) * bfr(gq[k] * W[(size_t)k * 768 + col]);
        QR[i] = f2bf(z);
    }
}
NVF(nv_uq_ss) {
    const bf16_t* QR = ws_bf(P, WS_QR); const float* sscq = ws_f32(P, WS_SSCQ); float *ssqn = ws_f32(P, WS_SSQN), *ssqr = ws_f32(P, WS_SSQR);
    for (long i = gt; i < (long)MROWS * 8; i += gn) { const long row = i >> 3; float a = 0.f, b = 0.f;
        for (int s = 0; s < 64; ++s) { const float v = bf2f(QR[i * 96 + s]); a += v * v; }
        for (int s = 64; s < 96; ++s) { const float v = bf2f(QR[i * 96 + s]); b += v * v; }
        float c = 0.f; for (int j = 0; j < 8; ++j) c += sscq[row * 8 + j];
        ssqn[i] = a + 96.f * EPS * (c * (1.f / 384.f) + EPS); ssqr[i] = b; }
}
NVF(nv_ukv) {
    const bf16_t* CKVN = ws_bf(P, WS_CKVN); const float* W = P.in[I_WUKV] + (size_t)(layer >> 1) * 256 * 1024;
    unsigned char* KI = P.ws + WS_KIMG; unsigned char* VI = P.ws + WS_VIMG;
    for (long i = gt; i < (long)MROWS_X * 1024; i += gn) {
        const int feat = (int)(i & 1023), head = feat >> 7, r = feat & 127; const int R = (int)(i >> 10); float v = 0.f;
        for (int k = 0; k < 256; ++k) v += bf2f(CKVN[(size_t)R * 256 + k]) * bfr(W[(size_t)k * 1024 + feat]);
        int kin; const int tile = kv_tile(R, head, 8, kin);
        if (r < 64) *(bf16_t*)(KI + (size_t)tile * 12288 + (r >> 3) * 1024 + kin * 16 + (r & 7) * 2) = f2bf(v);
        else { const int dv = r - 64; *(bf16_t*)(VI + (size_t)tile * 8192 + (dv >> 5) * 4096 + kin * 64 + (dv & 31) * 2) = f2bf(v); }
    }
}
NVF(nv_k_post) {
    const bf16_t* KR = ws_bf(P, WS_KR); const float* sskr = ws_f32(P, WS_SSKR); const float* gk = P.in[I_KHG] + (layer >> 1) * 96; const float* r8 = ws_f32(P, WS_ROPE8);
    unsigned char* KI = P.ws + WS_KIMG;
    for (long i = gt; i < (long)MROWS_X * 8; i += gn) {
        const int R = (int)(i >> 3), head = (int)(i & 7); int kin; const int tile = kv_tile(R, head, 8, kin);
        unsigned char* base = KI + (size_t)tile * 12288 + kin * 16;
        float s = sskr[R];
        for (int d = 0; d < 64; ++d) { const float v = bf2f(*(bf16_t*)(base + (d >> 3) * 1024 + (d & 7) * 2)); s += v * v; }
        const float rs = 1.0f / sqrtf(s * (1.f / 96.f) + EPS);
        for (int d = 0; d < 64; ++d) { bf16_t* p = (bf16_t*)(base + (d >> 3) * 1024 + (d & 7) * 2); *p = f2bf(bf2f(*p) * rs * gk[d]); }
        const bool lat = (R >= NP_ROWS && R < MROWS); const int t = (R - NP_ROWS) & 4095, pr = t >> 6, pc = t & 63;
        for (int half = 0; half < 2; ++half) for (int f = 0; f < 8; ++f) {
            const int j1 = 16 * half + f, j2 = j1 + 8; const int o1 = j2o32(j1), o2 = j2o32(j2);
            float x1 = bf2f(KR[(size_t)R * 32 + o1]) * rs * gk[64 + j1], x2 = bf2f(KR[(size_t)R * 32 + o2]) * rs * gk[64 + j2];
            if (lat) { const int pos = half ? pc : pr; const float c = r8[(pos * 8 + f) * 2], sn = r8[(pos * 8 + f) * 2 + 1]; const float y1 = x1 * c - x2 * sn, y2 = x1 * sn + x2 * c; x1 = y1; x2 = y2; }
            *(bf16_t*)(base + ((64 + o1) >> 3) * 1024 + (o1 & 7) * 2) = f2bf(x1); *(bf16_t*)(base + ((64 + o2) >> 3) * 1024 + (o2 & 7) * 2) = f2bf(x2); }
    }
}
__device__ __forceinline__ int chunk_row0(int c) { return c < 64 ? (c >> 1) * 256 + (c & 1) * 128 : NP_ROWS + ((c - 64) >> 5) * 4096 + ((c - 64) & 31) * 128; }
__device__ __forceinline__ unsigned char* ur_ptr(CParams& P, int c, int head, int dir) { return c < 64 ? P.ws + WS_URP + (size_t)((c * 4 + head) * 2 + dir) * 16384 : P.ws + WS_URS + (size_t)(((c - 64) * 4 + head) * 2 + dir) * 16384; }
__device__ __forceinline__ size_t ur_el(int p, int dv) { return (size_t)(dv >> 5) * 4096 + p * 64 + (dv & 31) * 2; }
NVF(nv_u) {
    const bf16_t *RK = ws_bf(P, WS_RK), *RV = ws_bf(P, WS_RV);
    for (long i = gt; i < 192L * 4 * 2 * 8192; i += gn) {
        const int dv = (int)(i & 127), p = (int)((i >> 7) & 63), dir = (int)((i >> 13) & 1), head = (int)((i >> 14) & 3), c = (int)(i >> 16);
        const float lg = log_gamma(P, layer, dir, head); const int r0 = chunk_row0(c); float s = 0.f;
        for (int t = 0; t < 128; ++t) { const float w = __expf(lg * (float)(dir ? t : 127 - t)); s += bfr(bf2f(RK[(size_t)(r0 + t) * 256 + head * 64 + p]) * w) * bf2f(RV[(size_t)(r0 + t) * 512 + head * 128 + dv]); }
        *(bf16_t*)(ur_ptr(P, c, head, dir) + ur_el(p, dv)) = f2bf(s);
    }
}
NVF(nv_scan) {
    float* orf = P.out + (layer == 0 ? O_L0RF : O_L2RF); float* orb = P.out + (layer == 0 ? O_L0RB : O_L2RB);
    const float* s0f = P.in[layer == 0 ? I_S0F : I_S2F]; const float* s0b = P.in[layer == 0 ? I_S0B : I_S2B];
    for (long i = gt; i < 36L * 4 * 2 * 8192; i += gn) {
        const int dv = (int)(i & 127), p = (int)((i >> 7) & 63), dir = (int)((i >> 13) & 1), head = (int)((i >> 14) & 3), seq = (int)(i >> 16);
        const float gC = __expf(128.f * log_gamma(P, layer, dir, head)); const size_t el = ur_el(p, dv); const int d = p2d64(p);
        if (seq < 32) {
            bf16_t* u0 = (bf16_t*)(ur_ptr(P, 2 * seq, head, dir) + el); bf16_t* u1 = (bf16_t*)(ur_ptr(P, 2 * seq + 1, head, dir) + el);
            const float a = bf2f(*u0), b = bf2f(*u1);
            if (dir == 0) { orf[((size_t)(seq * 4 + head) * 64 + d) * 128 + dv] = gC * a + b; *u0 = 0; *u1 = f2bf(a); }
            else { orb[((size_t)(seq * 4 + head) * 64 + d) * 128 + dv] = gC * b + a; *u1 = 0; *u0 = f2bf(b); }
        } else {
            const int b = seq - 32; float R = (dir ? s0b : s0f)[((size_t)(b * 4 + head) * 64 + d) * 128 + dv];
            for (int n = 0; n < 32; ++n) { const int c = 64 + b * 32 + (dir ? 31 - n : n); bf16_t* u = (bf16_t*)(ur_ptr(P, c, head, dir) + el); const float uv = bf2f(*u); *u = f2bf(R); R = gC * R + uv; }
        }
    }
}
__device__ __forceinline__ float mla_q_at(CParams& P, int layer, int row, int head, int s) {
    const bf16_t* QR = ws_bf(P, WS_QR) + ((size_t)row * 8 + head) * 96; const float* gq = P.in[I_QHG] + (layer >> 1) * 96; const float* r8 = ws_f32(P, WS_ROPE8);
    const float ss = ws_f32(P, WS_SSQN)[row * 8 + head] + ws_f32(P, WS_SSQR)[row * 8 + head]; const float rs = 1.0f / sqrtf(ss * (1.f / 96.f));
    const float qs = 0.10206207261596575f * LOG2E;
    if (s < 64) return bfr(bf2f(QR[s]) * rs * gq[s] * qs);
    const RowInfo ri = row_info(row);
    const int j = o2j32(s - 64), j1 = j & ~8, j2 = j1 + 8, half = j >> 4, f = j & 7;
    const float x1 = bf2f(QR[64 + j2o32(j1)]) * rs * gq[64 + j1], x2 = bf2f(QR[64 + j2o32(j2)]) * rs * gq[64 + j2];
    float c = 1.f, sn = 0.f;
    if (ri.sample) { const int pos = half ? (ri.t & 63) : (ri.t >> 6); c = r8[(pos * 8 + f) * 2]; sn = r8[(pos * 8 + f) * 2 + 1]; }
    const float y = (j & 8) ? (x1 * sn + x2 * c) : (x1 * c - x2 * sn);
    return bfr(y * qs);
}
NVF(nv_mla_attn) {
    const unsigned char* KI = P.ws + WS_KIMG; const unsigned char* VI = P.ws + WS_VIMG; bf16_t* G = ws_bf(P, WS_G); const float bnd = ws_f32(P, WS_BND)[layer >> 1];
    const int lane = (int)(gt & 63);
    for (long it = gt >> 6; it < (long)MROWS * 8; it += gn >> 6) {
        const int row = (int)(it % MROWS), head = (int)(it / MROWS); const RowInfo ri = row_info(row);
        const float q0 = mla_q_at(P, layer, row, head, lane), q1 = lane < 32 ? mla_q_at(P, layer, row, head, 64 + lane) : 0.f;
        float o = 0.f, l = 0.f;
        const int t0 = kv_seq_tile0(ri.sample, ri.b, head, 8), nk = ri.sample ? 4608 : 256;
        for (int key = 0; key < nk; ++key) {
            const unsigned char* kb = KI + (size_t)(t0 + (key >> 6)) * 12288 + (key & 63) * 16; const unsigned char* vb = VI + (size_t)(t0 + (key >> 6)) * 8192 + (key & 63) * 64;
            float s = q0 * bf2f(*(const bf16_t*)(kb + (lane >> 3) * 1024 + (lane & 7) * 2));
            if (lane < 32) s += q1 * bf2f(*(const bf16_t*)(kb + ((64 + lane) >> 3) * 1024 + (lane & 7) * 2));
            s = wave_sum(s);
            const float p = exp2f(s - bnd); l += p;
            o += bfr(p) * bf2f(*(const bf16_t*)(vb + (lane >> 5) * 4096 + (lane & 31) * 2));
        }
        bf16_t* g = G + (size_t)row * 1024 + head * 64 + lane; *g = f2bf(o / l * bf2f(*g));
    }
}
NVF(nv_ret_out) {
    const bf16_t *RQ = ws_bf(P, WS_RQ), *RK = ws_bf(P, WS_RK), *RV = ws_bf(P, WS_RV); bf16_t* G = ws_bf(P, WS_G); const float* gn_ = P.in[I_RNG] + (layer >> 1) * 512;
    const int lane = (int)(gt & 63);
    for (long it = gt >> 6; it < (long)MROWS * 4; it += gn >> 6) {
        const int row = (int)(it % MROWS), head = (int)(it / MROWS);
        const int c = row < NP_ROWS ? row >> 7 : 64 + ((row - NP_ROWS) >> 7); const int ii = row & 127, r0 = chunk_row0(c);
        const float lgf = log_gamma(P, layer, 0, head), lgb = log_gamma(P, layer, 1, head);
        const float ql = bf2f(RQ[(size_t)row * 256 + head * 64 + lane]);
        float o0 = 0.f, o1 = 0.f;
        for (int j = 0; j < 128; ++j) {
            const float s = wave_sum(ql * bf2f(RK[(size_t)(r0 + j) * 256 + head * 64 + lane]));
            const float D = j < ii ? __expf(lgf * (float)(ii - j)) : (j > ii ? __expf(lgb * (float)(j - ii)) : 2.f);
            const float pb = bfr(s * D);
            o0 += pb * bf2f(RV[(size_t)(r0 + j) * 512 + head * 128 + lane]); o1 += pb * bf2f(RV[(size_t)(r0 + j) * 512 + head * 128 + 64 + lane]);
        }
        const float wf = __expf(lgf * (float)(ii + 1)), wb = __expf(lgb * (float)(128 - ii));
        const unsigned char* Rf = ur_ptr(P, c, head, 0); const unsigned char* Rb = ur_ptr(P, c, head, 1);
        for (int p = 0; p < 64; ++p) { const float qp = bf2f(RQ[(size_t)row * 256 + head * 64 + p]); const float qf = bfr(qp * wf), qb = bfr(qp * wb);
            o0 += qf * bf2f(*(const bf16_t*)(Rf + ur_el(p, lane))) + qb * bf2f(*(const bf16_t*)(Rb + ur_el(p, lane)));
            o1 += qf * bf2f(*(const bf16_t*)(Rf + ur_el(p, 64 + lane))) + qb * bf2f(*(const bf16_t*)(Rb + ur_el(p, 64 + lane))); }
        const float mu = wave_sum(o0 + o1) * (1.f / 128.f);
        const float d0 = o0 - mu, d1 = o1 - mu; const float var = wave_sum(d0 * d0 + d1 * d1) * (1.f / 128.f);
        const float rs = 1.0f / sqrtf(var + EPS);
        bf16_t* g = G + (size_t)row * 1024 + 512 + head * 128 + lane;
        g[0] = f2bf(d0 * rs * gn_[head * 128 + lane] * bf2f(g[0])); g[64] = f2bf(d1 * rs * gn_[head * 128 + 64 + lane] * bf2f(g[64]));
    }
}
NVF(nv_out) {
    const bf16_t* G = ws_bf(P, WS_G); const float* W = ((layer & 1) ? P.in[I_WWOUT] : P.in[I_ABWOUT]) + (size_t)(layer >> 1) * 1024 * 1024; const float* mod = ws_f32(P, WS_MOD);
    for (long i = gt; i < (long)(MROWS / 4) * 1024; i += gn) {
        const int col = (int)(i & 1023), r0 = (int)(i >> 10) * 4; float acc[4] = {0.f, 0.f, 0.f, 0.f};
        for (int k = 0; k < 1024; ++k) { const float w = bfr(W[(size_t)k * 1024 + col]);
#pragma unroll
            for (int r = 0; r < 4; ++r) acc[r] += bf2f(G[(size_t)(r0 + r) * 1024 + k]) * w; }
#pragma unroll
        for (int r = 0; r < 4; ++r) { const int row = r0 + r; const RowInfo ri = row_info(row);
            P.out[(size_t)row * 1024 + col] = y_row(P, layer, row)[col] + mod[(layer * 5 + ri.cond) * 3072 + 2048 + col] * acc[r]; }
    }
}
NVF(nv_in_odd) {
    const bf16_t* A = ws_bf(P, WS_AODD); const float* SS = ws_f32(P, WS_SS); const float* W = P.in[I_WWIN] + (size_t)(layer >> 1) * 1024 * WIN_IN; const float* bias = ws_f32(P, WS_BIAS);
    bf16_t *QW = ws_bf(P, WS_QW), *G = ws_bf(P, WS_G); unsigned char* KI = P.ws + WS_KWIMG; unsigned char* VI = P.ws + WS_VWIMG; float* ov = P.out + (layer == 1 ? O_L1V : O_L3V);
    for (long i = gt; i < (long)(MROWS / 4) * WIN_IN; i += gn) {
        const int col = (int)(i % WIN_IN), r0 = (int)(i / WIN_IN) * 4; float acc[4] = {0.f, 0.f, 0.f, 0.f};
        for (int k = 0; k < 1024; ++k) { const float w = bfr(W[(size_t)k * WIN_IN + col]);
#pragma unroll
            for (int r = 0; r < 4; ++r) acc[r] += bf2f(A[(size_t)(r0 + r) * 1024 + k]) * w; }
#pragma unroll
        for (int r = 0; r < 4; ++r) { const int row = r0 + r; const RowInfo ri = row_info(row);
            const float v = acc[r] * row_rstd(SS, row) + bias[(layer * 5 + ri.cond) * 2816 + col];
            if (col < 1024) QW[(size_t)row * 1024 + (col >> 6) * 64 + d2p64(col & 63)] = f2bf(v);
            else if (col < 1280) { const int x = col - 1024, kvh = x >> 6, p = d2p64(x & 63); int kin; const int tile = kv_tile(row, kvh, 4, kin); *(bf16_t*)(KI + (size_t)tile * 8192 + (p >> 3) * 1024 + kin * 16 + (p & 7) * 2) = f2bf(v); }
            else if (col < 1536) { const int x = col - 1280, kvh = x >> 6, dv = x & 63; int kin; const int tile = kv_tile(row, kvh, 4, kin); *(bf16_t*)(VI + (size_t)tile * 8192 + (dv >> 5) * 4096 + kin * 64 + (dv & 31) * 2) = f2bf(v); if (!ri.sample) ov[(size_t)row * 256 + x] = v; }
            else G[(size_t)row * 1024 + col - 1536] = f2bf(silu_f(v)); }
    }
}
NVF(nv_post_odd) {
    bf16_t* QW = ws_bf(P, WS_QW); unsigned char* KI = P.ws + WS_KWIMG; const float* r16 = ws_f32(P, WS_ROPE16); float* ok = P.out + (layer == 1 ? O_L1K : O_L3K);
    const float* gq = P.in[I_WQHG] + (layer >> 1) * 64; const float* gk = P.in[I_WKHG] + (layer >> 1) * 64;
    const int d = (int)(gt & 63), p = d2p64(d);
    for (long it = gt >> 6; it < (long)MROWS * 20; it += gn >> 6) {
        const int row = (int)(it / 20), hh = (int)(it % 20); const RowInfo ri = row_info(row); const bool isq = hh < 16; const int kvh = hh - 16;
        int kin = 0, tile = 0; if (!isq) tile = kv_tile(row, kvh, 4, kin);
        bf16_t* ptr = isq ? QW + (size_t)row * 1024 + hh * 64 + p : (bf16_t*)(KI + (size_t)tile * 8192 + (p >> 3) * 1024 + kin * 16 + (p & 7) * 2);
        float x = bf2f(*ptr);
        const float rs = 1.0f / sqrtf(wave_sum(x * x) * (1.f / 64.f) + EPS);
        x *= rs * (isq ? gq[d] : gk[d]);
        if (!isq && !ri.sample) ok[(size_t)row * 256 + kvh * 64 + d] = x;
        const float xp = xor_shfl<16>(x);
        if (ri.sample) { const int half = d >> 5, f = d & 15; const int pos = half ? (ri.t & 63) : (ri.t >> 6);
            const float c = r16[(pos * 16 + f) * 2], sn = r16[(pos * 16 + f) * 2 + 1];
            x = (d & 16) ? (xp * sn + x * c) : (x * c - xp * sn); }
        *ptr = f2bf(isq ? x * 0.125f * LOG2E : x);
    }
}
NVF(nv_ctx_odd) {
    const float* ck = P.in[layer == 1 ? I_C1K : I_C3K]; const float* cv = P.in[layer == 1 ? I_C1V : I_C3V]; unsigned char* KI = P.ws + WS_KWIMG; unsigned char* VI = P.ws + WS_VWIMG;
    unsigned* bmax = (unsigned*)ws_f32(P, WS_BND) + 4 + (layer >> 1);
    for (long i = gt; i < (long)CTX_ROWS * 4; i += gn) { const int rc = (int)(i >> 2), kvh = (int)(i & 3); int kin; const int tile = kv_tile(MROWS + rc, kvh, 4, kin); float s = 0.f;
        for (int d = 0; d < 64; ++d) { const int p = d2p64(d); const bf16_t kb = f2bf(ck[(size_t)rc * 256 + kvh * 64 + d]); s += bf2f(kb) * bf2f(kb);
            *(bf16_t*)(KI + (size_t)tile * 8192 + (p >> 3) * 1024 + kin * 16 + (p & 7) * 2) = kb;
            *(bf16_t*)(VI + (size_t)tile * 8192 + (d >> 5) * 4096 + kin * 64 + (d & 31) * 2) = f2bf(cv[(size_t)rc * 256 + kvh * 64 + d]); }
        atomicMax(bmax, __float_as_uint(s)); }
}
NVF(nv_win_attn) {
    const bf16_t* QW = ws_bf(P, WS_QW); const unsigned char* KI = P.ws + WS_KWIMG; const unsigned char* VI = P.ws + WS_VWIMG; bf16_t* G = ws_bf(P, WS_G);
    const float* bf = ws_f32(P, WS_BND); const int li = layer >> 1;
    const float knorm = fmaxf(8.f * bf[10 + li], sqrtf(bf[4 + li])); const float bnd = 0.125f * LOG2E * 8.f * bf[8 + li] * knorm;
    const int lane = (int)(gt & 63);
    for (long it = gt >> 6; it < (long)MROWS * 16; it += gn >> 6) {
        const int row = (int)(it % MROWS), head = (int)(it / MROWS), kvh = head >> 2; const RowInfo ri = row_info(row);
        const float ql = bf2f(QW[(size_t)row * 1024 + head * 64 + lane]);
        float o = 0.f, l = exp2f(P.in[I_SINK][li * 16 + head] * LOG2E - bnd);
        const int t0 = kv_seq_tile0(ri.sample, ri.b, kvh, 4);
        int klo = 0, khi = 256, k2lo = 0, k2hi = 0;
        if (ri.sample) { klo = 0; khi = 512; k2lo = 512 + max(0, ri.t - 128); k2hi = 512 + min(4095, ri.t + 128) + 1; }
        for (int seg = 0; seg < 2; ++seg) { const int a = seg ? k2lo : klo, b = seg ? k2hi : khi;
            for (int key = a; key < b; ++key) {
                const unsigned char* kb = KI + (size_t)(t0 + (key >> 6)) * 8192 + (key & 63) * 16; const unsigned char* vb = VI + (size_t)(t0 + (key >> 6)) * 8192 + (key & 63) * 64;
                const float s = wave_sum(ql * bf2f(*(const bf16_t*)(kb + (lane >> 3) * 1024 + (lane & 7) * 2)));
                const float pp = exp2f(s - bnd); l += pp;
                o += bfr(pp) * bf2f(*(const bf16_t*)(vb + (lane >> 5) * 4096 + (lane & 31) * 2)); } }
        bf16_t* g = G + (size_t)row * 1024 + head * 64 + lane; *g = f2bf(o / l * bf2f(*g));
    }
}
NVF(nv_zero_bnd) { if (gt < 64) ws_f32(P, WS_BND)[gt] = 0.f; }

namespace pg8 {
#define PG8_LAS __attribute__((address_space(3)))
typedef short bf16x8 __attribute__((ext_vector_type(8)));
typedef float f32x4 __attribute__((ext_vector_type(4)));
typedef unsigned u32x4 __attribute__((ext_vector_type(4)));
constexpr int BM = 256, BK = 64, HALF = 128, HTB = HALF * BK * 2  , STAGE_BYTES = 8 * HTB, NXCD = 8, WGM = 8;

__host__ __device__ __forceinline__ int lds_byte(int r, int c) { const int st = (r >> 4) * 2 + (c >> 5), rr = r & 15, cc = c & 31, ob = rr * 64 + cc * 2; return st * 1024 + (ob ^ (((ob >> 9) & 1) << 5)); }
__host__ __device__ __forceinline__ void stage_rc(int b, int& R, int& C) { const int st = b / 1024, sb = b % 1024, swz = sb ^ (((sb >> 9) & 1) << 5); R = (st >> 1) * 16 + swz / 64; C = (st & 1) * 32 + (swz % 64) / 2; }
__host__ __device__ __forceinline__ int perm32(int rho) { const int n = rho >> 4, i = rho & 15; return 8 * (i >> 2) + 4 * n + (i & 3); }

struct Unit { int pm, pn; };
struct Gemm { const bf16_t* A; const bf16_t* Bt; int M, N, K, lda; };

struct StaticOrder {
    int nM, nN, nwg, G, c;
    __host__ __device__ void init(int M, int N, int G_, int c_) { nM = M / BM; nN = N / BM; nwg = nM * nN; G = G_; c = c_; }
    __host__ __device__ bool next(int i, Unit& u) const {
        const long L = (long)i * G + c; if (L >= nwg) return false;
        int wgid = (int)L; { const int q = nwg / NXCD, r = nwg % NXCD, xcd = wgid % NXCD, off = wgid / NXCD; wgid = (xcd < r ? xcd * (q + 1) : r * (q + 1) + (xcd - r) * q) + off; }
        const int nig = WGM * nN, gid = wgid / nig, fm = gid * WGM, gsz = (nM - fm) < WGM ? (nM - fm) : WGM;
        u.pm = fm + ((wgid % nig) % gsz); u.pn = (wgid % nig) / gsz; return true;
    }
    __device__ __forceinline__ void a_ready(const Unit&) const {}
    __device__ __forceinline__ void done(const Unit&) const {}
};

template <class Epi, class Sched, bool ALIGN_EPI = false, bool SP2 = false>
__device__ __forceinline__ void gemm_phase(PG8_LAS unsigned char* lds, const Gemm g, const Sched& S, const Epi& E, int wave_s) {
    int ws_ = wave_s; asm volatile("" : "+s"(ws_)); int ln_ = lane_id(); asm volatile("" : "+v"(ln_)); const int wid = ws_, lane = ln_, tid = wid * 64 + lane, wr = wid >> 2, wc = wid & 3, fr = lane & 15, fq = lane >> 4;
    const int K = g.K, nt = K / BK;
    unsigned voffA[2], voffB[2];
#pragma unroll
    for (int i = 0; i < 2; ++i) { int R, C; stage_rc(tid * 16 + i * 8192, R, C); const int Rb = Epi::PERM ? ((R & ~31) + perm32(R & 31)) : R;
        voffA[i] = (unsigned)(R * g.lda + C) * 2u; voffB[i] = (unsigned)(Rb * K + C) * 2u; }
    const size_t kstep = (size_t)(BK * 2);
    const size_t hstepA = (size_t)HALF * g.lda * 2, hstepB = (size_t)HALF * K * 2;
    const size_t tstepA = 2 * hstepA, tstepB = 2 * hstepB;
    const unsigned ldsw = (unsigned)wid * 1024u;
    const int aoff = lds_byte(wr * 64 + fr, fq * 8), boff = lds_byte(wc * 32 + fr, fq * 8);
#define PG8_SA(b, h) (((b) * 2 + (h)) * HTB)
#define PG8_SB(b, h) ((4 + (b) * 2 + (h)) * HTB)
#define PG8_STAGE(bufoff, gbase, voff) do { _Pragma("unroll") for (int _i = 0; _i < 2; ++_i) \
        __builtin_amdgcn_global_load_lds((const unsigned*)((const char*)(gbase) + (voff)[_i]), (PG8_LAS unsigned*)(lds + (bufoff) + ldsw + _i * 8192), 16, 0, 0); } while (0)
#define PG8_LDA(dst, b, h) do { _Pragma("unroll") for (int m = 0; m < 4; ++m) _Pragma("unroll") for (int k = 0; k < 2; ++k) dst[m][k] = *(const PG8_LAS bf16x8*)(lds + PG8_SA(b, h) + aoff + m * 2048 + k * 1024); } while (0)
#define PG8_LDB(dst, b, h) do { _Pragma("unroll") for (int n = 0; n < 2; ++n) _Pragma("unroll") for (int k = 0; k < 2; ++k) dst[n][k] = *(const PG8_LAS bf16x8*)(lds + PG8_SB(b, h) + boff + n * 2048 + k * 1024); } while (0)
#define PG8_MMA(ai, bj, At, Bt) do { __builtin_amdgcn_s_setprio(1); _Pragma("unroll") for (int m = 0; m < 4; ++m) _Pragma("unroll") for (int n = 0; n < 2; ++n) _Pragma("unroll") for (int k = 0; k < 2; ++k) \
        acc[ai][bj][m][n] = __builtin_amdgcn_mfma_f32_16x16x32_bf16(Bt[n][k], At[m][k], acc[ai][bj][m][n], 0, 0, 0); __builtin_amdgcn_s_setprio(0); } while (0)
#define PG8_WAIT_V(n) asm volatile("s_waitcnt vmcnt(" #n ")" ::: "memory")
#define PG8_WAIT_L(n) asm volatile("s_waitcnt lgkmcnt(" #n ")" ::: "memory")
#define PG8_BAR __builtin_amdgcn_s_barrier()
#define PG8_SCHED __builtin_amdgcn_sched_barrier(0)
    Unit cur, nxt; int ui = 0;
    if (!S.next(0, cur)) return;
    f32x4 acc[2][2][4][2];
#pragma unroll
    for (int a = 0; a < 2; ++a)
#pragma unroll
        for (int b = 0; b < 2; ++b)
#pragma unroll
            for (int m = 0; m < 4; ++m)
#pragma unroll
                for (int n = 0; n < 2; ++n) acc[a][b][m][n] = (f32x4){0.f, 0.f, 0.f, 0.f};
    bf16x8 At[4][2], B0[2][2], B1[2][2];
    const char* cA = (const char*)g.A + (size_t)cur.pm * tstepA; const char* cB = (const char*)g.Bt + (size_t)cur.pn * tstepB;
    S.a_ready(cur);
    if constexpr (SP2) {
        PG8_STAGE(PG8_SB(0, 0), cB, voffB); PG8_STAGE(PG8_SB(0, 1), cB + hstepB, voffB); PG8_STAGE(PG8_SA(0, 0), cA, voffA); PG8_STAGE(PG8_SA(0, 1), cA + hstepA, voffA);
        if (wr == 1) PG8_BAR;
        PG8_WAIT_V(2); PG8_BAR;
        PG8_STAGE(PG8_SB(1, 0), cB + kstep, voffB); PG8_STAGE(PG8_SA(1, 0), cA + kstep, voffA); PG8_STAGE(PG8_SB(1, 1), cB + hstepB + kstep, voffB);
        PG8_WAIT_V(6); PG8_BAR;
    } else {
        PG8_STAGE(PG8_SB(0, 0), cB, voffB); PG8_STAGE(PG8_SA(0, 0), cA, voffA); PG8_STAGE(PG8_SB(0, 1), cB + hstepB, voffB); PG8_STAGE(PG8_SA(0, 1), cA + hstepA, voffA);
        if (wr == 1) PG8_BAR;
        PG8_WAIT_V(4); PG8_BAR;
        PG8_STAGE(PG8_SB(1, 0), cB + kstep, voffB); PG8_STAGE(PG8_SA(1, 0), cA + kstep, voffA); PG8_STAGE(PG8_SB(1, 1), cB + hstepB + kstep, voffB);
        PG8_WAIT_V(6); PG8_BAR;
    }
    for (;;) {
        const bool has_next = S.next(ui + 1, nxt);
        const char* nA = has_next ? (const char*)g.A + (size_t)nxt.pm * tstepA : cA; const char* nB = has_next ? (const char*)g.Bt + (size_t)nxt.pn * tstepB : cB;
        for (int t = 0; t < nt; t += 2) {
            const bool last = (t == nt - 2);
            const char* a1 = cA + (size_t)(t + 1) * kstep;
            const char* a2 = last ? nA : cA + (size_t)(t + 2) * kstep; const char* b2 = last ? nB : cB + (size_t)(t + 2) * kstep;
            const char* a3 = a2 + kstep; const char* b3 = b2 + kstep;
            if (last && has_next) S.a_ready(nxt);
            if constexpr (SP2) {
            PG8_LDB(B0, 0, 0); PG8_LDB(B1, 0, 1); PG8_SCHED; PG8_LDA(At, 0, 0); PG8_STAGE(PG8_SA(1, 1), a1 + hstepA, voffA);
            PG8_WAIT_V(8); PG8_WAIT_L(0); PG8_BAR; PG8_MMA(0, 0, At, B0); PG8_MMA(0, 1, At, B1); PG8_BAR; PG8_SCHED;
            PG8_LDA(At, 0, 1); PG8_STAGE(PG8_SB(0, 0), b2, voffB); PG8_STAGE(PG8_SB(0, 1), b2 + hstepB, voffB); PG8_STAGE(PG8_SA(0, 0), a2, voffA);
            PG8_WAIT_V(8); PG8_WAIT_L(0); PG8_BAR; PG8_MMA(1, 0, At, B0); PG8_MMA(1, 1, At, B1); PG8_BAR; PG8_SCHED;
            PG8_LDB(B0, 1, 0); PG8_LDB(B1, 1, 1); PG8_SCHED; PG8_LDA(At, 1, 0); PG8_STAGE(PG8_SA(0, 1), a2 + hstepA, voffA);
            PG8_WAIT_V(8); PG8_WAIT_L(0); PG8_BAR; PG8_MMA(0, 0, At, B0); PG8_MMA(0, 1, At, B1); PG8_BAR; PG8_SCHED;
            PG8_LDA(At, 1, 1); PG8_STAGE(PG8_SB(1, 0), b3, voffB); PG8_STAGE(PG8_SB(1, 1), b3 + hstepB, voffB); PG8_STAGE(PG8_SA(1, 0), a3, voffA);
            PG8_WAIT_V(8); PG8_WAIT_L(0); PG8_BAR; PG8_MMA(1, 0, At, B0); PG8_MMA(1, 1, At, B1); PG8_BAR; PG8_SCHED;
            } else {
            PG8_LDB(B0, 0, 0); PG8_SCHED; PG8_LDA(At, 0, 0); PG8_STAGE(PG8_SA(1, 1), a1 + hstepA, voffA);
            PG8_WAIT_L(8); PG8_BAR; PG8_WAIT_L(0); PG8_MMA(0, 0, At, B0); PG8_BAR; PG8_SCHED;
            PG8_LDB(B1, 0, 1); PG8_STAGE(PG8_SB(0, 0), b2, voffB);
            PG8_BAR; PG8_WAIT_L(0); PG8_MMA(0, 1, At, B1); PG8_BAR;
            PG8_LDA(At, 0, 1); PG8_STAGE(PG8_SA(0, 0), a2, voffA);
            PG8_BAR; PG8_WAIT_L(0); PG8_MMA(1, 0, At, B0); PG8_BAR; PG8_SCHED;
            PG8_STAGE(PG8_SB(0, 1), b2 + hstepB, voffB);
            PG8_WAIT_V(6); PG8_BAR; PG8_MMA(1, 1, At, B1); PG8_BAR;
            PG8_LDB(B0, 1, 0); PG8_SCHED; PG8_LDA(At, 1, 0); PG8_STAGE(PG8_SA(0, 1), a2 + hstepA, voffA);
            PG8_WAIT_L(8); PG8_BAR; PG8_WAIT_L(0); PG8_MMA(0, 0, At, B0); PG8_BAR; PG8_SCHED;
            PG8_LDB(B1, 1, 1); PG8_STAGE(PG8_SB(1, 0), b3, voffB);
            PG8_BAR; PG8_WAIT_L(0); PG8_MMA(0, 1, At, B1); PG8_BAR;
            PG8_LDA(At, 1, 1); PG8_STAGE(PG8_SA(1, 0), a3, voffA);
            PG8_BAR; PG8_WAIT_L(0); PG8_MMA(1, 0, At, B0); PG8_BAR; PG8_SCHED;
            PG8_STAGE(PG8_SB(1, 1), b3 + hstepB, voffB);
            PG8_WAIT_V(6); PG8_BAR; PG8_MMA(1, 1, At, B1); PG8_BAR;
            }
        }
        if constexpr (ALIGN_EPI) { if (wr == 0) PG8_BAR; }
        if constexpr (!Epi::AFTER_DRAIN) { E(acc, cur, wr, wc, fr, fq); S.done(cur); }
        if (!has_next) break;
#pragma unroll
        for (int a = 0; a < 2; ++a)
#pragma unroll
            for (int b = 0; b < 2; ++b)
#pragma unroll
                for (int m = 0; m < 4; ++m)
#pragma unroll
                    for (int n = 0; n < 2; ++n) acc[a][b][m][n] = (f32x4){0.f, 0.f, 0.f, 0.f};
        cur = nxt; cA = nA; cB = nB; ++ui;
        if constexpr (ALIGN_EPI) { if (wr == 1) PG8_BAR; }
    }
    PG8_WAIT_V(0);
    if constexpr (!ALIGN_EPI) { if (wr == 0) PG8_BAR; }
    PG8_BAR;
    if constexpr (Epi::AFTER_DRAIN) { E.fused(acc, cur, wr, wc, fr, fq, lds, wid, lane); S.done(cur); }
#undef PG8_SA
#undef PG8_SB
#undef PG8_STAGE
#undef PG8_LDA
#undef PG8_LDB
#undef PG8_MMA
#undef PG8_WAIT_V
#undef PG8_WAIT_L
#undef PG8_BAR
#undef PG8_SCHED
}
}
#define LAS __attribute__((address_space(3)))
typedef float f32x4 __attribute__((ext_vector_type(4)));
typedef unsigned u32x4 __attribute__((ext_vector_type(4)));
typedef unsigned u32x2 __attribute__((ext_vector_type(2)));
constexpr int NWAVES = 8, NTHREADS = 512;
constexpr int RING_BYTES = 131072, EPI_OFF = RING_BYTES, EPI_BYTES = 8192, MISC_OFF = EPI_OFF + EPI_BYTES, LDS_BYTES = 147456;

typedef float f32x2_t __attribute__((ext_vector_type(2))); typedef __bf16 bf16x2_t __attribute__((ext_vector_type(2)));
__device__ __forceinline__ unsigned pk2(float lo, float hi) { f32x2_t v = {lo, hi}; bf16x2_t b = __builtin_convertvector(v, bf16x2_t); return __builtin_bit_cast(unsigned, b); }
__device__ __forceinline__ u32x4 pk8(const f32x4& a, const f32x4& b) { u32x4 r; r.x = pk2(a[0], a[1]); r.y = pk2(a[2], a[3]); r.z = pk2(b[0], b[1]); r.w = pk2(b[2], b[3]); return r; }
__device__ __forceinline__ float sum4sq(const f32x4& a) { return (a[0] * a[0] + a[1] * a[1]) + (a[2] * a[2] + a[3] * a[3]); }
__device__ __forceinline__ float fq_sum(float s) { s += xor_shfl<16>(s); return sum_halves(s); }

struct LDec { int pn, bj, wc, nn, fq, e, f, w, d; };
__device__ __forceinline__ LDec ldec(int n) { LDec r; r.pn = n >> 8; const int L = n & 255; r.bj = L >> 7; r.wc = (L >> 5) & 3; r.nn = (L >> 4) & 1; r.fq = (L >> 2) & 3; r.e = L & 3;
    r.f = 128 * r.bj + 32 * r.wc + 8 * r.fq + 4 * r.nn + r.e;
    r.w = 16 * r.fq + 8 * r.bj + 4 * r.nn + r.e;
    r.d = 32 * r.bj + 16 * r.nn + 4 * r.fq + r.e;
    return r; }
enum { MAP_OUT = 0, MAP_IN_ODD, MAP_IN_EVEN, MAP_UQ, MAP_UKV };
__device__ __forceinline__ int srccol(int map, int n) {
    const LDec r = ldec(n);
    switch (map) {
        case MAP_OUT: return r.pn * 256 + r.f;
        case MAP_IN_ODD:
            if (r.pn < 4) return (4 * r.pn + r.wc) * 64 + r.d;
            if (r.pn == 4) return 1024 + r.wc * 64 + r.d;
            if (r.pn == 5) return 1280 + r.wc * 64 + r.w;
            return 1536 + (r.pn - 6) * 256 + r.f;
        case MAP_IN_EVEN:
            switch (r.pn) {
                case 0: return r.f;
                case 1: if (r.bj == 0) return 256 + r.f; return r.wc == 0 ? 640 + o2j32(8 * r.fq + 4 * r.nn + r.e) : -1;
                case 2: return 384 + r.f;
                case 3: case 4: return 672 + (r.pn - 3) * 256 + r.f;
                case 5: case 6: return 2208 + (r.pn - 5) * 256 + r.f;
                case 7: return 1184 + r.wc * 64 + r.d;
                case 8: return 1440 + r.wc * 64 + r.d;
                default: return 1696 + (2 * (r.pn - 9) + (r.wc >> 1)) * 128 + 64 * (r.wc & 1) + r.w;
            }
        case MAP_UQ:
            if (r.pn < 2) return (4 * r.pn + r.wc) * 96 + r.w;
            return (2 * r.wc + (r.w >> 5)) * 96 + 64 + o2j32(r.w & 31);
        default:
            if (r.pn < 2) return (4 * r.pn + r.wc) * 128 + r.w;
            return (4 * (r.pn - 2) + r.wc) * 128 + 64 + r.w;
    }
}
__device__ __forceinline__ void prep_item(const float* W, int K, int Nsrc, bf16_t* WT, int map, const float* kscale, LAS float* scr, int item, int lane) {
    const int nblk_k = K / 64, nb = item / nblk_k, kb = item % nblk_k, k0 = 64 * kb, n0 = 32 * nb;
    const int sc = srccol(map, n0 + (lane & 31));
#pragma unroll 8
    for (int i = 0; i < 32; ++i) { const int kk = 2 * i + (lane >> 5); float v = 0.f; if (sc >= 0) { v = W[(size_t)(k0 + kk) * Nsrc + sc]; if (kscale) v *= kscale[k0 + kk]; } scr[kk * 33 + (lane & 31)] = v; }
    asm volatile("s_waitcnt lgkmcnt(0)" ::: "memory");
    const int c = lane & 7;
#pragma unroll
    for (int j = 0; j < 4; ++j) { const int n = (lane >> 3) + 8 * j; const LAS float* s = scr + (8 * c) * 33 + n;
        u32x4 o; o.x = pk2(s[0 * 33], s[1 * 33]); o.y = pk2(s[2 * 33], s[3 * 33]); o.z = pk2(s[4 * 33], s[5 * 33]); o.w = pk2(s[6 * 33], s[7 * 33]);
        *(u32x4*)(WT + (size_t)(n0 + n) * K + k0 + 8 * c) = o; }
    asm volatile("s_waitcnt lgkmcnt(0)" ::: "memory");
}
__device__ __forceinline__ void prep_layer_weights(CParams& P, int layer, LAS float* scr, int gw, int ngw, int lane) {
    const int li = layer >> 1;
    if (layer & 1) {
        const int nIn = (2560 / 32) * 16, nOut = (1024 / 32) * 16;
        for (int it = gw; it < nIn + nOut; it += ngw) {
            if (it < nIn) prep_item(P.in[I_WWIN] + (size_t)li * 1024 * WIN_IN, 1024, WIN_IN, ws_bf(P, WS_WIN), MAP_IN_ODD, nullptr, scr, it, lane);
            else prep_item(P.in[I_WWOUT] + (size_t)li * 1024 * 1024, 1024, 1024, ws_bf(P, layer & 1 ? WS_WOUT1 : WS_WOUT0), MAP_OUT, nullptr, scr, it - nIn, lane);
        }
    } else {
        const int nIn = (2816 / 32) * 16, nOut = (1024 / 32) * 16, nUq = (768 / 32) * 6, nUkv = (1024 / 32) * 4;
        for (int it = gw; it < nIn + nOut + nUq + nUkv; it += ngw) {
            int r = it;
            if (r < nIn) { prep_item(P.in[I_ABWIN] + (size_t)li * 1024 * AB_IN, 1024, AB_IN, ws_bf(P, WS_WIN), MAP_IN_EVEN, nullptr, scr, r, lane); continue; } r -= nIn;
            if (r < nOut) { prep_item(P.in[I_ABWOUT] + (size_t)li * 1024 * 1024, 1024, 1024, ws_bf(P, WS_WOUT0), MAP_OUT, nullptr, scr, r, lane); continue; } r -= nOut;
            if (r < nUq) { prep_item(P.in[I_WUQ] + (size_t)li * 384 * 768, 384, 768, ws_bf(P, WS_WUQ), MAP_UQ, P.in[I_QNG] + li * 384, scr, r, lane); continue; } r -= nUq;
            prep_item(P.in[I_WUKV] + (size_t)li * 256 * 1024, 256, 1024, ws_bf(P, WS_WUKV), MAP_UKV, nullptr, scr, r, lane);
        }
    }
}
__device__ void fast_biasL(CParams& P, long gt, long gn) {
    float* biasl = ws_f32(P, WS_BIASL); const float* mod = ws_f32(P, WS_MOD);
    for (long i = gt; i < 4L * 5 * 2816; i += gn) {
        const int n = (int)(i % 2816), c = (int)((i / 2816) % 5), l = (int)(i / (2816 * 5));
        const int N = (l & 1) ? WIN_IN : AB_IN; float s = 0.f;
        const int sc = (n < ((l & 1) ? 2560 : 2816)) ? srccol((l & 1) ? MAP_IN_ODD : MAP_IN_EVEN, n) : -1;
        if (sc >= 0) { const float* w = ((l & 1) ? P.in[I_WWIN] : P.in[I_ABWIN]) + (size_t)(l >> 1) * 1024 * N + sc; const float* sh = mod + (l * 5 + c) * 3072;
            for (int k = 0; k < 1024; ++k) s += sh[k] * w[(size_t)k * N]; }
        biasl[i] = s;
    }
}

#define EPI_ROW(ai, m) (u.pm * 256 + (ai) * 128 + wr * 64 + (m) * 16 + fr)
typedef f32x4 AccT[2][2][4][2];

struct EpiOut {
    static constexpr bool PERM = false, AFTER_DRAIN = false;
    CParams* Pp; int layer;
    __device__ __forceinline__ void operator()(const AccT& acc, const pg8::Unit& u, int wr, int wc, int fr_, int fq_) const {
        const int ln_ = lane_id(); const int fr = ln_ & 15, fq = ln_ >> 4; (void)fr_; (void)fq_;
        CParams* Pl = Pp; asm volatile("" : "+s"(Pl)); CParams& P = *Pl;
        const int cond = u.pm < 32 ? 4 : (u.pm - 32) >> 4;
        const float* gate = ws_f32(P, WS_MOD) + (layer * 5 + cond) * 3072 + 2048; const float* gsn = ws_f32(P, WS_GS) + ((layer + 1) * 5 + cond) * 1024;
        bf16_t* An = ws_bf(P, (layer & 1) ? WS_AEVEN : WS_AODD); float* SS = ws_f32(P, WS_SS);
        float ssq[2][4];
#pragma unroll
        for (int ai = 0; ai < 2; ++ai)
#pragma unroll
            for (int m = 0; m < 4; ++m) ssq[ai][m] = 0.f;
#pragma unroll
        for (int bj = 0; bj < 2; ++bj) {
            const int col = u.pn * 256 + 128 * bj + 32 * wc + 8 * fq;
            const f32x4 g0 = *(const f32x4*)(gate + col), g1 = *(const f32x4*)(gate + col + 4);
            f32x4 s0 = {0.f, 0.f, 0.f, 0.f}, s1 = s0; if (layer < 3) { s0 = *(const f32x4*)(gsn + col); s1 = *(const f32x4*)(gsn + col + 4); }
#pragma unroll
            for (int ai = 0; ai < 2; ++ai)
#pragma unroll
                for (int m = 0; m < 4; ++m) {
                    const int row = EPI_ROW(ai, m); const float* yo = y_row(P, layer, row) + col; float* yn = P.out + (size_t)row * 1024 + col;
                    const f32x4 y0 = *(const f32x4*)(yo) + g0 * acc[ai][bj][m][0], y1 = *(const f32x4*)(yo + 4) + g1 * acc[ai][bj][m][1];
                    *(f32x4*)(yn) = y0; *(f32x4*)(yn + 4) = y1; ssq[ai][m] += sum4sq(y0) + sum4sq(y1);
                    if (layer < 3) *(u32x4*)(An + (size_t)row * 1024 + col) = pk8(y0 * s0, y1 * s1);
                    if (m & 1) asm volatile("" ::: "memory");
                }
        }
        if (layer < 3) {
#pragma unroll
            for (int ai = 0; ai < 2; ++ai)
#pragma unroll
                for (int m = 0; m < 4; ++m) { const float s = fq_sum(ssq[ai][m]); if (fq == 0) SS[EPI_ROW(ai, m) * 16 + u.pn * 4 + wc] = s; }
        }
    }
};

__device__ __forceinline__ void rope4(f32x4& x0, f32x4& x1, const float* cs) {
    const f32x4 a = *(const f32x4*)cs, b = *(const f32x4*)(cs + 4);
    const f32x4 c = {a[0], a[2], b[0], b[2]}, s = {a[1], a[3], b[1], b[3]};
    const f32x4 y0 = x0 * c - x1 * s, y1 = x0 * s + x1 * c; x0 = y0; x1 = y1;
}

template <bool ODD> struct EpiIn {
    static constexpr bool PERM = false, AFTER_DRAIN = false;
    CParams* Pp; int layer; LAS float* xch;
    __device__ __forceinline__ void operator()(const AccT& acc, const pg8::Unit& u, int wr, int wc, int fr_, int fq_) const {
        const int ln_ = lane_id(); const int fr = ln_ & 15, fq = ln_ >> 4; (void)fr_; (void)fq_;
        CParams* Pl = Pp; asm volatile("" : "+s"(Pl)); CParams& P = *Pl;
        const int pn = u.pn; const bool sample = u.pm >= 32; const int cond = sample ? (u.pm - 32) >> 4 : 4; const int li = layer >> 1;
        const float* SS = ws_f32(P, WS_SS); const float* biasl = ws_f32(P, WS_BIASL) + (layer * 5 + cond) * 2816 + pn * 256;
        const float* r16 = ws_f32(P, WS_ROPE16);
        f32x4 bv[2][2];
#pragma unroll
        for (int bj = 0; bj < 2; ++bj)
#pragma unroll
            for (int n = 0; n < 2; ++n) bv[bj][n] = *(const f32x4*)(biasl + 128 * bj + 32 * wc + 16 * n + 4 * fq);
        enum { K_NAT_G, K_ROPEHEAD, K_V, K_CQ0, K_CQ1, K_CKV, K_RV };
        int kind; bf16_t* gdst = nullptr;
        if (ODD) { kind = pn < 5 ? K_ROPEHEAD : (pn == 5 ? K_V : K_NAT_G); if (pn >= 6) gdst = ws_bf(P, WS_G) + (pn - 6) * 256; }
        else { kind = pn == 0 ? K_CQ0 : pn == 1 ? K_CQ1 : pn == 2 ? K_CKV : pn < 7 ? K_NAT_G : pn < 9 ? K_ROPEHEAD : K_RV; if (pn >= 3 && pn < 7) gdst = ws_bf(P, WS_G) + (pn - 3) * 256; }
        const float* hg = nullptr; f32x4 hgv[2][2];
        if (ODD && pn < 5) { hg = (pn < 4 ? P.in[I_WQHG] : P.in[I_WKHG]) + li * 64;
#pragma unroll
            for (int bj = 0; bj < 2; ++bj)
#pragma unroll
                for (int n = 0; n < 2; ++n) hgv[bj][n] = *(const f32x4*)(hg + 32 * bj + 16 * n + 4 * fq); }
        if (!ODD && kind == K_CKV) {
#pragma unroll
            for (int ai = 0; ai < 2; ++ai)
#pragma unroll
                for (int m = 0; m < 4; ++m) { const int row = EPI_ROW(ai, m); const float rs = row_rstd(SS, row); float s = 0.f;
#pragma unroll
                    for (int bj = 0; bj < 2; ++bj)
#pragma unroll
                        for (int n = 0; n < 2; ++n) s += sum4sq(acc[ai][bj][m][n] * rs + bv[bj][n]);
                    s = fq_sum(s); if (fq == 0) xch[(ai * 128 + wr * 64 + m * 16 + fr) * 4 + wc] = s; }
            asm volatile("s_waitcnt lgkmcnt(0)" ::: "memory"); __builtin_amdgcn_s_barrier(); asm volatile("" ::: "memory");
        }
#pragma unroll
        for (int ai = 0; ai < 2; ++ai)
#pragma unroll
            for (int m = 0; m < 4; ++m) {
                const int row = EPI_ROW(ai, m); const float rs = row_rstd(SS, row);
                f32x4 v[2][2];
#pragma unroll
                for (int bj = 0; bj < 2; ++bj)
#pragma unroll
                    for (int n = 0; n < 2; ++n) v[bj][n] = acc[ai][bj][m][n] * rs + bv[bj][n];
                const int t = (row - NP_ROWS) & 4095, pr = t >> 6, pc = t & 63;
                if (kind == K_NAT_G) {
#pragma unroll
                    for (int bj = 0; bj < 2; ++bj) { f32x4 a = v[bj][0], b = v[bj][1];
#pragma unroll
                        for (int e = 0; e < 4; ++e) { a[e] = silu_f(a[e]); b[e] = silu_f(b[e]); }
                        *(u32x4*)(gdst + (size_t)row * 1024 + 128 * bj + 32 * wc + 8 * fq) = pk8(a, b); }
                } else if (kind == K_ROPEHEAD) {
                    if (ODD) {
                        float s = 0.f;
#pragma unroll
                        for (int bj = 0; bj < 2; ++bj) s += sum4sq(v[bj][0]) + sum4sq(v[bj][1]);
                        s = fq_sum(s); const float hr = 1.0f / sqrtf(s * (1.f / 64.f) + EPS);
#pragma unroll
                        for (int bj = 0; bj < 2; ++bj)
#pragma unroll
                            for (int n = 0; n < 2; ++n) v[bj][n] = v[bj][n] * hr * hgv[bj][n];
                        if (pn == 4 && !sample) { float* ok = P.out + (layer == 1 ? O_L1K : O_L3K) + (size_t)row * 256 + wc * 64;
#pragma unroll
                            for (int bj = 0; bj < 2; ++bj)
#pragma unroll
                                for (int n = 0; n < 2; ++n) *(f32x4*)(ok + 32 * bj + 16 * n + 4 * fq) = v[bj][n]; }
                        if (sample) { rope4(v[0][0], v[0][1], r16 + (pr * 16 + 4 * fq) * 2); rope4(v[1][0], v[1][1], r16 + (pc * 16 + 4 * fq) * 2); }
                        if (pn < 4) { const float qs = 0.125f * LOG2E; bf16_t* q = ws_bf(P, WS_QW) + (size_t)row * 1024 + (4 * pn + wc) * 64 + 16 * fq;
                            *(u32x4*)(q) = pk8(v[0][0] * qs, v[0][1] * qs); *(u32x4*)(q + 8) = pk8(v[1][0] * qs, v[1][1] * qs);
                        } else { int kin; const int tile = kv_tile(row, wc, 4, kin); unsigned char* kb = P.ws + WS_KWIMG + (size_t)tile * 8192 + kin * 16;
                            *(u32x4*)(kb + (2 * fq) * 1024) = pk8(v[0][0], v[0][1]); *(u32x4*)(kb + (2 * fq + 1) * 1024) = pk8(v[1][0], v[1][1]); }
                    } else {
                        if (pn == 7) {
#pragma unroll
                            for (int bj = 0; bj < 2; ++bj) { v[bj][0] = v[bj][0] * 0.125f; v[bj][1] = v[bj][1] * 0.125f; } }
                        if (sample) { rope4(v[0][0], v[0][1], r16 + (pr * 16 + 4 * fq) * 2); rope4(v[1][0], v[1][1], r16 + (pc * 16 + 4 * fq) * 2); }
                        bf16_t* q = ws_bf(P, pn == 7 ? WS_RQ : WS_RK) + (size_t)row * 256 + wc * 64 + 16 * fq;
                        *(u32x4*)(q) = pk8(v[0][0], v[0][1]); *(u32x4*)(q + 8) = pk8(v[1][0], v[1][1]);
                    }
                } else if (kind == K_V) {
                    if (!sample) { float* ov = P.out + (layer == 1 ? O_L1V : O_L3V) + (size_t)row * 256 + wc * 64 + 16 * fq;
#pragma unroll
                        for (int bj = 0; bj < 2; ++bj) { *(f32x4*)(ov + 8 * bj) = v[bj][0]; *(f32x4*)(ov + 8 * bj + 4) = v[bj][1]; } }
                    int kin; const int tile = kv_tile(row, wc, 4, kin); unsigned char* vb = P.ws + WS_VWIMG + (size_t)tile * 8192 + (fq >> 1) * 4096 + kin * 64 + (fq & 1) * 32;
                    *(u32x4*)(vb) = pk8(v[0][0], v[0][1]); *(u32x4*)(vb + 16) = pk8(v[1][0], v[1][1]);
                } else if (kind == K_CQ0 || kind == K_CQ1) {
                    bf16_t* cq = ws_bf(P, WS_CQ) + (size_t)row * 384; float* sscq = ws_f32(P, WS_SSCQ);
                    if (kind == K_CQ0) {
#pragma unroll
                        for (int bj = 0; bj < 2; ++bj) *(u32x4*)(cq + 128 * bj + 32 * wc + 8 * fq) = pk8(v[bj][0], v[bj][1]);
                        float s = sum4sq(v[0][0]) + sum4sq(v[0][1]) + sum4sq(v[1][0]) + sum4sq(v[1][1]); s = fq_sum(s); if (fq == 0) sscq[row * 8 + wc] = s;
                    } else {
                        *(u32x4*)(cq + 256 + 32 * wc + 8 * fq) = pk8(v[0][0], v[0][1]);
                        float s = sum4sq(v[0][0]) + sum4sq(v[0][1]); s = fq_sum(s); if (fq == 0) sscq[row * 8 + 4 + wc] = s;
                        if (wc == 0) {
                            *(u32x4*)(ws_bf(P, WS_KR) + (size_t)row * 32 + 8 * fq) = pk8(v[1][0], v[1][1]);
                            float s2 = sum4sq(v[1][0]) + sum4sq(v[1][1]); s2 = fq_sum(s2); if (fq == 0) ws_f32(P, WS_SSKR)[row] = s2;
                            if (!sample) { float* okr = P.out + (layer == 0 ? O_L0KR : O_L2KR) + (size_t)row * 32 + 16 * (fq >> 1) + 4 * (fq & 1); *(f32x4*)(okr) = v[1][0]; *(f32x4*)(okr + 8) = v[1][1]; }
                        }
                    }
                } else if (kind == K_CKV) {
                    const LAS float* xr = xch + (ai * 128 + wr * 64 + m * 16 + fr) * 4; const float s = (xr[0] + xr[1]) + (xr[2] + xr[3]);
                    const float cr = 1.0f / sqrtf(s * (1.f / 256.f) + EPS); const float* gkv = P.in[I_KVNG] + li * 256;
#pragma unroll
                    for (int bj = 0; bj < 2; ++bj) { const int col = 128 * bj + 32 * wc + 8 * fq;
                        const f32x4 a = v[bj][0] * cr * *(const f32x4*)(gkv + col), b = v[bj][1] * cr * *(const f32x4*)(gkv + col + 4);
                        *(u32x4*)(ws_bf(P, WS_CKVN) + (size_t)row * 256 + col) = pk8(a, b);
                        if (!sample) { float* oc = P.out + (layer == 0 ? O_L0CKV : O_L2CKV) + (size_t)row * 256 + col; *(f32x4*)(oc) = a; *(f32x4*)(oc + 4) = b; } }
                } else {
                    bf16_t* rv = ws_bf(P, WS_RV) + (size_t)row * 512 + (2 * (pn - 9) + (wc >> 1)) * 128 + 64 * (wc & 1) + 16 * fq;
                    *(u32x4*)(rv) = pk8(v[0][0], v[0][1]); *(u32x4*)(rv + 8) = pk8(v[1][0], v[1][1]);
                }
            }
        if (!ODD && kind == K_CKV) { asm volatile("s_waitcnt lgkmcnt(0)" ::: "memory"); __builtin_amdgcn_s_barrier(); asm volatile("" ::: "memory"); }
    }
};

struct EpiUq {
    static constexpr bool PERM = false, AFTER_DRAIN = false;
    CParams* Pp; int layer;
    __device__ __forceinline__ void operator()(const AccT& acc, const pg8::Unit& u, int wr, int wc, int fr_, int fq_) const {
        const int ln_ = lane_id(); const int fr = ln_ & 15, fq = ln_ >> 4; (void)fr_; (void)fq_;
        CParams* Pl = Pp; asm volatile("" : "+s"(Pl)); CParams& P = *Pl;
        bf16_t* QR = ws_bf(P, WS_QR); const float* sscq = ws_f32(P, WS_SSCQ);
#pragma unroll
        for (int ai = 0; ai < 2; ++ai)
#pragma unroll
            for (int m = 0; m < 4; ++m) { const int row = EPI_ROW(ai, m);
                float s = sum4sq(acc[ai][0][m][0]) + sum4sq(acc[ai][0][m][1]) + sum4sq(acc[ai][1][m][0]) + sum4sq(acc[ai][1][m][1]);
                if (u.pn < 2) { const int head = 4 * u.pn + wc; bf16_t* q = QR + ((size_t)row * 8 + head) * 96 + 16 * fq;
                    *(u32x4*)(q) = pk8(acc[ai][0][m][0], acc[ai][0][m][1]); *(u32x4*)(q + 8) = pk8(acc[ai][1][m][0], acc[ai][1][m][1]);
                    s = fq_sum(s);
                    if (fq == 0) { float c = 0.f;
#pragma unroll
                        for (int j = 0; j < 8; ++j) c += sscq[row * 8 + j];
                        ws_f32(P, WS_SSQN)[row * 8 + head] = s + 96.f * EPS * (c * (1.f / 384.f) + EPS); }
                } else { const int head = 2 * wc + (fq >> 1); bf16_t* q = QR + ((size_t)row * 8 + head) * 96 + 64 + 16 * (fq & 1);
                    *(u32x4*)(q) = pk8(acc[ai][0][m][0], acc[ai][0][m][1]); *(u32x4*)(q + 8) = pk8(acc[ai][1][m][0], acc[ai][1][m][1]);
                    s += xor_shfl<16>(s);
                    if ((fq & 1) == 0) ws_f32(P, WS_SSQR)[row * 8 + head] = s; }
            }
    }
};

struct EpiUkv {
    static constexpr bool PERM = false, AFTER_DRAIN = false;
    CParams* Pp; int layer;
    __device__ __forceinline__ void operator()(const AccT& acc, const pg8::Unit& u, int wr, int wc, int fr_, int fq_) const {
        const int ln_ = lane_id(); const int fr = ln_ & 15, fq = ln_ >> 4; (void)fr_; (void)fq_;
        CParams* Pl = Pp; asm volatile("" : "+s"(Pl)); CParams& P = *Pl;
        const int li = layer >> 1; const float* gk = P.in[I_KHG] + li * 96; const float* r8 = ws_f32(P, WS_ROPE8); const float* sskr = ws_f32(P, WS_SSKR); const bf16_t* KR = ws_bf(P, WS_KR);
        const bool lat = (u.pm >= 32 && u.pm < 96);
#pragma unroll
        for (int ai = 0; ai < 2; ++ai)
#pragma unroll
            for (int m = 0; m < 4; ++m) { const int R = EPI_ROW(ai, m);
                if (u.pn < 2) { const int head = 4 * u.pn + wc; int kin; const int tile = kv_tile(R, head, 8, kin); unsigned char* kb = P.ws + WS_KIMG + (size_t)tile * 12288 + kin * 16;
                    float s = sum4sq(acc[ai][0][m][0]) + sum4sq(acc[ai][0][m][1]) + sum4sq(acc[ai][1][m][0]) + sum4sq(acc[ai][1][m][1]);
                    s = fq_sum(s) + sskr[R]; const float rs = 1.0f / sqrtf(s * (1.f / 96.f) + EPS);
#pragma unroll
                    for (int bj = 0; bj < 2; ++bj) { const float* g = gk + 16 * fq + 8 * bj;
                        *(u32x4*)(kb + (2 * fq + bj) * 1024) = pk8(acc[ai][bj][m][0] * rs * *(const f32x4*)(g), acc[ai][bj][m][1] * rs * *(const f32x4*)(g + 4)); }
                    const u32x4 kr = *(const u32x4*)(KR + (size_t)R * 32 + 8 * fq); const int jb = 16 * (fq >> 1) + 4 * (fq & 1);
                    f32x4 x1 = {__uint_as_float(kr.x << 16), __uint_as_float(kr.x & 0xffff0000u), __uint_as_float(kr.y << 16), __uint_as_float(kr.y & 0xffff0000u)};
                    f32x4 x2 = {__uint_as_float(kr.z << 16), __uint_as_float(kr.z & 0xffff0000u), __uint_as_float(kr.w << 16), __uint_as_float(kr.w & 0xffff0000u)};
                    x1 = x1 * rs * *(const f32x4*)(gk + 64 + jb); x2 = x2 * rs * *(const f32x4*)(gk + 64 + jb + 8);
                    if (lat) { const int t = (R - NP_ROWS) & 4095; const int pos = (fq >> 1) ? (t & 63) : (t >> 6); rope4(x1, x2, r8 + (pos * 8 + 4 * (fq & 1)) * 2); }
                    *(u32x4*)(kb + (8 + fq) * 1024) = pk8(x1, x2);
                } else { const int head = 4 * (u.pn - 2) + wc; int kin; const int tile = kv_tile(R, head, 8, kin);
                    unsigned char* vb = P.ws + WS_VIMG + (size_t)tile * 8192 + (fq >> 1) * 4096 + kin * 64 + (fq & 1) * 32;
                    *(u32x4*)(vb) = pk8(acc[ai][0][m][0], acc[ai][0][m][1]); *(u32x4*)(vb + 16) = pk8(acc[ai][1][m][0], acc[ai][1][m][1]); }
            }
    }
};
typedef short bf16x8 __attribute__((ext_vector_type(8)));
typedef float f32x16 __attribute__((ext_vector_type(16)));
typedef short v4i16_t __attribute__((ext_vector_type(4)));
__device__ __forceinline__ int crow(int r, int hi) { return (r & 3) + 8 * (r >> 2) + 4 * hi; }
__device__ __forceinline__ v4i16_t vtr(const LAS unsigned char* p) { return __builtin_amdgcn_ds_read_tr16_b64_v4i16((LAS v4i16_t*)p); }
#define ATT_BAR() asm volatile("s_waitcnt vmcnt(0) lgkmcnt(0)\n\ts_barrier" ::: "memory")

constexpr int AT_K0 = 0, AT_KSZ = 12288, AT_V0 = 2 * AT_KSZ, AT_VSZ = 8192, AT_WS = AT_V0 + 2 * AT_VSZ, AT_OST = AT_WS + 8 * 256, AT_END = AT_OST + 8 * 4096;
static_assert(AT_END <= RING_BYTES, "attention LDS map");

struct AttnTiles { const unsigned char* kbase; const unsigned char* vbase; int a0, nA, b0, nB; };

template <int DQK>
__device__ __forceinline__ void attn_unit(LAS unsigned char* lds, const AttnTiles& T, const bf16x8 (&qf)[DQK / 16], float bnd, int maskq, int klo, int qb,
                                          f32x16 (&o)[2], float& lsum, int wave, int lane, int tid) {
    constexpr int KT = DQK * 128;
    constexpr int NS = DQK / 16;
    const int r = lane & 31, hh = lane >> 5;
    const int nT = T.nA + T.nB;
    u32x4 kr0, kr1 = {0u, 0u, 0u, 0u}, vr;
    const bool k2 = (DQK == 96) && (tid < 256);
#define AT_TILE(i) ((i) < T.nA ? T.a0 + (i) : T.b0 + ((i) - T.nA))
#define AT_LOAD(i) do { const int ti_ = AT_TILE(i); const unsigned char* kp_ = T.kbase + (size_t)ti_ * KT; kr0 = *(const u32x4*)(kp_ + tid * 16); \
        if (k2) kr1 = *(const u32x4*)(kp_ + 8192 + tid * 16); vr = *(const u32x4*)(T.vbase + (size_t)ti_ * 8192 + tid * 16); } while (0)
#define AT_STORE(b) do { *(LAS u32x4*)(lds + AT_K0 + (b) * AT_KSZ + tid * 16) = kr0; if (k2) *(LAS u32x4*)(lds + AT_K0 + (b) * AT_KSZ + 8192 + tid * 16) = kr1; \
        *(LAS u32x4*)(lds + AT_V0 + (b) * AT_VSZ + tid * 16) = vr; } while (0)
    f32x16 negb;
#pragma unroll
    for (int i = 0; i < 16; ++i) negb[i] = -bnd;
    AT_LOAD(0); AT_STORE(0); ATT_BAR();
    for (int it = 0; it < nT; ++it) {
        const int cur = it & 1;
        const bool more = it + 1 < nT;
        if (more) AT_LOAD(it + 1);
        const LAS unsigned char* kb = lds + AT_K0 + cur * AT_KSZ + hh * 1024 + r * 16;
        f32x16 p0 = negb, p1 = negb;
#pragma unroll
        for (int s = 0; s < NS; ++s) {
            const bf16x8 k0 = *(const LAS bf16x8*)(kb + s * 2048), k1 = *(const LAS bf16x8*)(kb + s * 2048 + 512);
            p0 = __builtin_amdgcn_mfma_f32_32x32x16_bf16(k0, qf[s], p0, 0, 0, 0);
            p1 = __builtin_amdgcn_mfma_f32_32x32x16_bf16(k1, qf[s], p1, 0, 0, 0);
        }
#pragma unroll
        for (int i = 0; i < 16; ++i) { p0[i] = __builtin_amdgcn_exp2f(p0[i]); p1[i] = __builtin_amdgcn_exp2f(p1[i]); }
        if (maskq >= 0 && it >= T.nA) {
            const int kt = klo + (it - T.nA);
            if (kt == qb - 2 || kt == qb + 2) {
                const int q = maskq + r, k0i = 64 * kt + 4 * hh;
#pragma unroll
                for (int i = 0; i < 16; ++i) { const int d0 = k0i + (i & 3) + 8 * (i >> 2) - q, d1 = d0 + 32;
                    if (d0 > 128 || d0 < -128) p0[i] = 0.f; if (d1 > 128 || d1 < -128) p1[i] = 0.f; }
            }
        }
        { float s0 = 0.f, s1 = 0.f;
#pragma unroll
          for (int i = 0; i < 16; ++i) { s0 += p0[i]; s1 += p1[i]; }
          lsum += s0 + s1; }
        u32x4 pw[4];
#pragma unroll
        for (int j = 0; j < 4; ++j) { pw[0][j] = pk2(p0[2 * j], p0[2 * j + 1]); pw[1][j] = pk2(p0[8 + 2 * j], p0[8 + 2 * j + 1]); pw[2][j] = pk2(p1[2 * j], p1[2 * j + 1]); pw[3][j] = pk2(p1[8 + 2 * j], p1[8 + 2 * j + 1]); }
        const LAS unsigned char* vb = lds + AT_V0 + cur * AT_VSZ + ((lane >> 4) & 1) * 32 + (lane & 3) * 8 + (4 * hh + ((lane & 15) >> 2)) * 64;
#pragma unroll
        for (int d0 = 0; d0 < 2; ++d0)
#pragma unroll
            for (int ks = 0; ks < 4; ++ks) {
                const v4i16_t lo = vtr(vb + d0 * 4096 + ks * 1024), hi = vtr(vb + d0 * 4096 + ks * 1024 + 512);
                const bf16x8 vf = {lo[0], lo[1], lo[2], lo[3], hi[0], hi[1], hi[2], hi[3]};
                o[d0] = __builtin_amdgcn_mfma_f32_32x32x16_bf16(__builtin_bit_cast(bf16x8, pw[ks]), vf, o[d0], 0, 0, 0);
            }
        if (more) AT_STORE(cur ^ 1);
        ATT_BAR();
    }
#undef AT_LOAD
#undef AT_TILE
#undef AT_STORE
}
template <int DQK>
__device__ __forceinline__ void attn_unit_pipe(LAS unsigned char* lds, const AttnTiles& T, const bf16x8 (&qf)[DQK / 16], float bnd, int maskq, int klo, int qb,
                                               f32x16 (&o)[2], float& lsum, int wave, int lane, int tid) {
    constexpr int KT = DQK * 128, NS = DQK / 16;
    const int r = lane & 31, hh = lane >> 5;
    const int nT = T.nA + T.nB;
#define AT_TILE(i) ((i) < T.nA ? T.a0 + (i) : T.b0 + ((i) - T.nA))
#define AT_DMAK(i, b) do { const unsigned char* kp_ = T.kbase + (size_t)AT_TILE(i) * KT + lane * 16; \
        __builtin_amdgcn_global_load_lds((const unsigned*)(kp_ + wave * 1024), (LAS unsigned*)(lds + AT_K0 + (b) * AT_KSZ + wave * 1024), 16, 0, 0); \
        if (wave + 8 < KT / 1024) __builtin_amdgcn_global_load_lds((const unsigned*)(kp_ + (wave + 8) * 1024), (LAS unsigned*)(lds + AT_K0 + (b) * AT_KSZ + (wave + 8) * 1024), 16, 0, 0); } while (0)
#define AT_DMAV(i, b) do { __builtin_amdgcn_global_load_lds((const unsigned*)(T.vbase + (size_t)AT_TILE(i) * 8192 + wave * 1024 + lane * 16), (LAS unsigned*)(lds + AT_V0 + (b) * AT_VSZ + wave * 1024), 16, 0, 0); } while (0)
    f32x16 negb;
#pragma unroll
    for (int i = 0; i < 16; ++i) negb[i] = -bnd;
    const LAS unsigned char* kb0 = lds + AT_K0 + hh * 1024 + r * 16;
    const LAS unsigned char* vb0 = lds + AT_V0 + ((lane >> 4) & 1) * 32 + (lane & 3) * 8 + (4 * hh + ((lane & 15) >> 2)) * 64;
#define AT_QK(P0, P1, buf) do { const LAS unsigned char* kb_ = kb0 + (buf) * AT_KSZ; P0 = negb; P1 = negb; \
        _Pragma("unroll") for (int s = 0; s < NS; ++s) { const bf16x8 k0_ = *(const LAS bf16x8*)(kb_ + s * 2048), k1_ = *(const LAS bf16x8*)(kb_ + s * 2048 + 512); \
            P0 = __builtin_amdgcn_mfma_f32_32x32x16_bf16(k0_, qf[s], P0, 0, 0, 0); P1 = __builtin_amdgcn_mfma_f32_32x32x16_bf16(k1_, qf[s], P1, 0, 0, 0); } } while (0)
#define AT_SOFT(P0, P1, it) do { \
        _Pragma("unroll") for (int i = 0; i < 16; ++i) { P0[i] = __builtin_amdgcn_exp2f(P0[i]); P1[i] = __builtin_amdgcn_exp2f(P1[i]); } \
        if (maskq >= 0 && (it) >= T.nA) { const int kt_ = klo + ((it) - T.nA); \
            if (kt_ == qb - 2 || kt_ == qb + 2) { const int q_ = maskq + r, k0i_ = 64 * kt_ + 4 * hh; \
                _Pragma("unroll") for (int i = 0; i < 16; ++i) { const int d0_ = k0i_ + (i & 3) + 8 * (i >> 2) - q_, d1_ = d0_ + 32; \
                    if (d0_ > 128 || d0_ < -128) P0[i] = 0.f; if (d1_ > 128 || d1_ < -128) P1[i] = 0.f; } } } \
        { float s0_ = 0.f, s1_ = 0.f; _Pragma("unroll") for (int i = 0; i < 16; ++i) { s0_ += P0[i]; s1_ += P1[i]; } lsum += s0_ + s1_; } \
        _Pragma("unroll") for (int j = 0; j < 4; ++j) { pw[0][j] = pk2(P0[2 * j], P0[2 * j + 1]); pw[1][j] = pk2(P0[8 + 2 * j], P0[8 + 2 * j + 1]); pw[2][j] = pk2(P1[2 * j], P1[2 * j + 1]); pw[3][j] = pk2(P1[8 + 2 * j], P1[8 + 2 * j + 1]); } } while (0)
#define AT_PV(buf) do { const LAS unsigned char* vb_ = vb0 + (buf) * AT_VSZ; \
        _Pragma("unroll") for (int d0 = 0; d0 < 2; ++d0) _Pragma("unroll") for (int ks = 0; ks < 4; ++ks) { \
            const v4i16_t lo_ = vtr(vb_ + d0 * 4096 + ks * 1024), hi_ = vtr(vb_ + d0 * 4096 + ks * 1024 + 512); \
            const bf16x8 vf_ = {lo_[0], lo_[1], lo_[2], lo_[3], hi_[0], hi_[1], hi_[2], hi_[3]}; \
            o[d0] = __builtin_amdgcn_mfma_f32_32x32x16_bf16(__builtin_bit_cast(bf16x8, pw[ks]), vf_, o[d0], 0, 0, 0); } } while (0)
#define AT_STEP(PC0, PC1, PN0, PN1, t) do { const int t_ = (t); \
        if (t_ + 2 < nT) AT_DMAK(t_ + 2, t_ & 1); if (t_ + 1 < nT) AT_DMAV(t_ + 1, (t_ + 1) & 1); \
        if (t_ + 1 < nT) AT_QK(PN0, PN1, (t_ + 1) & 1); \
        AT_SOFT(PC0, PC1, t_); \
        AT_PV(t_ & 1); \
        ATT_BAR(); } while (0)
    u32x4 pw[4];
    f32x16 pA0, pA1, pB0, pB1;
    AT_DMAK(0, 0); AT_DMAV(0, 0);
    if (nT > 1) AT_DMAK(1, 1);
    ATT_BAR();
    AT_QK(pA0, pA1, 0);
    ATT_BAR();
    int t = 0;
    for (; t + 1 < nT; t += 2) { AT_STEP(pA0, pA1, pB0, pB1, t); AT_STEP(pB0, pB1, pA0, pA1, t + 1); }
    if (t < nT) { AT_STEP(pA0, pA1, pB0, pB1, t); }
#undef AT_TILE
#undef AT_DMAK
#undef AT_DMAV
#undef AT_QK
#undef AT_SOFT
#undef AT_PV
#undef AT_STEP
}
__device__ __forceinline__ void attn_finish(LAS unsigned char* lds, f32x16 (&o)[2], float lsum, float ladd, bf16_t* G, int row0, int col0, int wave, int lane, bool dry = false) {
    const int r = lane & 31, hh = lane >> 5;
    LAS float* wsf = (LAS float*)(lds + AT_WS) + wave * 64;
    const float l = sum_halves(lsum) + ladd;
    if (hh == 0) wsf[r] = l;
    asm volatile("s_waitcnt lgkmcnt(0)" ::: "memory");
    LAS bf16_t* stg = (LAS bf16_t*)(lds + AT_OST) + wave * 2048;
#pragma unroll
    for (int i = 0; i < 16; ++i) { const int orow = crow(i, hh); const float rl = __builtin_amdgcn_rcpf(wsf[orow]);
#pragma unroll
        for (int d0 = 0; d0 < 2; ++d0) stg[orow * 64 + d0 * 32 + r] = f2bf(o[d0][i] * rl); }
    asm volatile("s_waitcnt lgkmcnt(0)" ::: "memory");
#pragma unroll
    for (int i = 0; i < 4; ++i) { const int row = i * 8 + (lane >> 3), ch = lane & 7;
        const u32x4 v = *(const LAS u32x4*)(stg + row * 64 + ch * 8); bf16_t* gp = G + (size_t)(row0 + row) * 1024 + col0 + ch * 8; const u32x4 g = *(const u32x4*)gp;
        u32x4 w;
#pragma unroll
        for (int j = 0; j < 4; ++j) { const float a0 = __uint_as_float(v[j] << 16) * __uint_as_float(g[j] << 16), a1 = __uint_as_float(v[j] & 0xffff0000u) * __uint_as_float(g[j] & 0xffff0000u); w[j] = pk2(a0, a1); }
        if (!dry) *(u32x4*)gp = w; else asm volatile("" :: "v"(w)); }
    asm volatile("s_waitcnt lgkmcnt(0)" ::: "memory");
}
__device__ __forceinline__ f32x4 unpk_lo(const u32x4& v) { return (f32x4){__uint_as_float(v.x << 16), __uint_as_float(v.x & 0xffff0000u), __uint_as_float(v.y << 16), __uint_as_float(v.y & 0xffff0000u)}; }
__device__ __forceinline__ f32x4 unpk_hi(const u32x4& v) { return (f32x4){__uint_as_float(v.z << 16), __uint_as_float(v.z & 0xffff0000u), __uint_as_float(v.w << 16), __uint_as_float(v.w & 0xffff0000u)}; }

__device__ __forceinline__ void mla_unit(CParams& P, int layer, LAS unsigned char* lds, bool sample, int b, int h, int qblk, int wave, int lane, int tid, bool dry = false) {
    const int li = layer >> 1, r = lane & 31, hh = lane >> 5;
    const int row0 = (sample ? NP_ROWS + b * 4096 + qblk * 256 : b * 256) + wave * 32, row = row0 + r;
    bf16x8 qf[6];
    { const bf16_t* QR = ws_bf(P, WS_QR) + ((size_t)row * 8 + h) * 96; const float* gq = P.in[I_QHG] + li * 96; const float* r8 = ws_f32(P, WS_ROPE8);
      const float ss = ws_f32(P, WS_SSQN)[row * 8 + h] + ws_f32(P, WS_SSQR)[row * 8 + h]; const float rs = 1.0f / sqrtf(ss * (1.f / 96.f)); const float qs = 0.10206207261596575f * LOG2E;
      const int t = (row - NP_ROWS) & 4095;
#pragma unroll
      for (int s = 0; s < 6; ++s) { const u32x4 raw = *(const u32x4*)(QR + 16 * s + 8 * hh); f32x4 x0 = unpk_lo(raw), x1 = unpk_hi(raw);
          if (s < 4) { const float* g = gq + 16 * s + 8 * hh; x0 = x0 * rs * *(const f32x4*)(g); x1 = x1 * rs * *(const f32x4*)(g + 4); }
          else { const int base = 16 * (s - 4) + 4 * hh; x0 = x0 * rs * *(const f32x4*)(gq + 64 + base); x1 = x1 * rs * *(const f32x4*)(gq + 64 + base + 8);
              if (sample) { const int pos = (s == 4) ? (t >> 6) : (t & 63); rope4(x0, x1, r8 + (pos * 8 + 4 * hh) * 2); } }
          qf[s] = __builtin_bit_cast(bf16x8, pk8(x0 * qs, x1 * qs)); } }
    AttnTiles T; T.kbase = P.ws + WS_KIMG; T.vbase = P.ws + WS_VIMG; T.a0 = kv_seq_tile0(sample, b, h, 8); T.nA = sample ? 72 : 4; T.b0 = 0; T.nB = 0;
    f32x16 o[2]; float lsum = 0.f;
#pragma unroll
    for (int i = 0; i < 16; ++i) { o[0][i] = 0.f; o[1][i] = 0.f; }
    attn_unit_pipe<96>(lds, T, qf, ws_f32(P, WS_BND)[li], -1, 0, 0, o, lsum, wave, lane, tid);
    attn_finish(lds, o, lsum, 0.f, ws_bf(P, WS_G), row0, h * 64, wave, lane, dry);
}
__device__ __forceinline__ void mla_phase(CParams& P, int layer, LAS unsigned char* lds, int wave) {
    const int lane = lane_id(), tid = wave * 64 + lane;
    const int G = gridDim.x, bx = blockIdx.x; const int vcu = (G % 8 == 0) ? (bx % 8) * (G / 8) + bx / 8 : bx;
#ifndef DRY_MLA
#define DRY_MLA 0
#endif
    for (int rep = 0; rep <= DRY_MLA; ++rep) { const bool dry = rep < DRY_MLA;
    for (int u = vcu * 2; u < 512; u += 2 * G)
        for (int j = 0; j < 2; ++j) { const int uu = u + j; mla_unit(P, layer, lds, true, (uu >> 4) >> 3, (uu >> 4) & 7, uu & 15, wave, lane, tid, dry); }
    for (int u = vcu; u < 256; u += G) mla_unit(P, layer, lds, false, u >> 3, u & 7, 0, wave, lane, tid, dry); }
}
__device__ __forceinline__ void win_unit(CParams& P, int layer, LAS unsigned char* lds, bool sample, int b, int kvh, int qb, int wave, int lane, int tid, bool dry = false) {
    const int li = layer >> 1, r = lane & 31, hh = lane >> 5; const int head = 4 * kvh + (wave >> 1);
    const int qlat = qb * 64 + (wave & 1) * 32;
    const int row0 = (sample ? NP_ROWS + b * 4096 : b * 256) + qlat, row = row0 + r;
    bf16x8 qf[4];
    { const bf16_t* q = ws_bf(P, WS_QW) + (size_t)row * 1024 + head * 64 + 8 * hh;
#pragma unroll
      for (int s = 0; s < 4; ++s) qf[s] = *(const bf16x8*)(q + 16 * s); }
    const float* bf = ws_f32(P, WS_BND); const float knorm = fmaxf(8.f * bf[10 + li], sqrtf(bf[4 + li])); const float bnd = 0.125f * LOG2E * 8.f * bf[8 + li] * knorm;
    AttnTiles T; T.kbase = P.ws + WS_KWIMG; T.vbase = P.ws + WS_VWIMG; const int t0 = kv_seq_tile0(sample, b, kvh, 4);
    int klo = 0;
    if (sample) { klo = max(qb - 2, 0); const int khi = min(qb + 2, 63); T.a0 = t0; T.nA = 8; T.b0 = t0 + 8 + klo; T.nB = khi - klo + 1; }
    else { T.a0 = t0; T.nA = 4; T.b0 = 0; T.nB = 0; }
    f32x16 o[2]; float lsum = 0.f;
#pragma unroll
    for (int i = 0; i < 16; ++i) { o[0][i] = 0.f; o[1][i] = 0.f; }
    attn_unit_pipe<64>(lds, T, qf, bnd, sample ? qlat : -1, klo, qb, o, lsum, wave, lane, tid);
    attn_finish(lds, o, lsum, __builtin_amdgcn_exp2f(P.in[I_SINK][li * 16 + head] * LOG2E - bnd), ws_bf(P, WS_G), row0, head * 64, wave, lane, dry);
}
__device__ __forceinline__ void win_phase(CParams& P, int layer, LAS unsigned char* lds, int wave) {
    const int lane = lane_id(), tid = wave * 64 + lane;
    const int G = gridDim.x, bx = blockIdx.x; const int vcu = (G % 8 == 0) ? (bx % 8) * (G / 8) + bx / 8 : bx;
#ifndef DRY_WIN
#define DRY_WIN 0
#endif
    for (int rep = 0; rep <= DRY_WIN; ++rep) { const bool dry = rep < DRY_WIN;
    for (int u = vcu * 4; u < 1024; u += 4 * G)
        for (int j = 0; j < 4; ++j) { const int uu = u + j; win_unit(P, layer, lds, true, (uu >> 6) >> 2, (uu >> 6) & 3, uu & 63, wave, lane, tid, dry); }
    for (int u = vcu * 2; u < 512; u += 2 * G)
        for (int j = 0; j < 2; ++j) { const int uu = u + j; win_unit(P, layer, lds, false, (uu >> 2) >> 2, (uu >> 2) & 3, uu & 3, wave, lane, tid, dry); } }
}
#define RET_BAR() asm volatile("s_waitcnt vmcnt(0) lgkmcnt(0)\n\ts_barrier" ::: "memory")
__device__ __forceinline__ bf16x8 tr_frag(const LAS unsigned char* p, int hi_off) { const v4i16_t lo = vtr(p), hi = vtr(p + hi_off); return (bf16x8){lo[0], lo[1], lo[2], lo[3], hi[0], hi[1], hi[2], hi[3]}; }

constexpr int RU_KF = 0, RU_KB = 16384, RU_V = 32768;
__device__ __forceinline__ void ret_u_unit(CParams& P, int layer, LAS unsigned char* lds, int c, int h, int wave, int lane, int tid) {
    const int r0 = chunk_row0(c); const float lgf = log_gamma(P, layer, 0, h), lgb = log_gamma(P, layer, 1, h);
    const bf16_t* RK = ws_bf(P, WS_RK); const bf16_t* RV = ws_bf(P, WS_RV);
#pragma unroll
    for (int j = 0; j < 2; ++j) { const int q = tid + 512 * j, i = q >> 3, pc = q & 7; const u32x4 raw = *(const u32x4*)(RK + (size_t)(r0 + i) * 256 + h * 64 + 8 * pc);
        const float wf = __expf(lgf * (float)(127 - i)), wb = __expf(lgb * (float)i); const f32x4 a = unpk_lo(raw), b = unpk_hi(raw);
        const int off = (pc >> 2) * 8192 + i * 64 + (pc & 3) * 16;
        *(LAS u32x4*)(lds + RU_KF + off) = pk8(a * wf, b * wf); *(LAS u32x4*)(lds + RU_KB + off) = pk8(a * wb, b * wb); }
#pragma unroll
    for (int j = 0; j < 4; ++j) { const int q = tid + 512 * j, i = q >> 4, vc = q & 15;
        *(LAS u32x4*)(lds + RU_V + (vc >> 2) * 8192 + i * 64 + (vc & 3) * 16) = *(const u32x4*)(RV + (size_t)(r0 + i) * 512 + h * 128 + 8 * vc); }
    RET_BAR();
    const int hh = lane >> 5, r = lane & 31, dir = wave >> 2, pblk = (wave >> 1) & 1, db = 2 * (wave & 1);
    const int lp = ((lane >> 4) & 1) * 32 + (lane & 3) * 8 + (4 * hh + ((lane & 15) >> 2)) * 64;
    const LAS unsigned char* ka = lds + (dir ? RU_KB : RU_KF) + pblk * 8192 + lp; const LAS unsigned char* vb = lds + RU_V + db * 8192 + lp;
    f32x16 acc[2];
#pragma unroll
    for (int i = 0; i < 16; ++i) { acc[0][i] = 0.f; acc[1][i] = 0.f; }
#pragma unroll
    for (int s = 0; s < 8; ++s) { const bf16x8 a = tr_frag(ka + s * 1024, 512);
        acc[0] = __builtin_amdgcn_mfma_f32_32x32x16_bf16(a, tr_frag(vb + s * 1024, 512), acc[0], 0, 0, 0);
        acc[1] = __builtin_amdgcn_mfma_f32_32x32x16_bf16(a, tr_frag(vb + 8192 + s * 1024, 512), acc[1], 0, 0, 0); }
    unsigned char* U = ur_ptr(P, c, h, dir);
#pragma unroll
    for (int d = 0; d < 2; ++d)
#pragma unroll
        for (int i = 0; i < 16; ++i) *(bf16_t*)(U + (size_t)(db + d) * 4096 + (32 * pblk + crow(i, hh)) * 64 + r * 2) = f2bf(acc[d][i]);
    RET_BAR();
}
__device__ __forceinline__ void ret_u_phase(CParams& P, int layer, LAS unsigned char* lds, int wave) {
    const int lane = lane_id(), tid = wave * 64 + lane;
    for (int u = blockIdx.x; u < 768; u += gridDim.x) ret_u_unit(P, layer, lds, u >> 2, u & 3, wave, lane, tid);
}

constexpr int RO_K = 0, RO_V = 16384, RO_RF = 49152, RO_RB = 65536, RO_X = 81920;
__device__ __forceinline__ void ret_out_unit(CParams& P, int layer, LAS unsigned char* lds, int c, int h, int wave, int lane, int tid, bool dry = false) {
    const int r0 = chunk_row0(c); const float lgf = log_gamma(P, layer, 0, h), lgb = log_gamma(P, layer, 1, h);
    const bf16_t* RQ = ws_bf(P, WS_RQ); const bf16_t* RK = ws_bf(P, WS_RK); const bf16_t* RV = ws_bf(P, WS_RV);
#pragma unroll
    for (int j = 0; j < 2; ++j) { const int q = tid + 512 * j, i = q >> 3, pc = q & 7;
        *(LAS u32x4*)(lds + RO_K + pc * 2048 + i * 16) = *(const u32x4*)(RK + (size_t)(r0 + i) * 256 + h * 64 + 8 * pc); }
#pragma unroll
    for (int j = 0; j < 4; ++j) { const int q = tid + 512 * j, i = q >> 4, vc = q & 15;
        *(LAS u32x4*)(lds + RO_V + (vc >> 2) * 8192 + i * 64 + (vc & 3) * 16) = *(const u32x4*)(RV + (size_t)(r0 + i) * 512 + h * 128 + 8 * vc); }
    { const unsigned char* Rf = ur_ptr(P, c, h, 0); const unsigned char* Rb = ur_ptr(P, c, h, 1);
#pragma unroll
      for (int j = 0; j < 2; ++j) { const int q = tid + 512 * j; *(LAS u32x4*)(lds + RO_RF + q * 16) = *(const u32x4*)(Rf + q * 16); *(LAS u32x4*)(lds + RO_RB + q * 16) = *(const u32x4*)(Rb + q * 16); } }
    RET_BAR();
    const int hh = lane >> 5, r = lane & 31, ib = wave & 3, dvh = wave >> 2;
    const int ii = 32 * ib + r, row = r0 + ii;
    bf16x8 qf[4], qwf[4], qwb[4];
    { const float wf = __expf(lgf * (float)(ii + 1)), wb = __expf(lgb * (float)(128 - ii)); const bf16_t* q = RQ + (size_t)row * 256 + h * 64 + 8 * hh;
#pragma unroll
      for (int s = 0; s < 4; ++s) { const u32x4 raw = *(const u32x4*)(q + 16 * s); qf[s] = __builtin_bit_cast(bf16x8, raw); const f32x4 a = unpk_lo(raw), b = unpk_hi(raw);
          qwf[s] = __builtin_bit_cast(bf16x8, pk8(a * wf, b * wf)); qwb[s] = __builtin_bit_cast(bf16x8, pk8(a * wb, b * wb)); } }
    f32x16 acc[2];
#pragma unroll
    for (int i = 0; i < 16; ++i) { acc[0][i] = 0.f; acc[1][i] = 0.f; }
    { const int lpn = ((lane >> 4) & 1) * 32 + (lane & 3) * 8 + (8 * hh + ((lane & 15) >> 2)) * 64;
#pragma unroll
      for (int d = 0; d < 2; ++d) { const LAS unsigned char* rf = lds + RO_RF + (2 * dvh + d) * 4096 + lpn; const LAS unsigned char* rb = lds + RO_RB + (2 * dvh + d) * 4096 + lpn;
#pragma unroll
          for (int s = 0; s < 4; ++s) { acc[d] = __builtin_amdgcn_mfma_f32_32x32x16_bf16(tr_frag(rf + s * 1024, 256), qwf[s], acc[d], 0, 0, 0);
              acc[d] = __builtin_amdgcn_mfma_f32_32x32x16_bf16(tr_frag(rb + s * 1024, 256), qwb[s], acc[d], 0, 0, 0); } } }
    { const LAS unsigned char* kb = lds + RO_K + hh * 2048 + r * 16;
      const int lpp = ((lane >> 4) & 1) * 32 + (lane & 3) * 8 + (4 * hh + ((lane & 15) >> 2)) * 64;
#pragma unroll
      for (int jb = 0; jb < 4; ++jb) {
          f32x16 st;
#pragma unroll
          for (int i = 0; i < 16; ++i) st[i] = 0.f;
#pragma unroll
          for (int s = 0; s < 4; ++s) st = __builtin_amdgcn_mfma_f32_32x32x16_bf16(*(const LAS bf16x8*)(kb + s * 4096 + jb * 512), qf[s], st, 0, 0, 0);
#pragma unroll
          for (int i = 0; i < 16; ++i) { const int j = 32 * jb + crow(i, hh); const int dl = ii - j;
              const float D = dl > 0 ? __expf(lgf * (float)dl) : (dl < 0 ? __expf(lgb * (float)(-dl)) : 2.f); st[i] *= D; }
          u32x4 pw0, pw1;
#pragma unroll
          for (int j = 0; j < 4; ++j) { pw0[j] = pk2(st[2 * j], st[2 * j + 1]); pw1[j] = pk2(st[8 + 2 * j], st[8 + 2 * j + 1]); }
#pragma unroll
          for (int d = 0; d < 2; ++d) { const LAS unsigned char* vb = lds + RO_V + (2 * dvh + d) * 8192 + lpp + jb * 2048;
              acc[d] = __builtin_amdgcn_mfma_f32_32x32x16_bf16(tr_frag(vb, 512), __builtin_bit_cast(bf16x8, pw0), acc[d], 0, 0, 0);
              acc[d] = __builtin_amdgcn_mfma_f32_32x32x16_bf16(tr_frag(vb + 1024, 512), __builtin_bit_cast(bf16x8, pw1), acc[d], 0, 0, 0); }
      } }
    LAS float* X = (LAS float*)(lds + RO_X);
    float s = 0.f;
#pragma unroll
    for (int i = 0; i < 16; ++i) s += acc[0][i] + acc[1][i];
    s = sum_halves(s); if (hh == 0) X[dvh * 128 + ii] = s;
    RET_BAR();
    const float mu = (X[ii] + X[128 + ii]) * (1.f / 128.f);
    float v = 0.f;
#pragma unroll
    for (int i = 0; i < 16; ++i) { const float a = acc[0][i] - mu, b = acc[1][i] - mu; v += a * a + b * b; }
    v = sum_halves(v);
    RET_BAR();
    if (hh == 0) X[dvh * 128 + ii] = v;
    RET_BAR();
    const float rs = 1.0f / sqrtf((X[ii] + X[128 + ii]) * (1.f / 128.f) + EPS);
    const float* gn_ = P.in[I_RNG] + (layer >> 1) * 512 + h * 128; bf16_t* G = ws_bf(P, WS_G) + (size_t)row * 1024 + 512 + h * 128;
#pragma unroll
    for (int d = 0; d < 2; ++d)
#pragma unroll
        for (int a = 0; a < 4; ++a) { const int dv = 32 * (2 * dvh + d) + 8 * a + 4 * hh; const f32x4 gv = *(const f32x4*)(gn_ + dv); const u32x2 gg = *(const u32x2*)(G + dv);
            const float g0 = __uint_as_float(gg.x << 16), g1 = __uint_as_float(gg.x & 0xffff0000u), g2 = __uint_as_float(gg.y << 16), g3 = __uint_as_float(gg.y & 0xffff0000u);
            u32x2 w; w.x = pk2((acc[d][4 * a] - mu) * rs * gv[0] * g0, (acc[d][4 * a + 1] - mu) * rs * gv[1] * g1); w.y = pk2((acc[d][4 * a + 2] - mu) * rs * gv[2] * g2, (acc[d][4 * a + 3] - mu) * rs * gv[3] * g3);
            if (!dry) *(u32x2*)(G + dv) = w; else asm volatile("" :: "v"(w)); }
    RET_BAR();
}
__device__ __forceinline__ void ret_out_phase(CParams& P, int layer, LAS unsigned char* lds, int wave) {
    const int lane = lane_id(), tid = wave * 64 + lane;
#ifndef DRY_RET
#define DRY_RET 0
#endif
    for (int rep = 0; rep <= DRY_RET; ++rep)
    for (int u = blockIdx.x; u < 768; u += gridDim.x) ret_out_unit(P, layer, lds, u >> 2, u & 3, wave, lane, tid, rep < DRY_RET);
}
__device__ __forceinline__ void fast_scan(CParams& P, int layer, int wave) {
    const int lane = lane_id(); const long gt = ((long)blockIdx.x * NWAVES + wave) * 64 + lane, gn = (long)gridDim.x * NTHREADS;
    float* orf = P.out + (layer == 0 ? O_L0RF : O_L2RF); float* orb = P.out + (layer == 0 ? O_L0RB : O_L2RB);
    const float* s0f = P.in[layer == 0 ? I_S0F : I_S2F]; const float* s0b = P.in[layer == 0 ? I_S0B : I_S2B];
    for (long it = gt; it < 288L * 1024; it += gn) {
        const int q = (int)(it & 1023), sd = (int)(it >> 10);
        const int dir = sd & 1, head = (sd >> 1) & 3, sq = sd >> 3;
        const int blk = q >> 8, p = (q >> 2) & 63, dv = 32 * blk + (q & 3) * 8, d = p2d64(p);
        const float gC = __expf(128.f * log_gamma(P, layer, dir, head));
        if (sq < 4) {
            const float* s0 = (dir ? s0b : s0f) + ((size_t)(sq * 4 + head) * 64 + d) * 128 + dv;
            f32x4 Ra = *(const f32x4*)s0, Rb = *(const f32x4*)(s0 + 4);
#pragma unroll 4
            for (int n = 0; n < 32; ++n) { const int c = 64 + sq * 32 + (dir ? 31 - n : n); u32x4* u = (u32x4*)(ur_ptr(P, c, head, dir) + q * 16);
                const u32x4 uv = *u; *u = pk8(Ra, Rb); Ra = Ra * gC + unpk_lo(uv); Rb = Rb * gC + unpk_hi(uv); }
        } else {
            const int b = sq - 4; u32x4* u0 = (u32x4*)(ur_ptr(P, 2 * b, head, dir) + q * 16); u32x4* u1 = (u32x4*)(ur_ptr(P, 2 * b + 1, head, dir) + q * 16);
            const u32x4 a = *u0, bb = *u1; const u32x4 z = {0u, 0u, 0u, 0u};
            float* o = (dir ? orb : orf) + ((size_t)(b * 4 + head) * 64 + d) * 128 + dv;
            if (dir == 0) { *(f32x4*)o = unpk_lo(a) * gC + unpk_lo(bb); *(f32x4*)(o + 4) = unpk_hi(a) * gC + unpk_hi(bb); *u0 = z; *u1 = a; }
            else { *(f32x4*)o = unpk_lo(bb) * gC + unpk_lo(a); *(f32x4*)(o + 4) = unpk_hi(bb) * gC + unpk_hi(a); *u1 = z; *u0 = bb; }
        }
    }
}
__device__ __forceinline__ void fast_mod(CParams& P, LAS unsigned char* lds, int wave) {
    const int lane = lane_id(), tid = wave * 64 + lane;
    LAS float* sc = (LAS float*)lds;
    LAS float* red = (LAS float*)(lds + 20480);
    for (int i = tid; i < 5120; i += NTHREADS) { const int c = i >> 10, k = i & 1023; sc[i] = silu_f(cond_vec(P, c)[k]); }
    RET_BAR();
    float* mod = ws_f32(P, WS_MOD);
    for (int task = blockIdx.x; task < 4 * 48; task += gridDim.x) {
        const int l = task / 48, j = (task % 48) * 64 + lane; const float* w = P.in[I_ADAW] + (size_t)l * 1024 * 3072 + (size_t)(wave * 128) * 3072 + j;
        float a0 = 0.f, a1 = 0.f, a2 = 0.f, a3 = 0.f, a4 = 0.f;
#pragma unroll 8
        for (int k = 0; k < 128; ++k) { const float x = w[(size_t)k * 3072]; const int kk = wave * 128 + k; a0 += sc[kk] * x; a1 += sc[1024 + kk] * x; a2 += sc[2048 + kk] * x; a3 += sc[3072 + kk] * x; a4 += sc[4096 + kk] * x; }
        red[(wave * 5 + 0) * 64 + lane] = a0; red[(wave * 5 + 1) * 64 + lane] = a1; red[(wave * 5 + 2) * 64 + lane] = a2; red[(wave * 5 + 3) * 64 + lane] = a3; red[(wave * 5 + 4) * 64 + lane] = a4;
        RET_BAR();
        if (tid < 320) { const int c = tid >> 6, jj = tid & 63; float s = 0.f;
#pragma unroll
            for (int wv = 0; wv < 8; ++wv) s += red[(wv * 5 + c) * 64 + jj];
            const int jo = (task % 48) * 64 + jj; mod[(l * 5 + c) * 3072 + jo] = s + P.in[I_ADAB][l * 3072 + jo]; }
        RET_BAR();
    }
    const long gt = (long)blockIdx.x * NTHREADS + tid, gn = (long)gridDim.x * NTHREADS;
    float* r8 = ws_f32(P, WS_ROPE8); float* r16 = ws_f32(P, WS_ROPE16);
    for (long i = gt; i < 64 * 8; i += gn) { const int pos = (int)(i >> 3), f = (int)(i & 7); const float inv = powf(10000.f, -(float)f / 8.f), a = (float)pos * inv; r8[2 * i] = cosf(a); r8[2 * i + 1] = sinf(a); }
    for (long i = gt; i < 64 * 16; i += gn) { const int pos = (int)(i >> 4), f = (int)(i & 15); const float inv = powf(10000.f, -(float)f / 16.f), a = (float)pos * inv; r16[2 * i] = cosf(a); r16[2 * i + 1] = sinf(a); }
}
__device__ __forceinline__ void fast_biasL2(CParams& P, LAS unsigned char* lds, int wave) {
    const int lane = lane_id(), tid = wave * 64 + lane;
    LAS float* red = (LAS float*)(lds + 20480);
    float* biasl = ws_f32(P, WS_BIASL); const float* mod = ws_f32(P, WS_MOD);
    for (int task = blockIdx.x; task < 4 * 44; task += gridDim.x) {
        const int l = task / 44, nb = task % 44, n = nb * 64 + lane; const int N = (l & 1) ? WIN_IN : AB_IN;
        const int sc = (n < ((l & 1) ? 2560 : 2816)) ? srccol((l & 1) ? MAP_IN_ODD : MAP_IN_EVEN, n) : -1;
        const float* w = ((l & 1) ? P.in[I_WWIN] : P.in[I_ABWIN]) + (size_t)(l >> 1) * 1024 * N + (size_t)(wave * 128) * N + (sc >= 0 ? sc : 0);
        const float* sh = mod + (l * 5) * 3072 + wave * 128;
        float a0 = 0.f, a1 = 0.f, a2 = 0.f, a3 = 0.f, a4 = 0.f;
        if ((l & 1) == 0 || nb < 40) {
#pragma unroll 8
            for (int k = 0; k < 128; ++k) { const float x = sc >= 0 ? w[(size_t)k * N] : 0.f; a0 += sh[k] * x; a1 += sh[3072 + k] * x; a2 += sh[2 * 3072 + k] * x; a3 += sh[3 * 3072 + k] * x; a4 += sh[4 * 3072 + k] * x; }
        }
        red[(wave * 5 + 0) * 64 + lane] = a0; red[(wave * 5 + 1) * 64 + lane] = a1; red[(wave * 5 + 2) * 64 + lane] = a2; red[(wave * 5 + 3) * 64 + lane] = a3; red[(wave * 5 + 4) * 64 + lane] = a4;
        RET_BAR();
        if (tid < 320) { const int c = tid >> 6, jj = tid & 63; float s = 0.f;
#pragma unroll
            for (int wv = 0; wv < 8; ++wv) s += red[(wv * 5 + c) * 64 + jj];
            biasl[(l * 5 + c) * 2816 + nb * 64 + jj] = s; }
        RET_BAR();
    }
}
__device__ __forceinline__ void fast_prepA0(CParams& P, int wave) {
    const int lane = lane_id(); const int gw = blockIdx.x * NWAVES + wave, ngw = gridDim.x * NWAVES;
    bf16_t* A = ws_bf(P, WS_AEVEN); float* SS = ws_f32(P, WS_SS); const float* mod = ws_f32(P, WS_MOD); const float* g = P.in[I_NORMG];
    for (int row = gw; row < MROWS; row += ngw) {
        const int cond = row < NP_ROWS ? 4 : (row - NP_ROWS) >> 12; const float* y = y_row(P, 0, row); const float* sc = mod + cond * 3072 + 1024;
        float s = 0.f;
#pragma unroll
        for (int j = 0; j < 2; ++j) { const int col = j * 512 + lane * 8;
            const f32x4 a = *(const f32x4*)(y + col), b = *(const f32x4*)(y + col + 4); s += sum4sq(a) + sum4sq(b);
            const f32x4 ga = *(const f32x4*)(g + col) * (*(const f32x4*)(sc + col) + 1.f), gb = *(const f32x4*)(g + col + 4) * (*(const f32x4*)(sc + col + 4) + 1.f);
            *(u32x4*)(A + (size_t)row * 1024 + col) = pk8(a * ga, b * gb); }
        s = wave_sum(s);
        if (lane < 16) SS[row * 16 + lane] = lane == 0 ? s : 0.f;
    }
}
__device__ __forceinline__ void fast_ctx_even(CParams& P, int layer, int wave) {
    const int lane = lane_id(); const long gt = ((long)blockIdx.x * NWAVES + wave) * 64 + lane, gn = (long)gridDim.x * NTHREADS;
    const float* cckv = P.in[layer == 0 ? I_C0CKV : I_C2CKV]; const float* ckr = P.in[layer == 0 ? I_C0KR : I_C2KR];
    bf16_t *CKVN = ws_bf(P, WS_CKVN), *KR = ws_bf(P, WS_KR); float* sskr = ws_f32(P, WS_SSKR);
    for (long i = gt; i < (long)CTX_ROWS * 32; i += gn) *(u32x4*)(CKVN + (size_t)MROWS * 256 + i * 8) = pk8(*(const f32x4*)(cckv + i * 8), *(const f32x4*)(cckv + i * 8 + 4));
    for (long i = gt; i < (long)CTX_ROWS * 4; i += gn) { const int rc = (int)(i >> 2), g = (int)(i & 3); const float* src = ckr + (size_t)rc * 32 + 16 * (g >> 1) + 4 * (g & 1);
        const u32x4 w = pk8(*(const f32x4*)src, *(const f32x4*)(src + 8)); *(u32x4*)(KR + (size_t)(MROWS + rc) * 32 + 8 * g) = w;
        float s = sum4sq(unpk_lo(w)) + sum4sq(unpk_hi(w)); s += xor_shfl<1>(s); s += xor_shfl<2>(s); if (g == 0) sskr[MROWS + rc] = s; }
}
__device__ __forceinline__ void fast_ctx_odd(CParams& P, int layer, int wave) {
    const int lane = lane_id(); const long gt = ((long)blockIdx.x * NWAVES + wave) * 64 + lane, gn = (long)gridDim.x * NTHREADS;
    const float* ck = P.in[layer == 1 ? I_C1K : I_C3K]; const float* cv = P.in[layer == 1 ? I_C1V : I_C3V]; unsigned char* KI = P.ws + WS_KWIMG; unsigned char* VI = P.ws + WS_VWIMG;
    unsigned* bmax = (unsigned*)ws_f32(P, WS_BND) + 4 + (layer >> 1);
    for (long i = gt; i < (long)CTX_ROWS * 32; i += gn) { const int pc = (int)(i & 7), kvh = (int)((i >> 3) & 3), rc = (int)(i >> 5); int kin; const int tile = kv_tile(MROWS + rc, kvh, 4, kin);
        const float* ks = ck + (size_t)rc * 256 + kvh * 64 + 32 * (pc & 1) + 4 * (pc >> 1);
        const u32x4 kw = pk8(*(const f32x4*)ks, *(const f32x4*)(ks + 16)); *(u32x4*)(KI + (size_t)tile * 8192 + pc * 1024 + kin * 16) = kw;
        const float* vs = cv + (size_t)rc * 256 + kvh * 64 + 8 * pc;
        *(u32x4*)(VI + (size_t)tile * 8192 + (pc >> 2) * 4096 + kin * 64 + (pc & 3) * 16) = pk8(*(const f32x4*)vs, *(const f32x4*)(vs + 4));
        float s = sum4sq(unpk_lo(kw)) + sum4sq(unpk_hi(kw)); s += xor_shfl<1>(s); s += xor_shfl<2>(s); s += xor_shfl<4>(s);
        if (pc == 0) atomicMax(bmax, __float_as_uint(s)); }
}
typedef __attribute__((address_space(1))) unsigned gu32;
#define XB_TMO      128
#define XB_XCNT(j)  (256  + 64 * (j))
#define XB_XSUB(j)  (1280 + 64 * (j))
#define XB_XGEN(j)  (2304 + 64 * (j))
#define XB_TOP      3328
#define XB_TOPGEN   3392
#define XCD_BAR_WORDS 3456
#define XB_SPIN_CAP (1u << 26)
__device__ __forceinline__ unsigned xb_ld(unsigned* p)              { return __hip_atomic_load(p, __ATOMIC_RELAXED, __HIP_MEMORY_SCOPE_AGENT); }
__device__ __forceinline__ unsigned xb_add(unsigned* p, unsigned v) { return __hip_atomic_fetch_add(p, v, __ATOMIC_RELAXED, __HIP_MEMORY_SCOPE_AGENT); }
__device__ __forceinline__ unsigned xb_xcc_id() { return (unsigned)__builtin_amdgcn_s_getreg((3 << 11) | 20) & 0xFu; }
#define XB_SPIN(cond, bar) do { unsigned _sp = 0; while (cond) { __builtin_amdgcn_s_sleep(1); \
    if ((++_sp & 255u) == 0u) { if (xb_ld(&(bar)[XB_TMO])) break; if (_sp > XB_SPIN_CAP) { atomicAdd(&(bar)[XB_TMO], 1u); break; } } } } while (0)
struct XcdBarrier { unsigned* bar; unsigned x; volatile LAS unsigned* st; };
__device__ __forceinline__ XcdBarrier xcd_barrier_post(unsigned* bar, volatile LAS unsigned* st, bool t0) {
    XcdBarrier b; b.bar = bar; b.x = xb_xcc_id(); b.st = st;
    if (t0) (void)xb_add(&bar[XB_XCNT(b.x)], 1u);
    return b;
}
__device__ __forceinline__ void xcd_barrier_complete(unsigned* bar, unsigned x, unsigned& nloc, unsigned& nx) {
    const unsigned G = gridDim.x * gridDim.y * gridDim.z;
    unsigned sum, cnt, mine, sp = 0u;
    for (;;) {
        sum = 0u; cnt = 0u; mine = 0u;
#pragma unroll
        for (unsigned j = 0; j < 16; ++j) { const unsigned c = xb_ld(&bar[XB_XCNT(j)]); sum += c; cnt += (c > 0u) ? 1u : 0u; mine = (j == x) ? c : mine; }
        if (sum == G) break;
        __builtin_amdgcn_s_sleep(1);
        if ((++sp & 255u) == 0u) { if (xb_ld(&bar[XB_TMO])) break; if (sp > XB_SPIN_CAP) { atomicAdd(&bar[XB_TMO], 1u); break; } }
    }
    nloc = mine > 0u ? mine : 1u; nx = cnt > 0u ? cnt : 1u;
}
__device__ __forceinline__ void xcd_barrier(const XcdBarrier& b, bool t0) {
    asm volatile("s_waitcnt vmcnt(0)" ::: "memory");
    __syncthreads();
    if (t0) {
        unsigned* bar = b.bar;
        __builtin_amdgcn_s_waitcnt(0);
        unsigned nloc = b.st[0], nx = b.st[1];
        if (nloc == 0u) { xcd_barrier_complete(bar, b.x, nloc, nx); b.st[0] = nloc; b.st[1] = nx; }
        const unsigned old = xb_add(&bar[XB_XSUB(b.x)], 1u);
        const unsigned gen = old / nloc;
        if (old + 1u == (gen + 1u) * nloc) {
            __builtin_amdgcn_fence(__ATOMIC_RELEASE, "agent");
            asm volatile("s_waitcnt vmcnt(0)" ::: "memory");
            const unsigned og = xb_add(&bar[XB_TOP], 1u);
            const unsigned tg = og / nx;
            if (og + 1u == (tg + 1u) * nx) xb_add(&bar[XB_TOPGEN], 1u);
            else XB_SPIN(xb_ld(&bar[XB_TOPGEN]) == tg, bar);
            __builtin_amdgcn_fence(__ATOMIC_ACQUIRE, "agent");
            xb_add(&bar[XB_XGEN(b.x)], 1u);
            asm volatile("s_waitcnt vmcnt(0)" ::: "memory");
        } else {
            XB_SPIN(xb_ld(&bar[XB_XGEN(b.x)]) == gen, bar);
            __builtin_amdgcn_fence(__ATOMIC_ACQUIRE, "agent");
            asm volatile("s_waitcnt vmcnt(0)" ::: "memory");
        }
    }
    __syncthreads();
}

#ifndef FAST_OUT
#define FAST_OUT 1
#endif
#ifndef FAST_IN_ODD
#define FAST_IN_ODD 1
#endif
#ifndef FAST_IN_EVEN
#define FAST_IN_EVEN 1
#endif
#ifndef FAST_UQ
#define FAST_UQ 1
#endif
#ifndef FAST_UKV
#define FAST_UKV 1
#endif
#ifndef FAST_MLA
#define FAST_MLA 1
#endif
#ifndef FAST_WIN
#define FAST_WIN 1
#endif
#ifndef FAST_RETU
#define FAST_RETU 1
#endif
#ifndef FAST_RETO
#define FAST_RETO 1
#endif

enum { K_P0 = 0, K_P1, K_E_IN, K_E_POST, K_E_UQ, K_E_UQSS, K_E_UKV, K_E_KPOST, K_E_SCAN, K_E_ATTN, K_E_OUT, K_E_PREPA, K_O_IN, K_O_POST, K_O_ATTN, K_O_OUT, K_O_PREPA };
template <int KIND, int LAYER> __device__ __forceinline__ void run_phase(LAS unsigned char* L, int wave_s) {
    constexpr int kind = KIND, layer = LAYER;
    CParams* Pq = params_ptr();
#define P (*Pq)
    int ws_ = wave_s; asm volatile("" : "+s"(ws_)); int ln_ = lane_id(); asm volatile("" : "+v"(ln_));
    const int wave = ws_, lane = ln_, tid = wave * 64 + lane;
    const int G = gridDim.x; const long gn = (long)G * NTHREADS, gt = (long)blockIdx.x * NTHREADS + tid; const int gw = blockIdx.x * NWAVES + wave, ngw = G * NWAVES;
    LAS float* wscr = (LAS float*)(L + wave * 16384);
    LAS float* xch = (LAS float*)(L + EPI_OFF);
    (void)lane; (void)gw; (void)ngw; (void)gt; (void)gn; (void)wscr; (void)xch;
    if constexpr (kind == K_P0) {
        nv_zero_bnd(P, 0, gt, gn); fast_mod(P, L, wave); prep_layer_weights(P, 0, wscr, gw, ngw, lane); fast_ctx_even(P, 0, wave);
    } else if constexpr (kind == K_P1) {
        nv_gs(P, 0, gt, gn); fast_biasL2(P, L, wave); fast_prepA0(P, wave);
    } else if constexpr (kind == K_E_IN) {
#if FAST_IN_EVEN
        pg8::Gemm g{ws_bf(P, WS_AEVEN), ws_bf(P, WS_WIN), MROWS, 2816, 1024, 1024}; pg8::StaticOrder S; S.init(MROWS, 2816, G, (int)blockIdx.x);
        EpiIn<false> E{Pq, layer, xch}; pg8::gemm_phase<EpiIn<false>, pg8::StaticOrder, true, true>(L, g, S, E, wave_s);
#else
        nv_in_even(P, layer, gt, gn);
#endif
    } else if constexpr (kind == K_E_POST) { nv_post_even(P, layer, gt, gn);
    } else if constexpr (kind == K_E_UQ) {
#if FAST_UQ
        pg8::Gemm g{ws_bf(P, WS_CQ), ws_bf(P, WS_WUQ), MROWS, 768, 384, 384}; pg8::StaticOrder S; S.init(MROWS, 768, G, (int)blockIdx.x);
        EpiUq E{Pq, layer}; pg8::gemm_phase<EpiUq, pg8::StaticOrder, true, true>(L, g, S, E, wave_s);
#else
        nv_uq(P, layer, gt, gn);
#endif
    } else if constexpr (kind == K_E_UQSS) { nv_uq_ss(P, layer, gt, gn);
    } else if constexpr (kind == K_E_UKV) {
#if FAST_UKV
        { pg8::Gemm g{ws_bf(P, WS_CKVN), ws_bf(P, WS_WUKV), MROWS_X, 1024, 256, 256}; pg8::StaticOrder S; S.init(MROWS_X, 1024, G, (int)blockIdx.x);
          EpiUkv E{Pq, layer}; pg8::gemm_phase<EpiUkv, pg8::StaticOrder, true, true>(L, g, S, E, wave_s); }
#else
        nv_ukv(P, layer, gt, gn);
#endif
#if FAST_RETU
        ret_u_phase(P, layer, L, wave);
#else
        nv_u(P, layer, gt, gn);
#endif
    } else if constexpr (kind == K_E_KPOST) { nv_k_post(P, layer, gt, gn);
    } else if constexpr (kind == K_E_SCAN) { fast_scan(P, layer, wave);
    } else if constexpr (kind == K_E_ATTN) {
#if FAST_MLA
        mla_phase(P, layer, L, wave);
#else
        nv_mla_attn(P, layer, gt, gn);
#endif
#if FAST_RETO
        ret_out_phase(P, layer, L, wave);
#else
        nv_ret_out(P, layer, gt, gn);
#endif
    } else if constexpr (kind == K_O_IN) {
#if FAST_IN_ODD
        pg8::Gemm g{ws_bf(P, WS_AODD), ws_bf(P, WS_WIN), MROWS, 2560, 1024, 1024}; pg8::StaticOrder S; S.init(MROWS, 2560, G, (int)blockIdx.x);
        EpiIn<true> E{Pq, layer, xch}; pg8::gemm_phase<EpiIn<true>, pg8::StaticOrder, true, true>(L, g, S, E, wave_s);
#else
        nv_in_odd(P, layer, gt, gn);
#endif
    } else if constexpr (kind == K_O_POST) { nv_post_odd(P, layer, gt, gn);
    } else if constexpr (kind == K_O_ATTN) {
#if FAST_WIN
        win_phase(P, layer, L, wave);
#else
        nv_win_attn(P, layer, gt, gn);
#endif
    } else if constexpr (kind == K_E_OUT || kind == K_O_OUT) {
        if constexpr (layer < 3) { prep_layer_weights(P, layer + 1, wscr, gw, ngw, lane); if constexpr ((layer + 1) & 1) fast_ctx_odd(P, layer + 1, wave); else fast_ctx_even(P, layer + 1, wave); }
        __syncthreads();
#if FAST_OUT
        pg8::Gemm g{ws_bf(P, WS_G), ws_bf(P, (layer & 1) ? WS_WOUT1 : WS_WOUT0), MROWS, 1024, 1024, 1024}; pg8::StaticOrder S; S.init(MROWS, 1024, G, (int)blockIdx.x);
        EpiOut E{Pq, layer}; pg8::gemm_phase<EpiOut, pg8::StaticOrder, true, true>(L, g, S, E, wave_s);
#else
        nv_out(P, layer, gt, gn);
#endif
    } else {   nv_prepA(P, layer + 1, gt, gn); }
#undef P
}
__device__ __forceinline__ void grid_bar(volatile LAS unsigned* MISC, int wave_s) {
    CParams* Pb = params_ptr(); XcdBarrier bar; bar.bar = (unsigned*)(Pb->ws + WS_CTL) + 4096; bar.x = xb_xcc_id(); bar.st = MISC + 8; xcd_barrier(bar, wave_s == 0 && lane_id() == 0);
}
#ifndef REPMASK
#define REPMASK 0
#endif
#define PH(kind, layer) do { run_phase<kind, layer>(L, wave_s); grid_bar(MISC, wave_s); if constexpr ((REPMASK >> (kind)) & 1) { run_phase<kind, layer>(L, wave_s); grid_bar(MISC, wave_s); } } while (0)
template <int LAYER> __device__ __forceinline__ void even_layer(LAS unsigned char* L, volatile LAS unsigned* MISC, int wave_s) {
    PH(K_E_IN, LAYER);
    if constexpr (!FAST_IN_EVEN) PH(K_E_POST, LAYER);
    PH(K_E_UQ, LAYER);
    if constexpr (!FAST_UQ) PH(K_E_UQSS, LAYER);
    PH(K_E_UKV, LAYER);
    if constexpr (!FAST_UKV) PH(K_E_KPOST, LAYER);
    PH(K_E_SCAN, LAYER);
    PH(K_E_ATTN, LAYER);
    PH(K_E_OUT, LAYER);
#ifdef REP_OUT0
    if constexpr (LAYER == 0) PH(K_E_OUT, LAYER);
#endif
    if constexpr (!FAST_OUT) PH(K_E_PREPA, LAYER);
}
template <int LAYER> __device__ __forceinline__ void odd_layer(LAS unsigned char* L, volatile LAS unsigned* MISC, int wave_s) {
    PH(K_O_IN, LAYER);
    if constexpr (!FAST_IN_ODD) PH(K_O_POST, LAYER);
    PH(K_O_ATTN, LAYER);
    if constexpr (LAYER == 3) { run_phase<K_O_OUT, LAYER>(L, wave_s); }
    else { PH(K_O_OUT, LAYER); if constexpr (!FAST_OUT) PH(K_O_PREPA, LAYER); }
}
__global__ void __launch_bounds__(NTHREADS, 2) mk_fwd(Params P_) {
    extern __shared__ __attribute__((aligned(16))) unsigned char lds[];
    LAS unsigned char* L = (LAS unsigned char*)lds;
    volatile LAS unsigned* MISC = (volatile LAS unsigned*)(L + MISC_OFF);
    const int wave_s = __builtin_amdgcn_readfirstlane(threadIdx.x >> 6);
    if (wave_s == 0 && lane_id() < 32) MISC[lane_id()] = 0u;
    __syncthreads();
    { CParams* P0 = params_ptr(); (void)xcd_barrier_post((unsigned*)(P0->ws + WS_CTL) + 4096, MISC + 8, wave_s == 0 && lane_id() == 0); }
    PH(K_P0, 0); PH(K_P1, 0);
    even_layer<0>(L, MISC, wave_s); odd_layer<1>(L, MISC, wave_s); even_layer<2>(L, MISC, wave_s); odd_layer<3>(L, MISC, wave_s);
}
extern "C" void kernel_launch(void* const* d_in, const int* in_sizes, int n_in, void* d_out, int out_size, void* d_ws, size_t ws_size, hipStream_t stream) {
    if (n_in != N_INPUTS || ws_size < WS_END || (size_t)out_size != O_END) { fprintf(stderr, "kernel_launch: unexpected shapes (n_in %d, out %d, ws %zu)\n", n_in, out_size, ws_size); return; }
    static int grid = 0;
    if (grid == 0) {
        int dev = 0, cus = 0;
        if (hipGetDevice(&dev) != hipSuccess || hipDeviceGetAttribute(&cus, hipDeviceAttributeMultiprocessorCount, dev) != hipSuccess) { grid = -1; return; }
        if (hipFuncSetAttribute((const void*)mk_fwd, hipFuncAttributeMaxDynamicSharedMemorySize, LDS_BYTES) != hipSuccess) { grid = -1; return; }
        grid = cus;
    }
    if (grid < 0) return;
    (void)hipMemsetAsync((char*)d_ws + WS_CTL, 0, 1 * MiB, stream);
    Params P{};
    for (int i = 0; i < N_INPUTS; ++i) P.in[i] = (const float*)d_in[i];
    P.out = (float*)d_out; P.ws = (unsigned char*)d_ws; P.ph_lo = 0; P.ph_hi = 0;
    hipLaunchKernelGGL(mk_fwd, dim3(grid), dim3(NTHREADS), LDS_BYTES, stream, P);
}
```
